# Optimizing an MI355X kernel written in HIP

```python
import jax, jax.numpy as jnp
from jax import lax
import numpy as np

D_MODEL = 2048
BATCH = 4
SEQ = 4096
DEPTH = 4

CTX_LEN = 256
GRID_W = 64
EPS = 1e-6
F_MIN = 1e-30
N_MOD = 6

HEAD_DIM = 128
ATTN_HEADS = 8
ATTN_KV_HEADS = 2
ATTN_GROUP = ATTN_HEADS // ATTN_KV_HEADS
ATTN_Q_BLOCK = 128
ROPE_THETA = 10000.0
ATTN_Q_W = ATTN_HEADS * HEAD_DIM
ATTN_KV_W = ATTN_KV_HEADS * HEAD_DIM

HG_HEADS = 4
HG_DK = 128
HG_DV = 128
HG_CHUNK = 16
HG_K_W = HG_HEADS * HG_DK
HG_V_W = HG_HEADS * HG_DV

SG_GROUPS = 4
SG_DIM = 128
SG_CHUNK = 128
SG_W = SG_GROUPS * SG_DIM

D_MIX = ATTN_Q_W + HG_V_W + SG_W
IN_SIZES = (ATTN_Q_W, ATTN_KV_W, ATTN_KV_W, HG_K_W, HG_K_W, HG_K_W, HG_V_W, HG_V_W, SG_W, SG_W)
IN_COLS = 5120

D_FF = 5632
CONV_W = 3

kernel_name = "hybrid_parallel_mixer_dit_block"


def rms_norm(x, g):
    xf = x.astype(jnp.float32)
    y = xf * lax.rsqrt(jnp.mean(xf * xf, axis=-1, keepdims=True) + EPS)
    return (y * g.astype(jnp.float32)).astype(x.dtype)


def axial_rope_tables(n_tokens):
    rows = n_tokens // GRID_W
    row = jnp.repeat(jnp.arange(rows, dtype=jnp.float32), GRID_W)
    col = jnp.tile(jnp.arange(GRID_W, dtype=jnp.float32), rows)
    n_freq = HEAD_DIM // 4
    inv = ROPE_THETA ** (-jnp.arange(n_freq, dtype=jnp.float32) / n_freq)
    ang = jnp.concatenate([row[:, None] * inv, col[:, None] * inv], axis=-1)
    return jnp.cos(ang), jnp.sin(ang)


def apply_rope(x, cos, sin):
    xf = x.astype(jnp.float32).reshape(*x.shape[:-1], HEAD_DIM // 2, 2)
    x1, x2 = xf[..., 0], xf[..., 1]
    cs, sn = cos[None, :, None, :], sin[None, :, None, :]
    out = jnp.stack([x1 * cs - x2 * sn, x1 * sn + x2 * cs], axis=-1)
    return out.reshape(x.shape).astype(x.dtype)


def gqa_softmax(q, k, v):
    s = jnp.einsum('bqkgd,bskd->bkgqs', q, k).astype(jnp.float32) * (HEAD_DIM ** -0.5)
    p = jax.nn.softmax(s, axis=-1).astype(v.dtype)
    return jnp.einsum('bkgqs,bskd->bqkgd', p, v)


def latent_attention(q, k_all, v_all):
    B, T, H, Dh = q.shape
    nb = T // ATTN_Q_BLOCK
    qb = q.reshape(B, nb, ATTN_Q_BLOCK, ATTN_KV_HEADS, ATTN_GROUP, Dh).transpose(1, 0, 2, 3, 4, 5)
    o = lax.map(lambda qblk: gqa_softmax(qblk, k_all, v_all), qb)
    return o.transpose(1, 0, 2, 3, 4, 5).reshape(B, T, H * Dh)


def context_attention(q, k, v):
    B, L, H, Dh = q.shape
    o = gqa_softmax(q.reshape(B, L, ATTN_KV_HEADS, ATTN_GROUP, Dh), k, v)
    return o.reshape(B, L, H * Dh)


def hgrn_lower_bounds(lb_param):
    p = jax.nn.softmax(lb_param.astype(jnp.float32), axis=1)
    return jnp.cumsum(p, axis=1) - p[:, :1]


def hgrn2_gates(f_raw, lb):
    z = f_raw.astype(jnp.float32)
    lb = lb.reshape(HG_HEADS, HG_DK)
    f = lb + (1.0 - lb) * jax.nn.sigmoid(z)
    log_f = jnp.log(jnp.maximum(f, F_MIN))
    k = (1.0 - lb) * jax.nn.sigmoid(-z)
    return log_f, k


def gla_chunkwise(q, k, v, log_f, s0):
    B, T, H, K = q.shape
    V = v.shape[-1]
    C = HG_CHUNK
    N = T // C
    q, k, log_f = [a.reshape(B, N, C, H, K) for a in (q, k, log_f)]
    v = v.reshape(B, N, C, H, V)
    b = jnp.cumsum(log_f, axis=2)
    tri = jnp.tril(jnp.ones((C, C), dtype=bool))[None, None, :, :, None, None]
    diff = b[:, :, :, None] - b[:, :, None, :]
    decay = jnp.where(tri, jnp.exp(jnp.where(tri, diff, 0.0)), 0.0)
    scores = jnp.einsum('bnthk,bnshk,bntshk->bnhts', q, k, decay)
    o_intra = jnp.einsum('bnhts,bnshv->bnthv', scores, v)
    b_last = b[:, :, -1]
    q_dec = q * jnp.exp(b)
    k_dec = k * jnp.exp(b_last[:, :, None] - b)

    def step(S, xs):
        qd, kd, vv, dl = xs
        o = jnp.einsum('bthk,bhkv->bthv', qd, S)
        S = S * dl[..., None] + jnp.einsum('bthk,bthv->bhkv', kd, vv)
        return S, o

    xs = tuple(jnp.moveaxis(a, 1, 0) for a in (q_dec, k_dec, v, jnp.exp(b_last)))
    s_fin, o_inter = lax.scan(step, s0, xs)
    o = o_intra + jnp.moveaxis(o_inter, 0, 1)
    return o.reshape(B, T, H, V), s_fin


def hgrn2_direction(q_l, i_l, f_l, q_c, i_c, f_c, lb):
    B = q_l.shape[0]
    s0 = jnp.zeros((B, HG_HEADS, HG_DK, HG_DV), jnp.float32)
    logf_c, k_c = hgrn2_gates(f_c, lb)
    o_c, s_ctx = gla_chunkwise(q_c, k_c, i_c, logf_c, s0)
    logf_l, k_l = hgrn2_gates(f_l, lb)
    o_l, _ = gla_chunkwise(q_l, k_l, i_l, logf_l, s_ctx)
    return o_l, o_c


def spatial_gating(u, v, norm_g, w_s, b_s):
    B, T, _ = u.shape
    N = T // SG_CHUNK
    u = jax.nn.gelu(u)
    v = rms_norm(jax.nn.gelu(v).reshape(B, T, SG_GROUPS, SG_DIM), norm_g.reshape(SG_GROUPS, SG_DIM))
    v = v.reshape(B, N, SG_CHUNK, SG_GROUPS, SG_DIM)
    mixed = jnp.einsum('gts,bnsgd->bntgd', w_s, v) + b_s.T[:, :, None]
    return u * mixed.reshape(B, T, SG_W)


def conv_ffn(h, w_up, conv_w, conv_b, w_down):
    T = h.shape[1]
    up = h @ w_up
    pad = jnp.pad(up, ((0, 0), (CONV_W // 2, CONV_W // 2), (0, 0)))
    y = conv_b + sum(pad[:, j:j + T] * conv_w[j] for j in range(CONV_W))
    gate, val = jnp.split(y, 2, axis=-1)
    return (jax.nn.silu(gate) * val) @ w_down


def token_mixers(h, hc, w_in, q_g, k_g, lb_f, lb_b, hg_g, sg_g, sg_w, sg_b, cos, sin, need_ctx):
    B, T, _ = h.shape
    L = hc.shape[1]
    splits = np.cumsum(IN_SIZES)[:-1].tolist()
    (aq, ak, av, hq, hff, hfb, hi, hgt, su, sv) = jnp.split(h @ w_in, splits, axis=-1)
    (aqc, akc, avc, hqc, hffc, hfbc, hic, hgtc, suc, svc) = jnp.split(hc @ w_in, splits, axis=-1)

    q = apply_rope(rms_norm(aq.reshape(B, T, ATTN_HEADS, HEAD_DIM), q_g), cos, sin)
    k = apply_rope(rms_norm(ak.reshape(B, T, ATTN_KV_HEADS, HEAD_DIM), k_g), cos, sin)
    v = av.reshape(B, T, ATTN_KV_HEADS, HEAD_DIM)
    kc = rms_norm(akc.reshape(B, L, ATTN_KV_HEADS, HEAD_DIM), k_g)
    vc = avc.reshape(B, L, ATTN_KV_HEADS, HEAD_DIM)
    attn = latent_attention(q, jnp.concatenate([k, kc], axis=1), jnp.concatenate([v, vc], axis=1))

    def heads(a, d):
        return a.astype(jnp.float32).reshape(a.shape[0], a.shape[1], -1, d)
    flip = lambda a: jnp.flip(a, axis=1)
    q_l, i_l = jax.nn.silu(heads(hq, HG_DK)), heads(hi, HG_DV)
    q_c, i_c = jax.nn.silu(heads(hqc, HG_DK)), heads(hic, HG_DV)
    ff_l, fb_l, ff_c, fb_c = heads(hff, HG_DK), heads(hfb, HG_DK), heads(hffc, HG_DK), heads(hfbc, HG_DK)
    o_f, oc_f = hgrn2_direction(q_l, i_l, ff_l, q_c, i_c, ff_c, lb_f)
    o_b, oc_b = hgrn2_direction(flip(q_l), flip(i_l), flip(fb_l), flip(q_c), flip(i_c), flip(fb_c), lb_b)
    hg_out = (rms_norm(o_f + flip(o_b), hg_g).reshape(B, T, HG_V_W)
              * jax.nn.silu(hgt.astype(jnp.float32))).astype(h.dtype)

    sg = spatial_gating(su, sv, sg_g, sg_w, sg_b)

    mix = jnp.concatenate([attn, hg_out, sg], axis=-1)
    if not need_ctx:
        return mix, None
    qc = rms_norm(aqc.reshape(B, L, ATTN_HEADS, HEAD_DIM), q_g)
    attn_c = context_attention(qc, kc, vc)
    hg_c = (rms_norm(oc_f + flip(oc_b), hg_g).reshape(B, L, HG_V_W)
            * jax.nn.silu(hgtc.astype(jnp.float32))).astype(hc.dtype)
    sg_c = spatial_gating(suc, svc, sg_g, sg_w, sg_b)
    mix_c = jnp.concatenate([attn_c, hg_c, sg_c], axis=-1)
    return mix, mix_c


def setup_inputs(seed: int = 0) -> dict:
    key = jax.random.key(seed)
    ks = jax.random.split(key, 24)
    nrm = lambda k, shape, s: jax.random.normal(k, shape, jnp.float32) * s
    L = DEPTH
    return {
        "x": nrm(ks[0], (BATCH, SEQ, D_MODEL), 1.0),
        "c": nrm(ks[1], (BATCH, D_MODEL), 1.0),
        "ctx": nrm(ks[2], (BATCH, CTX_LEN, D_MODEL), 1.0),
        "c_ctx": nrm(ks[3], (D_MODEL,), 1.0),
        "w_ada": nrm(ks[4], (L, D_MODEL, N_MOD * D_MODEL), 0.5 * D_MODEL ** -0.5),
        "b_ada": nrm(ks[5], (L, N_MOD * D_MODEL), 0.02),
        "norm1_g": 1.0 + nrm(ks[6], (L, D_MODEL), 0.02),
        "w_in": nrm(ks[7], (L, D_MODEL, IN_COLS), D_MODEL ** -0.5),
        "q_norm_g": 1.0 + nrm(ks[8], (L, HEAD_DIM), 0.02),
        "k_norm_g": 1.0 + nrm(ks[9], (L, HEAD_DIM), 0.02),
        "hg_lower_bounds": nrm(ks[10], (2, L, HG_K_W), 0.1),
        "hg_norm_g": 1.0 + nrm(ks[11], (L, HG_DV), 0.02),
        "sg_norm_g": 1.0 + nrm(ks[12], (L, SG_W), 0.02),
        "sg_w": nrm(ks[13], (L, SG_GROUPS, SG_CHUNK, SG_CHUNK), SG_CHUNK ** -0.5),
        "sg_b": 1.0 + nrm(ks[14], (L, SG_GROUPS, SG_CHUNK), 0.02),
        "w_out": nrm(ks[15], (L, D_MIX, D_MODEL), D_MIX ** -0.5),
        "norm2_g": 1.0 + nrm(ks[16], (L, D_MODEL), 0.02),
        "w_up": nrm(ks[17], (L, D_MODEL, 2 * D_FF), D_MODEL ** -0.5),
        "conv_w": nrm(ks[18], (L, CONV_W, 2 * D_FF), CONV_W ** -0.5),
        "conv_b": nrm(ks[19], (L, 2 * D_FF), 0.02),
        "w_down": nrm(ks[20], (L, D_FF, D_MODEL), D_FF ** -0.5),
        "final_norm_g": 1.0 + nrm(ks[21], (D_MODEL,), 0.02),
    }


def reference(x, c, ctx, c_ctx, w_ada, b_ada, norm1_g, w_in, q_norm_g, k_norm_g,
              hg_lower_bounds, hg_norm_g, sg_norm_g, sg_w, sg_b, w_out,
              norm2_g, w_up, conv_w, conv_b, w_down, final_norm_g):
    B, T, _ = x.shape
    cos, sin = axial_rope_tables(T)
    lbs = hgrn_lower_bounds(hg_lower_bounds)
    silu_c = jax.nn.silu(c)
    silu_cc = jax.nn.silu(c_ctx)
    cx = ctx
    for l in range(DEPTH):
        need_ctx = l < DEPTH - 1
        mod = (silu_c @ w_ada[l] + b_ada[l]).reshape(B, N_MOD, 1, D_MODEL)
        mod_c = (silu_cc @ w_ada[l] + b_ada[l]).reshape(N_MOD, D_MODEL)

        h = rms_norm(x, norm1_g[l]) * (1.0 + mod[:, 1]) + mod[:, 0]
        hc = rms_norm(cx, norm1_g[l]) * (1.0 + mod_c[1]) + mod_c[0]
        mix, mix_c = token_mixers(h, hc, w_in[l], q_norm_g[l], k_norm_g[l], lbs[0, l], lbs[1, l],
                                  hg_norm_g[l], sg_norm_g[l], sg_w[l], sg_b[l], cos, sin, need_ctx)
        x = x + mod[:, 2] * (mix @ w_out[l])

        h2 = rms_norm(x, norm2_g[l]) * (1.0 + mod[:, 4]) + mod[:, 3]
        x = x + mod[:, 5] * conv_ffn(h2, w_up[l], conv_w[l], conv_b[l], w_down[l])

        if need_ctx:
            cx = cx + mod_c[2] * (mix_c @ w_out[l])
            hc2 = rms_norm(cx, norm2_g[l]) * (1.0 + mod_c[4]) + mod_c[3]
            cx = cx + mod_c[5] * conv_ffn(hc2, w_up[l], conv_w[l], conv_b[l], w_down[l])
    return rms_norm(x, final_norm_g)
```

```cpp
#include <hip/hip_runtime.h>
#include <cstdio>
#include <cstdint>
#ifndef MK_ONE_LAUNCH
#define MK_ONE_LAUNCH 1
#endif
namespace pg8 {
#define PG8_LAS __attribute__((address_space(3)))
typedef unsigned short bf16_t;
typedef short bf16x8 __attribute__((ext_vector_type(8)));
typedef float f32x4 __attribute__((ext_vector_type(4)));
typedef unsigned u32x4 __attribute__((ext_vector_type(4)));
constexpr int BM = 256, BK = 64, HALF = 128, HTB = HALF * BK * 2  , STAGE_BYTES = 8 * HTB, NXCD = 8, WGM = 8;

__host__ __device__ __forceinline__ int lds_byte(int r, int c) { const int st = (r >> 4) * 2 + (c >> 5), rr = r & 15, cc = c & 31, ob = rr * 64 + cc * 2; return st * 1024 + (ob ^ (((ob >> 9) & 1) << 5)); }
__host__ __device__ __forceinline__ void stage_rc(int b, int& R, int& C) { const int st = b / 1024, sb = b % 1024, swz = sb ^ (((sb >> 9) & 1) << 5); R = (st >> 1) * 16 + swz / 64; C = (st & 1) * 32 + (swz % 64) / 2; }
__host__ __device__ __forceinline__ int perm32(int rho) { const int n = rho >> 4, i = rho & 15; return 8 * (i >> 2) + 4 * n + (i & 3); }

struct Unit { int pm, pn; };
struct Gemm { const bf16_t* A; const bf16_t* Bt; int M, N, K; };

struct StaticOrder {
    int nM, nN, nwg, G, c;
    __host__ __device__ void init(int M, int N, int G_, int c_) { nM = M / BM; nN = N / BM; nwg = nM * nN; G = G_; c = c_; }
    __host__ __device__ bool next(int i, Unit& u) const {
        const long L = (long)i * G + c; if (L >= nwg) return false;
        int wgid = (int)L; { const int q = nwg / NXCD, r = nwg % NXCD, xcd = wgid % NXCD, off = wgid / NXCD; wgid = (xcd < r ? xcd * (q + 1) : r * (q + 1) + (xcd - r) * q) + off; }
        const int nig = WGM * nN, gid = wgid / nig, fm = gid * WGM, gsz = (nM - fm) < WGM ? (nM - fm) : WGM;
        u.pm = fm + ((wgid % nig) % gsz); u.pn = (wgid % nig) / gsz; return true;
    }
    __device__ __forceinline__ void a_ready(const Unit&) const {}
    __device__ __forceinline__ void done(const Unit&) const {}
};

__device__ __forceinline__ unsigned cvt_pk_bf16(float lo, float hi) { unsigned r; asm volatile("v_cvt_pk_bf16_f32 %0, %1, %2" : "=v"(r) : "v"(lo), "v"(hi)); return r; }
typedef float f32x2 __attribute__((ext_vector_type(2)));
__device__ __forceinline__ f32x2 gelu_pk(f32x2 v) {
    const f32x2 av = __builtin_elementwise_abs(v), d = av * 0.2316418882f + 1.0f;
    f32x2 t; t.x = __builtin_amdgcn_rcpf(d.x); t.y = __builtin_amdgcn_rcpf(d.y);
    f32x2 q = t * 0.5307027145f + (-0.7265760135f); q = q * t + 0.7107068705f; q = q * t + (-0.142248368f); q = q * t + 0.127414796f; q = q * t;
    const f32x2 s = (v * v) * (-0.72134752044f);
    f32x2 e; e.x = __builtin_amdgcn_exp2f(s.x); e.y = __builtin_amdgcn_exp2f(s.y);
    const f32x2 m = v * (q * e), r = v - m;
    f32x2 o; o.x = v.x < 0.f ? m.x : r.x; o.y = v.y < 0.f ? m.y : r.y; return o;
}

template <int ACT  > struct EpiBf16 {
    static constexpr bool PERM = true, AFTER_DRAIN = false; static_assert(ACT == 0 || ACT == 1, "EpiBf16: ACT is 0 (none) or 1 (gelu_pk)");
    bf16_t* O; int ldc; const float* bias; int split_cols; size_t split_stride; float scale0;
    __device__ __forceinline__ void operator()(const f32x4 (&acc)[2][2][4][2], const Unit& u, int wr, int wc, int fr, int fq) const {
        const int row0 = u.pm * BM + wr * 64 + fr; int colt = u.pn * BM; bf16_t* base = O;
        float sc = 1.f; if (split_cols) { const int t = colt / split_cols; base += (size_t)t * split_stride; colt -= t * split_cols; if (t == 0) sc = scale0; }
        const int col0 = colt + wc * 32 + 8 * fq, bcol0 = u.pn * BM + wc * 32 + 8 * fq;
        f32x4 bv[2][2];
#pragma unroll
        for (int bj = 0; bj < 2; ++bj)
#pragma unroll
            for (int n = 0; n < 2; ++n) bv[bj][n] = bias ? *(const f32x4*)(bias + bcol0 + bj * HALF + 4 * n) : (f32x4){0.f, 0.f, 0.f, 0.f};
#pragma unroll
        for (int ai = 0; ai < 2; ++ai)
#pragma unroll
            for (int m = 0; m < 4; ++m) { bf16_t* rowp = base + (size_t)(row0 + ai * HALF + m * 16) * ldc + col0;
#pragma unroll
                for (int bj = 0; bj < 2; ++bj) { f32x4 v0 = acc[ai][bj][m][0] + bv[bj][0], v1 = acc[ai][bj][m][1] + bv[bj][1];
                    if (ACT == 1) { f32x2 a = gelu_pk((f32x2){v0[0], v0[1]}), b = gelu_pk((f32x2){v0[2], v0[3]}), c = gelu_pk((f32x2){v1[0], v1[1]}), d = gelu_pk((f32x2){v1[2], v1[3]});
                        v0 = (f32x4){a.x, a.y, b.x, b.y}; v1 = (f32x4){c.x, c.y, d.x, d.y}; }
                    v0 = v0 * sc; v1 = v1 * sc; u32x4 w; w.x = cvt_pk_bf16(v0[0], v0[1]); w.y = cvt_pk_bf16(v0[2], v0[3]); w.z = cvt_pk_bf16(v1[0], v1[1]); w.w = cvt_pk_bf16(v1[2], v1[3]);
                    *(u32x4*)(rowp + bj * HALF) = w; } }
    }
};
template <class Epi, class Sched, bool ALIGN_EPI = false, bool SP2 = false>
__device__ __forceinline__ void gemm_phase(PG8_LAS unsigned char* lds, const Gemm g, const Sched& S, const Epi& E) {
    int tid_l = threadIdx.x; asm volatile("" : "+v"(tid_l)); const int tid = tid_l, wid = __builtin_amdgcn_readfirstlane(tid >> 6), lane = tid & 63, wr = wid >> 2, wc = wid & 3, fr = lane & 15, fq = lane >> 4;
    const int K = g.K, nt = K / BK;
    unsigned voffA[2], voffB[2];
#pragma unroll
    for (int i = 0; i < 2; ++i) { int R, C; stage_rc(tid * 16 + i * 8192, R, C); const int Rb = Epi::PERM ? ((R & ~31) + perm32(R & 31)) : R;
        voffA[i] = (unsigned)(R * K + C) * 2u; voffB[i] = (unsigned)(Rb * K + C) * 2u; }
    const size_t kstep = (size_t)(BK * 2);
    const size_t hstep = (size_t)HALF * K * 2;
    const size_t tstep = 2 * hstep;
    const unsigned ldsw = (unsigned)wid * 1024u;
    const int aoff = lds_byte(wr * 64 + fr, fq * 8), boff = lds_byte(wc * 32 + fr, fq * 8);
#define PG8_SA(b, h) (((b) * 2 + (h)) * HTB)
#define PG8_SB(b, h) ((4 + (b) * 2 + (h)) * HTB)
#define PG8_STAGE(bufoff, gbase, voff) do { _Pragma("unroll") for (int _i = 0; _i < 2; ++_i) \
        __builtin_amdgcn_global_load_lds((const unsigned*)((const char*)(gbase) + (voff)[_i]), (PG8_LAS unsigned*)(lds + (bufoff) + ldsw + _i * 8192), 16, 0, 0); } while (0)
#define PG8_LDA(dst, b, h) do { _Pragma("unroll") for (int m = 0; m < 4; ++m) _Pragma("unroll") for (int k = 0; k < 2; ++k) dst[m][k] = *(const PG8_LAS bf16x8*)(lds + PG8_SA(b, h) + aoff + m * 2048 + k * 1024); } while (0)
#define PG8_LDB(dst, b, h) do { _Pragma("unroll") for (int n = 0; n < 2; ++n) _Pragma("unroll") for (int k = 0; k < 2; ++k) dst[n][k] = *(const PG8_LAS bf16x8*)(lds + PG8_SB(b, h) + boff + n * 2048 + k * 1024); } while (0)
#define PG8_MMA(ai, bj, At, Bt) do { __builtin_amdgcn_s_setprio(1); _Pragma("unroll") for (int m = 0; m < 4; ++m) _Pragma("unroll") for (int n = 0; n < 2; ++n) _Pragma("unroll") for (int k = 0; k < 2; ++k) \
        acc[ai][bj][m][n] = __builtin_amdgcn_mfma_f32_16x16x32_bf16(Bt[n][k], At[m][k], acc[ai][bj][m][n], 0, 0, 0); __builtin_amdgcn_s_setprio(0); } while (0)
#define PG8_WAIT_V(n) asm volatile("s_waitcnt vmcnt(" #n ")" ::: "memory")
#define PG8_WAIT_L(n) asm volatile("s_waitcnt lgkmcnt(" #n ")" ::: "memory")
#define PG8_BAR __builtin_amdgcn_s_barrier()
#define PG8_SCHED __builtin_amdgcn_sched_barrier(0)
    Unit cur, nxt; int ui = 0;
    if (!S.next(0, cur)) return;
    f32x4 acc[2][2][4][2];
#pragma unroll
    for (int a = 0; a < 2; ++a)
#pragma unroll
        for (int b = 0; b < 2; ++b)
#pragma unroll
            for (int m = 0; m < 4; ++m)
#pragma unroll
                for (int n = 0; n < 2; ++n) acc[a][b][m][n] = (f32x4){0.f, 0.f, 0.f, 0.f};
    bf16x8 At[4][2], B0[2][2], B1[2][2];
    const char* cA = (const char*)g.A + (size_t)cur.pm * tstep; const char* cB = (const char*)g.Bt + (size_t)cur.pn * tstep;
    S.a_ready(cur);
    if constexpr (SP2) {
        PG8_STAGE(PG8_SB(0, 0), cB, voffB); PG8_STAGE(PG8_SB(0, 1), cB + hstep, voffB); PG8_STAGE(PG8_SA(0, 0), cA, voffA); PG8_STAGE(PG8_SA(0, 1), cA + hstep, voffA);
        if (wr == 1) PG8_BAR;
        PG8_WAIT_V(2); PG8_BAR;
        PG8_STAGE(PG8_SB(1, 0), cB + kstep, voffB); PG8_STAGE(PG8_SA(1, 0), cA + kstep, voffA); PG8_STAGE(PG8_SB(1, 1), cB + hstep + kstep, voffB);
        PG8_WAIT_V(6); PG8_BAR;
    } else {
        PG8_STAGE(PG8_SB(0, 0), cB, voffB); PG8_STAGE(PG8_SA(0, 0), cA, voffA); PG8_STAGE(PG8_SB(0, 1), cB + hstep, voffB); PG8_STAGE(PG8_SA(0, 1), cA + hstep, voffA);
        if (wr == 1) PG8_BAR;
        PG8_WAIT_V(4); PG8_BAR;
        PG8_STAGE(PG8_SB(1, 0), cB + kstep, voffB); PG8_STAGE(PG8_SA(1, 0), cA + kstep, voffA); PG8_STAGE(PG8_SB(1, 1), cB + hstep + kstep, voffB);
        PG8_WAIT_V(6); PG8_BAR;
    }
    for (;;) {
        const bool has_next = S.next(ui + 1, nxt);
        const char* nA = has_next ? (const char*)g.A + (size_t)nxt.pm * tstep : cA; const char* nB = has_next ? (const char*)g.Bt + (size_t)nxt.pn * tstep : cB;
        for (int t = 0; t < nt; t += 2) {
            const bool last = (t == nt - 2);
            const char* a1 = cA + (size_t)(t + 1) * kstep;
            const char* a2 = last ? nA : cA + (size_t)(t + 2) * kstep; const char* b2 = last ? nB : cB + (size_t)(t + 2) * kstep;
            const char* a3 = a2 + kstep; const char* b3 = b2 + kstep;
            if (last && has_next) S.a_ready(nxt);
            if constexpr (SP2) {
            PG8_LDB(B0, 0, 0); PG8_LDB(B1, 0, 1); PG8_SCHED; PG8_LDA(At, 0, 0); PG8_STAGE(PG8_SA(1, 1), a1 + hstep, voffA);
            PG8_WAIT_V(8); PG8_WAIT_L(0); PG8_BAR; PG8_MMA(0, 0, At, B0); PG8_MMA(0, 1, At, B1); PG8_BAR; PG8_SCHED;
            PG8_LDA(At, 0, 1); PG8_STAGE(PG8_SB(0, 0), b2, voffB); PG8_STAGE(PG8_SB(0, 1), b2 + hstep, voffB); PG8_STAGE(PG8_SA(0, 0), a2, voffA);
            PG8_WAIT_V(8); PG8_WAIT_L(0); PG8_BAR; PG8_MMA(1, 0, At, B0); PG8_MMA(1, 1, At, B1); PG8_BAR; PG8_SCHED;
            PG8_LDB(B0, 1, 0); PG8_LDB(B1, 1, 1); PG8_SCHED; PG8_LDA(At, 1, 0); PG8_STAGE(PG8_SA(0, 1), a2 + hstep, voffA);
            PG8_WAIT_V(8); PG8_WAIT_L(0); PG8_BAR; PG8_MMA(0, 0, At, B0); PG8_MMA(0, 1, At, B1); PG8_BAR; PG8_SCHED;
            PG8_LDA(At, 1, 1); PG8_STAGE(PG8_SB(1, 0), b3, voffB); PG8_STAGE(PG8_SB(1, 1), b3 + hstep, voffB); PG8_STAGE(PG8_SA(1, 0), a3, voffA);
            PG8_WAIT_V(8); PG8_WAIT_L(0); PG8_BAR; PG8_MMA(1, 0, At, B0); PG8_MMA(1, 1, At, B1); PG8_BAR; PG8_SCHED;
            } else {
            PG8_LDB(B0, 0, 0); PG8_SCHED; PG8_LDA(At, 0, 0); PG8_STAGE(PG8_SA(1, 1), a1 + hstep, voffA);
            PG8_WAIT_L(8); PG8_BAR; PG8_WAIT_L(0); PG8_MMA(0, 0, At, B0); PG8_BAR; PG8_SCHED;
            PG8_LDB(B1, 0, 1); PG8_STAGE(PG8_SB(0, 0), b2, voffB);
            PG8_BAR; PG8_WAIT_L(0); PG8_MMA(0, 1, At, B1); PG8_BAR;
            PG8_LDA(At, 0, 1); PG8_STAGE(PG8_SA(0, 0), a2, voffA);
            PG8_BAR; PG8_WAIT_L(0); PG8_MMA(1, 0, At, B0); PG8_BAR; PG8_SCHED;
            PG8_STAGE(PG8_SB(0, 1), b2 + hstep, voffB);
            PG8_WAIT_V(6); PG8_BAR; PG8_MMA(1, 1, At, B1); PG8_BAR;
            PG8_LDB(B0, 1, 0); PG8_SCHED; PG8_LDA(At, 1, 0); PG8_STAGE(PG8_SA(0, 1), a2 + hstep, voffA);
            PG8_WAIT_L(8); PG8_BAR; PG8_WAIT_L(0); PG8_MMA(0, 0, At, B0); PG8_BAR; PG8_SCHED;
            PG8_LDB(B1, 1, 1); PG8_STAGE(PG8_SB(1, 0), b3, voffB);
            PG8_BAR; PG8_WAIT_L(0); PG8_MMA(0, 1, At, B1); PG8_BAR;
            PG8_LDA(At, 1, 1); PG8_STAGE(PG8_SA(1, 0), a3, voffA);
            PG8_BAR; PG8_WAIT_L(0); PG8_MMA(1, 0, At, B0); PG8_BAR; PG8_SCHED;
            PG8_STAGE(PG8_SB(1, 1), b3 + hstep, voffB);
            PG8_WAIT_V(6); PG8_BAR; PG8_MMA(1, 1, At, B1); PG8_BAR;
            }
        }
        if constexpr (ALIGN_EPI) { if (wr == 0) PG8_BAR; }
        if constexpr (!Epi::AFTER_DRAIN) { E(acc, cur, wr, wc, fr, fq); S.done(cur); }
        if (!has_next) break;
#pragma unroll
        for (int a = 0; a < 2; ++a)
#pragma unroll
            for (int b = 0; b < 2; ++b)
#pragma unroll
                for (int m = 0; m < 4; ++m)
#pragma unroll
                    for (int n = 0; n < 2; ++n) acc[a][b][m][n] = (f32x4){0.f, 0.f, 0.f, 0.f};
        cur = nxt; cA = nA; cB = nB; ++ui;
        if constexpr (ALIGN_EPI) { if (wr == 1) PG8_BAR; }
    }
    PG8_WAIT_V(0);
    if constexpr (!ALIGN_EPI) { if (wr == 0) PG8_BAR; }
    PG8_BAR;
    if constexpr (Epi::AFTER_DRAIN) { E.fused(acc, cur, wr, wc, fr, fq, lds, wid, lane); S.done(cur); }
#undef PG8_SA
#undef PG8_SB
#undef PG8_STAGE
#undef PG8_LDA
#undef PG8_LDB
#undef PG8_MMA
#undef PG8_WAIT_V
#undef PG8_WAIT_L
#undef PG8_BAR
#undef PG8_SCHED
}
}
constexpr int DM = 2048, NB = 4, SEQ = 4096, CTXL = 256, DEPTH = 4;
constexpr int TB = SEQ + CTXL;
constexpr int R = NB * TB;
constexpr int INC = 5120, DFF = 5632, UPC = 2 * DFF, NMODC = 6 * DM;
constexpr int C_AQ = 0, C_AK = 1024, C_AV = 1280, C_HQ = 1536, C_HFF = 2048, C_HFB = 2560, C_HI = 3072, C_HGT = 3584, C_SU = 4096, C_SV = 4608;
constexpr float EPS = 1e-6f;
constexpr int NWAVES = 8, NTHR = 512;
constexpr int NPHASE = 3 + 10 * DEPTH;

constexpr size_t MiB = 1u << 20;
constexpr size_t WS_CTL = 0, CTL_ZERO_BYTES = 4 * MiB;
constexpr size_t WS_MOD = 3 * MiB;
constexpr size_t WS_MISC = 1146 * MiB;
constexpr size_t WS_W = 4 * MiB, W_LAYER = 94 * MiB, W_IN = 0, W_OUT = 20 * MiB, W_UP = 28 * MiB, W_DN = 72 * MiB;
constexpr size_t WS_X = 380 * MiB;
constexpr size_t WS_H = 516 * MiB;
constexpr size_t WS_PROJ = 584 * MiB;
constexpr size_t WS_QN = 754 * MiB;
constexpr size_t WS_KN = 788 * MiB;
constexpr size_t WS_MIX = 797 * MiB;
constexpr size_t WS_HS = 865 * MiB;
constexpr size_t WS_HD = 897 * MiB;
constexpr size_t WS_HO = 898 * MiB;
constexpr size_t WS_UP = 584 * MiB;
constexpr size_t WS_ACT = 958 * MiB;
constexpr size_t WS_SWIN = 1 * MiB;
constexpr size_t WS_SWUP = WS_SWIN + 512 * 1024;
constexpr size_t WS_GS = 1145 * MiB;
constexpr size_t WS_END = 1147 * MiB;
constexpr size_t WS_RS = 65536;
static_assert(WS_RS + (size_t)2 * DEPTH * R * 4 <= WS_SWIN && WS_SWIN + (size_t)DEPTH * 5 * INC * 4 <= WS_SWUP && WS_SWUP + (size_t)DEPTH * 5 * UPC * 4 <= WS_MOD && WS_MOD + (size_t)DEPTH * 5 * NMODC * 4 <= CTL_ZERO_BYTES && WS_GS + (size_t)DEPTH * 2 * 5 * DM * 4 <= WS_MISC && WS_MISC + 65536 <= WS_END && WS_MOD + (size_t)DEPTH * 5 * NMODC * 4 <= WS_W, "ws map 4");
static_assert(WS_HO + (size_t)2 * R * 512 * 4 <= 966 * MiB && WS_UP + (size_t)R * UPC * 2 <= WS_ACT && WS_ACT + (size_t)R * DFF * 2 <= WS_GS, "ws map");
static_assert(WS_PROJ + (size_t)R * INC * 2 <= WS_QN && WS_QN + (size_t)R * 1024 * 2 <= WS_KN && WS_KN + (size_t)R * 256 * 2 <= WS_MIX && WS_MIX + (size_t)R * DM * 2 <= WS_HS, "ws map 2");
static_assert(WS_X + (size_t)R * DM * 4 <= WS_H && WS_H + (size_t)R * DM * 2 <= WS_PROJ && WS_W + DEPTH * W_LAYER <= WS_X, "ws map 3");
constexpr int CW_BAR = 4096;
constexpr int CW_Q0 = 64;

constexpr int RING_BYTES = 131072, LDSCTL_OFF = RING_BYTES, MISC_OFF = LDSCTL_OFF + 320, LDS_BYTES = 147456;

#define GAS __attribute__((address_space(1)))
#define LAS __attribute__((address_space(3)))
typedef unsigned short bf16;
typedef float v4f __attribute__((ext_vector_type(4)));
typedef unsigned v4u __attribute__((ext_vector_type(4)));
typedef unsigned v2u __attribute__((ext_vector_type(2)));
typedef float v2f __attribute__((ext_vector_type(2)));
typedef GAS unsigned gu32;
#define AS4 __attribute__((address_space(4)))
typedef const AS4 unsigned char* kptr_t;
#define LDS_WAIT() asm volatile("s_waitcnt lgkmcnt(0)" ::: "memory")
__device__ __forceinline__ float bf2f(unsigned u) { return __uint_as_float(u << 16); }
__device__ __forceinline__ unsigned f2bf(float f) { unsigned u = __float_as_uint(f); return (u + 0x7fffu + ((u >> 16) & 1u)) >> 16; }
__device__ __forceinline__ unsigned pk2(float lo, float hi) { return f2bf(lo) | (f2bf(hi) << 16); }
__device__ __forceinline__ unsigned cvtpk_rne(float lo, float hi) { unsigned r; asm volatile("v_cvt_pk_bf16_f32 %0, %1, %2" : "=v"(r) : "v"(lo), "v"(hi)); return r; }
__device__ __forceinline__ float dpp_f(float v, const int ctrl_unused) { return v; }
#define DPP_ADD(v, ctrl) ((v) + __builtin_bit_cast(float, __builtin_amdgcn_update_dpp(0, __builtin_bit_cast(int, (v)), (ctrl), 0xf, 0xf, false)))
__device__ __forceinline__ float wave_sum(float v) {
    v = DPP_ADD(v, 0xB1);
    v = DPP_ADD(v, 0x4E);
    v = DPP_ADD(v, 0x141);
    v = DPP_ADD(v, 0x140);
    { auto rr = __builtin_amdgcn_permlane16_swap(__float_as_uint(v), __float_as_uint(v), false, false); v = __uint_as_float(rr[0]) + __uint_as_float(rr[1]); }
    { auto rr = __builtin_amdgcn_permlane32_swap(__float_as_uint(v), __float_as_uint(v), false, false); v = __uint_as_float(rr[0]) + __uint_as_float(rr[1]); }
    return v;
}
__device__ __forceinline__ float sigm(float z) { return __builtin_amdgcn_rcpf(1.f + __expf(-z)); }
__device__ __forceinline__ float silu_f(float z) { return z * sigm(z); }
__device__ __forceinline__ float gelu_tanh(float x) {
    const float u = 0.7978845608028654f * (x + 0.044715f * x * x * x);
    const float th = 1.f - 2.f * __builtin_amdgcn_rcpf(1.f + __expf(2.f * u));
    return 0.5f * x * (1.f + th);
}
__device__ __forceinline__ v4f mfma4(float a, float b, v4f c) { return __builtin_amdgcn_mfma_f32_16x16x4f32(a, b, c, 0, 0, 0); }

#define XB_TMO      128
#define XB_XCNT(j)  (256  + 64 * (j))
#define XB_XSUB(j)  (1280 + 64 * (j))
#define XB_XGEN(j)  (2304 + 64 * (j))
#define XB_TOP      3328
#define XB_TOPGEN   3392
#define XCD_BAR_WORDS 3456
#define XB_SPIN_CAP (1u << 18)
__device__ __forceinline__ unsigned xb_ld(unsigned* p)              { return __hip_atomic_load(p, __ATOMIC_RELAXED, __HIP_MEMORY_SCOPE_AGENT); }
__device__ __forceinline__ unsigned xb_add(unsigned* p, unsigned v) { return __hip_atomic_fetch_add(p, v, __ATOMIC_RELAXED, __HIP_MEMORY_SCOPE_AGENT); }
__device__ __forceinline__ unsigned xb_xcc_id() { return (unsigned)__builtin_amdgcn_s_getreg((3 << 11) | 20) & 0xFu; }
#define XB_SPIN(cond, bar) do { unsigned _sp = 0; while (cond) { __builtin_amdgcn_s_sleep(1); \
    if ((++_sp & 255u) == 0u) { if (xb_ld(&(bar)[XB_TMO])) break; if (_sp > XB_SPIN_CAP) { atomicAdd(&(bar)[XB_TMO], 1u); break; } } } } while (0)
struct XcdBarrier { unsigned* bar; unsigned x; volatile LAS unsigned* st; };
__device__ __forceinline__ XcdBarrier xcd_barrier_post(unsigned* bar, volatile LAS unsigned* st) {
    XcdBarrier b; b.bar = bar; b.x = xb_xcc_id(); b.st = st;
    if (threadIdx.x == 0) (void)xb_add(&bar[XB_XCNT(b.x)], 1u);
    return b;
}
__device__ __forceinline__ void xcd_barrier_complete(unsigned* bar, unsigned x, unsigned& nloc, unsigned& nx) {
    const unsigned G = gridDim.x * gridDim.y * gridDim.z;
    unsigned sum, cnt, mine, sp = 0u;
    for (;;) {
        sum = 0u; cnt = 0u; mine = 0u;
#pragma unroll
        for (unsigned j = 0; j < 16; ++j) { const unsigned c = xb_ld(&bar[XB_XCNT(j)]); sum += c; cnt += (c > 0u) ? 1u : 0u; mine = (j == x) ? c : mine; }
        if (sum == G) break;
        __builtin_amdgcn_s_sleep(1);
        if ((++sp & 255u) == 0u) { if (xb_ld(&bar[XB_TMO])) break; if (sp > XB_SPIN_CAP) { atomicAdd(&bar[XB_TMO], 1u); break; } }
    }
    nloc = mine > 0u ? mine : 1u; nx = cnt > 0u ? cnt : 1u;
}
__device__ __forceinline__ void xcd_barrier(const XcdBarrier& b) {
    asm volatile("s_waitcnt vmcnt(0)" ::: "memory");
    __syncthreads();
    if (threadIdx.x == 0) {
        unsigned* bar = b.bar;
        __builtin_amdgcn_s_waitcnt(0);
        unsigned nloc = b.st[0], nx = b.st[1];
        if (nloc == 0u) { xcd_barrier_complete(bar, b.x, nloc, nx); b.st[0] = nloc; b.st[1] = nx; }
        const unsigned old = xb_add(&bar[XB_XSUB(b.x)], 1u);
        const unsigned gen = old / nloc;
        if (old + 1u == (gen + 1u) * nloc) {
            __builtin_amdgcn_fence(__ATOMIC_RELEASE, "agent");
            asm volatile("s_waitcnt vmcnt(0)" ::: "memory");
            const unsigned og = xb_add(&bar[XB_TOP], 1u);
            const unsigned tg = og / nx;
            if (og + 1u == (tg + 1u) * nx) xb_add(&bar[XB_TOPGEN], 1u);
            else XB_SPIN(xb_ld(&bar[XB_TOPGEN]) == tg, bar);
            __builtin_amdgcn_fence(__ATOMIC_ACQUIRE, "agent");
            xb_add(&bar[XB_XGEN(b.x)], 1u);
            asm volatile("s_waitcnt vmcnt(0)" ::: "memory");
        } else {
            XB_SPIN(xb_ld(&bar[XB_XGEN(b.x)]) == gen, bar);
            __builtin_amdgcn_fence(__ATOMIC_ACQUIRE, "agent");
            asm volatile("s_waitcnt vmcnt(0)" ::: "memory");
        }
    }
    __syncthreads();
}

struct TileOrder : pg8::StaticOrder {
    bool skip;
    __device__ void init2(int N, int G_, int c_, bool skip_) { skip = skip_; init(skip_ ? NB * SEQ : R, N, G_, c_); }
    __device__ bool next(int i, pg8::Unit& u) const { if (!pg8::StaticOrder::next(i, u)) return false; if (skip) u.pm += u.pm >> 4; return true; }
};
__device__ __forceinline__ unsigned cvt_pk2(float lo, float hi) { unsigned r; asm volatile("v_cvt_pk_bf16_f32 %0, %1, %2" : "=v"(r) : "v"(lo), "v"(hi)); return r; }
template <bool MAKE_H>
struct EpiResGate {
    static constexpr bool PERM = false, AFTER_DRAIN = false;
    float* X; const float* mod_l; int jg; bf16* H; const float* gs; float* rs;
    const float* xin; const float* cin;
    __device__ __forceinline__ void operator()(const pg8::f32x4 (&acc)[2][2][4][2], const pg8::Unit& u, int wr, int wc, int fr, int fq) const {
        const int b = u.pm / 17, jt = u.pm - b * 17, mrow = (jt == 16 ? 4 : b);
        const float* gp = mod_l + (size_t)mrow * NMODC + (size_t)jg * DM;
        const float* gsp = gs + (size_t)mrow * DM;
        const int col0 = u.pn * 256 + wc * 32 + 4 * fq;
        pg8::f32x4 gv[2][2];
#pragma unroll
        for (int bj = 0; bj < 2; ++bj)
#pragma unroll
            for (int n = 0; n < 2; ++n) gv[bj][n] = *(const pg8::f32x4*)(gp + col0 + bj * 128 + n * 16);
#pragma unroll
        for (int ai = 0; ai < 2; ++ai)
#pragma unroll
            for (int m = 0; m < 4; ++m) { const int row = u.pm * 256 + ai * 128 + wr * 64 + m * 16 + fr; const size_t off = (size_t)row * DM + col0; float ss = 0.f;
                const float* src = xin ? (jt == 16 ? cin + ((size_t)b * CTXL + (row - u.pm * 256)) * DM : xin + ((size_t)b * SEQ + jt * 256 + (row - u.pm * 256)) * DM) + col0 : X + off;
#pragma unroll
                for (int bj = 0; bj < 2; ++bj)
#pragma unroll
                    for (int n = 0; n < 2; ++n) { pg8::f32x4* p = (pg8::f32x4*)(X + off + bj * 128 + n * 16); const pg8::f32x4 xn = *(const pg8::f32x4*)(src + bj * 128 + n * 16) + gv[bj][n] * acc[ai][bj][m][n]; *p = xn;
                        if (MAKE_H) { ss += (xn[0] * xn[0] + xn[1] * xn[1]) + (xn[2] * xn[2] + xn[3] * xn[3]);
                            const pg8::f32x4 hv = xn * *(const pg8::f32x4*)(gsp + col0 + bj * 128 + n * 16);
                            v2u w; w.x = cvt_pk2(hv[0], hv[1]); w.y = cvt_pk2(hv[2], hv[3]); *(v2u*)(H + off + bj * 128 + n * 16) = w; } }
                if (MAKE_H) { ss += __shfl_xor(ss, 16); ss += __shfl_xor(ss, 32); if (fq == 0) unsafeAtomicAdd(rs + row, ss); }
                if (m & 1) asm volatile("" ::: "memory"); }
    }
};
struct EpiBf16N {
    static constexpr bool PERM = true, AFTER_DRAIN = false;
    bf16* O; int ldc; const float* rs; const float* sw;
    __device__ __forceinline__ void operator()(const pg8::f32x4 (&acc)[2][2][4][2], const pg8::Unit& u, int wr, int wc, int fr, int fq) const {
        const int b = u.pm / 17, jt = u.pm - b * 17, mrow = (jt == 16 ? 4 : b);
        const int row0 = u.pm * 256 + wr * 64 + fr, col0 = u.pn * 256 + wc * 32 + 8 * fq;
        const float* swp = sw + (size_t)mrow * ldc + col0;
        pg8::f32x4 bv[2][2];
#pragma unroll
        for (int bj = 0; bj < 2; ++bj)
#pragma unroll
            for (int n = 0; n < 2; ++n) bv[bj][n] = *(const pg8::f32x4*)(swp + bj * 128 + 4 * n);
#pragma unroll
        for (int ai = 0; ai < 2; ++ai)
#pragma unroll
            for (int m = 0; m < 4; ++m) { const int row = row0 + ai * 128 + m * 16; const float rstd = 1.0f / sqrtf(rs[row] * (1.f / DM) + EPS);
                bf16* rowp = O + (size_t)row * ldc + col0;
#pragma unroll
                for (int bj = 0; bj < 2; ++bj) { const pg8::f32x4 v0 = acc[ai][bj][m][0] * rstd + bv[bj][0], v1 = acc[ai][bj][m][1] * rstd + bv[bj][1];
                    pg8::u32x4 w; w.x = cvt_pk2(v0[0], v0[1]); w.y = cvt_pk2(v0[2], v0[3]); w.z = cvt_pk2(v1[0], v1[1]); w.w = cvt_pk2(v1[2], v1[3]);
                    *(pg8::u32x4*)(rowp + bj * 128) = w; } }
    }
};

namespace att {
using bf16x8 = __attribute__((ext_vector_type(8))) short;
using s16x4  = __attribute__((ext_vector_type(4))) short;
using f32x16 = __attribute__((ext_vector_type(16))) float;
using u32x4  = __attribute__((ext_vector_type(4))) unsigned;
constexpr int   D = 128, NW = 8, QBLK = 32, KVBLK = 64;
constexpr float SCALE = 0.088388347648318440f;
constexpr float THR = 8.f;
constexpr int LDQ = 1024, LDK = 256, LDV = INC, LDO = DM;
constexpr size_t SHM_V = KVBLK * D * 2, SHM_K = KVBLK * D * 2, SHM_ATTN = 2 * SHM_V + 2 * SHM_K + NW * 64 * 4;
#define KSWZ(row, colB) ((row) * 256 + ((colB) ^ (((row) & 7) << 4)))
#define SBAR() __builtin_amdgcn_sched_barrier(0)
__device__ __forceinline__ int crow(int r, int hi) { return (r & 3) + 8 * (r >> 2) + 4 * hi; }
__device__ __forceinline__ unsigned cvtpk(float lo, float hi) { unsigned r; asm volatile("v_cvt_pk_bf16_f32 %0, %1, %2" : "=v"(r) : "v"(lo), "v"(hi)); return r; }
__device__ __forceinline__ void partialSM(f32x16& p0, f32x16& p1, float& m_reg, float& mn, float& alpha) {
  constexpr float C = SCALE * 1.4426950408889634f;
  float pmax = p0[0]; for (int r = 1; r < 16; ++r) pmax = fmaxf(pmax, p0[r]); for (int r = 0; r < 16; ++r) pmax = fmaxf(pmax, p1[r]);
  { auto rr = __builtin_amdgcn_permlane32_swap(__float_as_uint(pmax), __float_as_uint(pmax), false, false);
    pmax = fmaxf(__uint_as_float(rr[0]), __uint_as_float(rr[1])); }
  if (__builtin_expect(__all(pmax - m_reg <= THR / SCALE), 1)) { mn = m_reg; alpha = 1.f; }
  else { mn = fmaxf(m_reg, pmax); alpha = __builtin_amdgcn_exp2f((m_reg - mn) * C); m_reg = mn; }
  float mnC = -mn * C;
  for (int r = 0; r < 16; ++r) p0[r] = fmaf(p0[r], C, mnC); for (int r = 0; r < 16; ++r) p1[r] = fmaf(p1[r], C, mnC);
  for (int r = 0; r < 16; ++r) p0[r] = __builtin_amdgcn_exp2f(p0[r]);
}
__device__ __forceinline__ void finishSM(f32x16& p0, f32x16& p1, float alpha, float& l_reg, bf16x8& pa0, bf16x8& pa1, bf16x8& pa2, bf16x8& pa3) {
  for (int r = 0; r < 16; ++r) p1[r] = __builtin_amdgcn_exp2f(p1[r]);
  float ps = 0; for (int r = 0; r < 16; ++r) ps += p0[r]; for (int r = 0; r < 16; ++r) ps += p1[r];
  { auto rr = __builtin_amdgcn_permlane32_swap(__float_as_uint(ps), __float_as_uint(ps), false, false);
    ps = __uint_as_float(rr[0]) + __uint_as_float(rr[1]); }
  l_reg = l_reg * alpha + ps;
#define PK4(P, BASE, OUT) do { unsigned a0 = cvtpk(P[BASE + 0], P[BASE + 1]), a1 = cvtpk(P[BASE + 2], P[BASE + 3]);   \
    unsigned b0 = cvtpk(P[BASE + 4], P[BASE + 5]), b1 = cvtpk(P[BASE + 6], P[BASE + 7]);                              \
    auto r0 = __builtin_amdgcn_permlane32_swap(a0, b0, false, false); auto r1 = __builtin_amdgcn_permlane32_swap(a1, b1, false, false); \
    u32x4 w = {r0[0], r1[0], r0[1], r1[1]}; OUT = *reinterpret_cast<bf16x8*>(&w); } while (0)
  PK4(p0, 0, pa0); PK4(p0, 8, pa1); PK4(p1, 0, pa2); PK4(p1, 8, pa3);
#undef PK4
}
__device__ __forceinline__ void qkt(f32x16& p0, f32x16& p1, const bf16* Ks, const bf16x8* qr, int r32, int hi) {
  p0 = f32x16{}; p1 = f32x16{};
  for (int d0 = 0; d0 < 8; ++d0) { int cb = (d0 * 16 + hi * 8) * 2;
    bf16x8 b0 = *reinterpret_cast<const bf16x8*>((const char*)Ks + KSWZ(r32, cb));
    bf16x8 b1 = *reinterpret_cast<const bf16x8*>((const char*)Ks + KSWZ(32 + r32, cb));
    p0 = __builtin_amdgcn_mfma_f32_32x32x16_bf16(b0, qr[d0], p0, 0, 0, 0);
    p1 = __builtin_amdgcn_mfma_f32_32x32x16_bf16(b1, qr[d0], p1, 0, 0, 0); }
}
__device__ __forceinline__ int v_st(int k, int c) { const int kk = (k & ~0xC) | ((k & 4) << 1) | ((k & 8) >> 1); return ((kk >> 3) * 4 + (c >> 5)) * 512 + ((kk & 7) * 32 + (c & 31)) * 2; }
__device__ __forceinline__ int v_rd_base(int lane) { return ((lane & 3) << 3) | (((lane >> 2) & 3) << 6) | (((lane >> 4) & 1) << 5) | (((lane >> 5) & 1) << 8); }
constexpr int v_rd_off(int d0, int ks, int half) { return d0 * 512 + ks * 4096 + half * 2048; }
template <int OFF> __device__ __forceinline__ s16x4 tr_read(int vb) {
  s16x4 r; asm volatile("ds_read_b64_tr_b16 %0, %1 offset:%2" : "=&v"(r) : "v"(vb), "i"(OFF) : "memory"); return r;
}
template <int D0> __device__ __forceinline__ void pv_one(f32x16& od, int vb, bf16x8 pa0, bf16x8 pa1, bf16x8 pa2, bf16x8 pa3) {
  const s16x4 l0 = tr_read<v_rd_off(D0, 0, 0)>(vb), h0 = tr_read<v_rd_off(D0, 0, 1)>(vb), l1 = tr_read<v_rd_off(D0, 1, 0)>(vb), h1 = tr_read<v_rd_off(D0, 1, 1)>(vb);
  const s16x4 l2 = tr_read<v_rd_off(D0, 2, 0)>(vb), h2 = tr_read<v_rd_off(D0, 2, 1)>(vb), l3 = tr_read<v_rd_off(D0, 3, 0)>(vb), h3 = tr_read<v_rd_off(D0, 3, 1)>(vb);
  asm volatile("s_waitcnt lgkmcnt(0)" ::: "memory"); SBAR();
#define PK(L, H) (bf16x8){L[0], L[1], L[2], L[3], H[0], H[1], H[2], H[3]}
  od = __builtin_amdgcn_mfma_f32_32x32x16_bf16(pa0, PK(l0, h0), od, 0, 0, 0);
  od = __builtin_amdgcn_mfma_f32_32x32x16_bf16(pa1, PK(l1, h1), od, 0, 0, 0);
  od = __builtin_amdgcn_mfma_f32_32x32x16_bf16(pa2, PK(l2, h2), od, 0, 0, 0);
  od = __builtin_amdgcn_mfma_f32_32x32x16_bf16(pa3, PK(l3, h3), od, 0, 0, 0);
#undef PK
}
__device__ __forceinline__ void pv_d0(f32x16* o, int vb, bf16x8 pa0, bf16x8 pa1, bf16x8 pa2, bf16x8 pa3) {
  pv_one<0>(o[0], vb, pa0, pa1, pa2, pa3); pv_one<1>(o[1], vb, pa0, pa1, pa2, pa3); pv_one<2>(o[2], vb, pa0, pa1, pa2, pa3); pv_one<3>(o[3], vb, pa0, pa1, pa2, pa3);
}
__device__ __forceinline__ void attn_dense_body(const bf16* __restrict__ Qb, const bf16* __restrict__ Kh, const bf16* __restrict__ Vh,
                                                bf16* __restrict__ Ob, int seq, char* lds) {
  int tid_l = threadIdx.x; asm volatile("" : "+v"(tid_l)); const int tid = tid_l, wid = tid >> 6, lane = tid & 63, r32 = lane & 31, hi = lane >> 5;
  bf16* V_lds = (bf16*)lds; bf16* K_lds = (bf16*)(lds + 2 * SHM_V);
  float* ws = (float*)(lds + 2 * SHM_V + 2 * SHM_K) + wid * 64; float* li_l = ws; float* al_l = ws + 32;
  float m_reg = -1e30f, l_reg = 0; f32x16 o[4] = {}; bf16x8 qr[8];
  const bf16* Qw = Qb + (long)(wid * QBLK + r32) * LDQ + hi * 8;
#pragma unroll
  for (int d0 = 0; d0 < 8; ++d0) qr[d0] = *reinterpret_cast<const bf16x8*>(Qw + d0 * 16);
  const int sr = tid >> 4, sc = (tid & 15) * 8, vst0 = v_st(sr, sc), vst1 = v_st(32 + sr, sc);
  const int vb0 = (int)(uintptr_t)V_lds + v_rd_base(lane);
  struct { bf16x8 vs0, vs1, ks0, ks1; } sr_[2];
#define SLOAD(i, k0) do { sr_[i].vs0 = *reinterpret_cast<const bf16x8*>(&Vh[(long)((k0) + sr) * LDV + sc]); sr_[i].vs1 = *reinterpret_cast<const bf16x8*>(&Vh[(long)((k0) + 32 + sr) * LDV + sc]); \
    sr_[i].ks0 = *reinterpret_cast<const bf16x8*>(&Kh[(long)((k0) + sr) * LDK + sc]); sr_[i].ks1 = *reinterpret_cast<const bf16x8*>(&Kh[(long)((k0) + 32 + sr) * LDK + sc]); } while (0)
#define SWRITE(b, i) do { *(bf16x8*)((char*)V_lds + (b) * SHM_V + vst0) = sr_[i].vs0;          \
    *(bf16x8*)((char*)V_lds + (b) * SHM_V + vst1) = sr_[i].vs1; int kc = sc * 2;               \
    *(bf16x8*)((char*)K_lds + (b) * SHM_K + KSWZ(sr, kc)) = sr_[i].ks0;                       \
    *(bf16x8*)((char*)K_lds + (b) * SHM_K + KSWZ(32 + sr, kc)) = sr_[i].ks1; } while (0)
#define SWAIT() asm volatile("s_waitcnt vmcnt(4)" ::: "memory")
#define RESC(a) do { if (__any((a) < 1.f)) { if (hi == 0) al_l[r32] = (a); asm volatile("s_waitcnt lgkmcnt(0)" ::: "memory"); \
    for (int d = 0; d < 4; ++d) for (int r = 0; r < 16; ++r) o[d][r] *= al_l[crow(r, hi)]; } } while (0)
  f32x16 pA0, pA1, pB0, pB1; float mnA, mnB, alA, alB; bf16x8 pa0, pa1, pa2, pa3; const int NT = seq / KVBLK;
  constexpr int SE = 0, SO = 1;
  SLOAD(SE, 0); asm volatile("s_waitcnt vmcnt(0)" ::: "memory"); SWRITE(0, SE); __syncthreads();
  qkt(pA0, pA1, K_lds, qr, r32, hi); partialSM(pA0, pA1, m_reg, mnA, alA);
  SLOAD(SO, KVBLK); if (2 < NT) SLOAD(SE, 2 * KVBLK);
  SWAIT(); SWRITE(1, SO); __syncthreads();
  for (int j = 1; j + 1 < NT; j += 2) {
    SBAR(); qkt(pB0, pB1, (bf16*)((char*)K_lds + SHM_K), qr, r32, hi);
    finishSM(pA0, pA1, alA, l_reg, pa0, pa1, pa2, pa3); SBAR();
    SLOAD(SO, (j + 2) * KVBLK); SBAR();
    pv_d0(o, vb0, pa0, pa1, pa2, pa3); partialSM(pB0, pB1, m_reg, mnB, alB);
    __syncthreads(); SWAIT(); SWRITE(0, SE);
    RESC(alB); __syncthreads();
    SBAR(); qkt(pA0, pA1, K_lds, qr, r32, hi);
    finishSM(pB0, pB1, alB, l_reg, pa0, pa1, pa2, pa3); SBAR();
    if (j + 3 < NT) SLOAD(SE, (j + 3) * KVBLK); SBAR();
    pv_d0(o, vb0 + (int)SHM_V, pa0, pa1, pa2, pa3); partialSM(pA0, pA1, m_reg, mnA, alA);
    __syncthreads(); SWAIT(); SWRITE(1, SO);
    RESC(alA); __syncthreads();
  }
  SBAR(); qkt(pB0, pB1, (bf16*)((char*)K_lds + SHM_K), qr, r32, hi);
  finishSM(pA0, pA1, alA, l_reg, pa0, pa1, pa2, pa3); SBAR();
  pv_d0(o, vb0, pa0, pa1, pa2, pa3); partialSM(pB0, pB1, m_reg, mnB, alB);
  __syncthreads(); RESC(alB);
  finishSM(pB0, pB1, alB, l_reg, pa0, pa1, pa2, pa3); SBAR();
  pv_d0(o, vb0 + (int)SHM_V, pa0, pa1, pa2, pa3);
  if (hi == 0) li_l[r32] = l_reg; asm volatile("s_waitcnt lgkmcnt(0)" ::: "memory");
  float rli[16];
#pragma unroll
  for (int r = 0; r < 16; ++r) rli[r] = __builtin_amdgcn_rcpf(li_l[crow(r, hi)]);
  bf16* Ow = Ob + (long)(wid * QBLK) * LDO;
#pragma unroll
  for (int r = 0; r < 16; ++r) { int orow = crow(r, hi);
    for (int d0 = 0; d0 < 4; ++d0) Ow[(long)orow * LDO + d0 * 32 + r32] = (bf16)f2bf(o[d0][r] * rli[r]); }
  __syncthreads();
#undef SLOAD
#undef SWRITE
#undef SWAIT
#undef RESC
}
}

struct Args { const float* in[22]; float* out; unsigned char* ws; int ph_lo, ph_hi; };
enum { I_X = 0, I_C, I_CTX, I_CCTX, I_WADA, I_BADA, I_N1G, I_WIN, I_QG, I_KG, I_LBP, I_HGG, I_SGG, I_SGW, I_SGB, I_WOUT, I_N2G, I_WUP, I_CW, I_CB, I_WDN, I_FNG };

__device__ __forceinline__ void p0_mod(const float* cin, const float* ccin, const float* wada, const float* bada, LAS unsigned char* lds, float* MOD, int tid, int lane, int wave, int bx, int G) {
    LAS float* sc = (LAS float*)lds;
    LAS float* red = (LAS float*)(lds + 40960);
    for (int i = tid; i < 5 * DM; i += NTHR) { const int r = i >> 11, k = i & 2047; const float v = r < 4 ? cin[r * DM + k] : ccin[k]; sc[i] = silu_f(v); }
    __syncthreads();
    for (int it = bx; it < 768; it += G) {
        const int cb = it >> 2, kq = it & 3, l = cb / 48, n0 = (cb % 48) * 256, kbase = 512 * kq + 64 * wave;
        const float* wp = wada + ((size_t)l * DM + kbase) * NMODC + n0 + 4 * lane;
        v4f acc[5];
#pragma unroll
        for (int r = 0; r < 5; ++r) acc[r] = (v4f){0.f, 0.f, 0.f, 0.f};
#pragma unroll 16
        for (int k = 0; k < 64; ++k) {
            const v4f w = *(const v4f*)(wp + (size_t)k * NMODC);
#pragma unroll
            for (int r = 0; r < 5; ++r) { const float s = sc[r * DM + kbase + k]; acc[r] += w * s; }
        }
#pragma unroll
        for (int r = 0; r < 5; ++r) *(LAS v4f*)(red + (wave * 5 + r) * 256 + 4 * lane) = acc[r];
        __syncthreads();
        for (int o = tid; o < 1280; o += NTHR) { const int r = o >> 8, ci = o & 255; float s = (kq == 0) ? bada[l * NMODC + n0 + ci] : 0.f;
#pragma unroll
            for (int w = 0; w < 8; ++w) s += red[(w * 5 + r) * 256 + ci];
            unsafeAtomicAdd(MOD + (size_t)(l * 5 + r) * NMODC + n0 + ci, s); }
        __syncthreads();
    }
}
template <bool SWACC>
__device__ __forceinline__ void p0_transpose_item(const float* W, int K, int N, bf16* WT, LAS float* scr, int item, int lane, float* sw, const float* sh) {
    const int nblk = N / 32, kb = item / nblk, nb = item % nblk, k0 = 64 * kb, n0 = 32 * nb;
#pragma unroll 8
    for (int i = 0; i < 32; ++i) { const int kk = 2 * i + (lane >> 5); scr[kk * 33 + (lane & 31)] = W[(size_t)(k0 + kk) * N + n0 + (lane & 31)]; }
    LDS_WAIT(); asm volatile("" ::: "memory");
    const int c = lane & 7;
#pragma unroll
    for (int j = 0; j < 4; ++j) { const int n = (lane >> 3) + 8 * j; const LAS float* s = scr + (8 * c) * 33 + n;
        v4u o; o.x = pk2(s[0 * 33], s[1 * 33]); o.y = pk2(s[2 * 33], s[3 * 33]); o.z = pk2(s[4 * 33], s[5 * 33]); o.w = pk2(s[6 * 33], s[7 * 33]);
        *(GAS v4u*)(WT + (size_t)(n0 + n) * K + k0 + 8 * c) = o; }
    if (SWACC) {
        const int n = lane & 31, kh = lane >> 5; float s5[5] = {0.f, 0.f, 0.f, 0.f, 0.f};
        const float* shp = sh + k0 + 32 * kh; const LAS float* tp = scr + (32 * kh) * 33 + n;
#pragma unroll
        for (int q = 0; q < 8; ++q) { const float w0 = tp[(4 * q) * 33], w1 = tp[(4 * q + 1) * 33], w2 = tp[(4 * q + 2) * 33], w3 = tp[(4 * q + 3) * 33];
#pragma unroll
            for (int r = 0; r < 5; ++r) { const v4f s = *(const v4f*)(shp + (size_t)r * NMODC + 4 * q); s5[r] += (s.x * w0 + s.y * w1) + (s.z * w2 + s.w * w3); } }
#pragma unroll
        for (int r = 0; r < 5; ++r) { s5[r] += __shfl_xor(s5[r], 32); if (lane < 32) unsafeAtomicAdd(sw + (size_t)r * N + n0 + n, s5[r]); }
    }
    LDS_WAIT(); asm volatile("" ::: "memory");
}
constexpr int CI_IN = (DM / 64) * (INC / 32), CI_OUT = (DM / 64) * (DM / 32), CI_UP = (DM / 64) * (UPC / 32), CI_DN = (DFF / 64) * (DM / 32);
template <int SEL>
__device__ __forceinline__ void convert_item(int l, int r, kptr_t kp, unsigned char* ws, LAS float* scr, int lane);
template <int SEL> constexpr int convert_count() { return ((SEL & 1) ? CI_IN : 0) + ((SEL & 2) ? CI_OUT : 0) + ((SEL & 4) ? CI_UP : 0) + ((SEL & 8) ? CI_DN : 0); }
__device__ __forceinline__ void norm_phase(const float* X, bf16* H, const float* g, const float* mod_l, int jshift, int jscale, bool skip_ctx, int gw, int NGW, int lane) {
    for (int m = gw; m < R; m += NGW) {
        const int b = m / TB, t = m - b * TB; const bool isc = t >= SEQ; if (isc && skip_ctx) continue;
        const float* mrow = mod_l + (size_t)(isc ? 4 : b) * NMODC;
        const v4f* xr = (const v4f*)(X + (size_t)m * DM) + lane;
        v4f v[8]; float ss = 0.f;
#pragma unroll
        for (int j = 0; j < 8; ++j) { v[j] = xr[64 * j]; ss += (v[j].x * v[j].x + v[j].y * v[j].y) + (v[j].z * v[j].z + v[j].w * v[j].w); }
        const float rstd = 1.0f / sqrtf(wave_sum(ss) * (1.f / DM) + EPS);
#pragma unroll
        for (int j = 0; j < 8; ++j) { const int c = 4 * lane + 256 * j;
            const v4f gg = *(const v4f*)(g + c), sh = *(const v4f*)(mrow + jshift * DM + c), sc = *(const v4f*)(mrow + jscale * DM + c);
            const v4f y = v[j] * rstd * gg * (1.f + sc) + sh;
            v2u w; w.x = pk2(y.x, y.y); w.y = pk2(y.z, y.w);
            *(v2u*)(H + (size_t)m * DM + c) = w; }
    }
}
__device__ __forceinline__ void qknorm_phase(const bf16* PROJ, bf16* QN, bf16* KN, const float* qg, const float* kg, const float* rcos, const float* rsin, int gw, int NGW, int lane) {
    const float qg0 = qg[2 * lane], qg1 = qg[2 * lane + 1], kg0 = kg[2 * lane], kg1 = kg[2 * lane + 1];
#pragma unroll 1
    for (int m0 = 4 * gw; m0 < R; m0 += 4 * NGW) {
        unsigned w2[4][10];
#pragma unroll
        for (int rr = 0; rr < 4; ++rr)
#pragma unroll
            for (int hh = 0; hh < 10; ++hh) w2[rr][hh] = *(const unsigned*)(PROJ + (size_t)(m0 + rr) * INC + hh * 128 + 2 * lane);
#pragma unroll
        for (int rr = 0; rr < 4; ++rr) {
            const int m = m0 + rr, b = m / TB, t = m - b * TB; const bool lat = t < SEQ;
            float cs = 1.f, sn = 0.f;
            if (lat) { const int pos = (lane < 32) ? (t >> 6) : (t & 63); cs = rcos[pos * 32 + (lane & 31)]; sn = rsin[pos * 32 + (lane & 31)]; }
#pragma unroll
            for (int hh = 0; hh < 10; ++hh) {
                const float x1 = bf2f(w2[rr][hh] & 0xffffu), x2 = bf2f(w2[rr][hh] >> 16);
                const float rstd = __builtin_amdgcn_rsqf(wave_sum(x1 * x1 + x2 * x2) * (1.f / 128.f) + EPS);
                const float y1 = x1 * rstd * (hh < 8 ? qg0 : kg0), y2 = x2 * rstd * (hh < 8 ? qg1 : kg1);
                const float o1 = y1 * cs - y2 * sn, o2 = y1 * sn + y2 * cs;
                bf16* dst = hh < 8 ? QN + (size_t)m * 1024 + hh * 128 + 2 * lane : KN + (size_t)m * 256 + (hh - 8) * 128 + 2 * lane;
                *(unsigned*)dst = cvtpk_rne(o1, o2);
            }
        }
    }
}
typedef short hbf16x8 __attribute__((ext_vector_type(8)));
__device__ __forceinline__ v4f mfma_bf(v4u a, v4u b, v4f c) { return __builtin_amdgcn_mfma_f32_16x16x32_bf16(__builtin_bit_cast(hbf16x8, a), __builtin_bit_cast(hbf16x8, b), c, 0, 0, 0); }
__device__ __forceinline__ unsigned cvtpk_hw(float lo, float hi) { unsigned r; asm volatile("v_cvt_pk_bf16_f32 %0, %1, %2" : "=v"(r) : "v"(lo), "v"(hi)); return r; }
constexpr int SG_PB = 272;
__device__ __forceinline__ void sg_unit(int b, int n, int g, int l, const bf16* PROJ, bf16* MIX, const float* sgg, const float* sgw, const float* sgb, LAS unsigned char* Vt, int tid, int lane, int wave) {
    const int row0 = b * TB + n * 128, c4 = lane >> 4, l15 = lane & 15;
    v4u wf[4];
    {   const float* W = sgw + ((size_t)(l * 4 + g) * 128 + 16 * wave + l15) * 128 + 8 * c4;
#pragma unroll
        for (int ks = 0; ks < 4; ++ks) { const v4f a0 = *(const v4f*)(W + 32 * ks), a1 = *(const v4f*)(W + 32 * ks + 4);
            wf[ks].x = cvtpk_hw(a0.x, a0.y); wf[ks].y = cvtpk_hw(a0.z, a0.w); wf[ks].z = cvtpk_hw(a1.x, a1.y); wf[ks].w = cvtpk_hw(a1.z, a1.w); } }
    const size_t orow = (size_t)(row0 + 16 * wave + l15);
    v2u uraw[8];
#pragma unroll
    for (int dt = 0; dt < 8; ++dt) uraw[dt] = *(const v2u*)(PROJ + orow * INC + C_SU + g * 128 + 16 * dt + 4 * c4);
    const float bsv = sgb[(l * 4 + g) * 128 + 16 * wave + l15];
    {
        const int s = tid >> 2, q = tid & 3;
        const v4u* src = (const v4u*)(PROJ + (size_t)(row0 + s) * INC + C_SV + g * 128 + 32 * q);
        float ge[32]; float ss = 0.f;
#pragma unroll
        for (int i = 0; i < 4; ++i) { const v4u w = src[i];
#pragma unroll
            for (int e = 0; e < 4; ++e) { const float a0 = gelu_tanh(bf2f(w[e] & 0xffffu)), a1 = gelu_tanh(bf2f(w[e] >> 16)); ge[8 * i + 2 * e] = a0; ge[8 * i + 2 * e + 1] = a1; ss += a0 * a0 + a1 * a1; } }
        ss += __shfl_xor(ss, 1); ss += __shfl_xor(ss, 2);
        const float rstd = 1.0f / sqrtf(ss * (1.f / 128.f) + EPS);
        const float* gp = sgg + g * 128 + 32 * q;
#pragma unroll
        for (int i = 0; i < 32; ++i) *(LAS bf16*)(Vt + (32 * q + i) * SG_PB + 2 * s) = (bf16)(cvtpk_hw(ge[i] * rstd * gp[i], 0.f) & 0xffffu);
    }
    __syncthreads();
#pragma unroll
    for (int dt = 0; dt < 8; ++dt) {
        v4f acc = (v4f){0.f, 0.f, 0.f, 0.f};
#pragma unroll
        for (int ks = 0; ks < 4; ++ks) acc = mfma_bf(*(const LAS v4u*)(Vt + (16 * dt + l15) * SG_PB + (32 * ks + 8 * c4) * 2), wf[ks], acc);
        const float u0 = gelu_tanh(bf2f(uraw[dt].x & 0xffffu)), u1 = gelu_tanh(bf2f(uraw[dt].x >> 16)), u2 = gelu_tanh(bf2f(uraw[dt].y & 0xffffu)), u3 = gelu_tanh(bf2f(uraw[dt].y >> 16));
        v2u o; o.x = cvtpk_hw(u0 * (acc[0] + bsv), u1 * (acc[1] + bsv)); o.y = cvtpk_hw(u2 * (acc[2] + bsv), u3 * (acc[3] + bsv));
        *(v2u*)(MIX + orow * DM + 1536 + g * 128 + 16 * dt + 4 * c4) = o;
    }
    __syncthreads();
}

__device__ __forceinline__ int hg_row(int b, int dir, int P) {
    if (P < CTXL) return b * TB + SEQ + (dir ? CTXL - 1 - P : P);
    const int t = P - CTXL; return b * TB + (dir ? SEQ - 1 - t : t);
}
constexpr int NCH = 136, SCH = 17, NSC = NCH / SCH;
constexpr size_t WS_QF = 966 * MiB, WS_KF = 1000 * MiB, WS_VF = 1034 * MiB, WS_PF = 1068 * MiB, WS_DF = 1077 * MiB;
static_assert(WS_DF + (size_t)32 * NCH * 512 <= WS_GS, "fragment buffers inside the mixer-half scratch");
constexpr int PL_T = 0, PL_QF = 4096, PL_KF = PL_QF + 8192, PL_VF = PL_KF + 8192, PL_PF = PL_VF + 8192, PL_QP = PL_PF + 2048, PL_KP1 = PL_QP + 8704, PL_KP0 = PL_KP1 + 8704;

__device__ __forceinline__ unsigned bf1(float x) { return cvtpk_hw(x, 0.f) & 0xffffu; }
__device__ __forceinline__ void hgrn_pre(int l, const bf16* PROJ, const float* LBS, unsigned char* QF, unsigned char* KF, unsigned char* VF, unsigned char* PF, float* DF,
                                         LAS unsigned char* L, int bx, int G, int tid, int lane, int wave) {
    const int kp = lane, jj = wave, c4 = lane >> 4, l15 = lane & 15;
    constexpr float LOG2E = 1.4426950408889634f, CLAMP2 = 115.f;
    LAS v2f* T = (LAS v2f*)(L + PL_T);
    unsigned zr[4], qr[4], vr[4];
#define PRE_LOAD(it_) do { const int ch_ = (it_) / NCH, ci_ = (it_) - ch_ * NCH, dir_ = ch_ & 1, bh_ = ch_ >> 1, h_ = bh_ & 3; \
        const bf16* pr_ = PROJ + (size_t)hg_row(bh_ >> 2, dir_, 32 * ci_ + 4 * jj) * INC + h_ * 128 + 2 * kp; const long st_ = dir_ ? -(long)INC : (long)INC; const int cf_ = dir_ ? C_HFB : C_HFF; \
        _Pragma("unroll") for (int i = 0; i < 4; ++i) { zr[i] = *(const unsigned*)(pr_ + cf_); qr[i] = *(const unsigned*)(pr_ + C_HQ); vr[i] = *(const unsigned*)(pr_ + C_HI); pr_ += st_; } } while (0)
    if (bx < 32 * NCH) PRE_LOAD(bx);
#pragma unroll 1
    for (int it = bx; it < 32 * NCH; it += G) {
        const int chain = it / NCH;
        const int dir = chain & 1, h = (chain >> 1) & 3;
        const v2f lb2 = *(const v2f*)(LBS + (dir * DEPTH + l) * 512 + h * 128 + 2 * kp);
        float cs[2][4], kk[2][4], qq[2][4];
#pragma unroll
        for (int i = 0; i < 4; ++i)
#pragma unroll
            for (int e = 0; e < 2; ++e) {
                float z = bf2f(e ? zr[i] >> 16 : zr[i] & 0xffffu); z = fminf(fmaxf(z, -40.f), 40.f);
                const float q = bf2f(e ? qr[i] >> 16 : qr[i] & 0xffffu);
                qq[e][i] = q * __builtin_amdgcn_rcpf(1.f + __builtin_amdgcn_exp2f(-q * LOG2E));
                const float lb = e ? lb2.y : lb2.x, oml = 1.f - lb;
                const float ez = __builtin_amdgcn_exp2f(-z * LOG2E), sg = __builtin_amdgcn_rcpf(1.f + ez);
                cs[e][i] = __builtin_amdgcn_logf(fmaxf(lb + oml * sg, 1e-30f)); kk[e][i] = oml * ez * sg;
            }
        v2u vfa, vfb;
        vfa.x = (vr[0] & 0xffffu) | (vr[1] << 16); vfa.y = (vr[2] & 0xffffu) | (vr[3] << 16);
        vfb.x = (vr[0] >> 16) | (vr[1] & 0xffff0000u); vfb.y = (vr[2] >> 16) | (vr[3] & 0xffff0000u);
        if (it + G < 32 * NCH) PRE_LOAD(it + G);
#pragma unroll
        for (int e = 0; e < 2; ++e)
#pragma unroll
            for (int i = 1; i < 4; ++i) cs[e][i] += cs[e][i - 1];
        T[jj * 64 + kp] = (v2f){cs[0][3], cs[1][3]};
        __syncthreads();
        v2f pre = (v2f){0.f, 0.f}, bend = pre, b15 = pre;
#pragma unroll
        for (int w = 0; w < 8; ++w) { const v2f t = T[w * 64 + kp]; bend += t; if (w < 4) b15 += t; if (w < jj) pre += t; }
        LAS unsigned char* qfp = L + PL_QF + (((jj >> 2) * 4 + (kp >> 4)) * 64 + ((kp >> 1) & 3) * 16 + 4 * (jj & 3)) * 16 + (4 * ((kp >> 3) & 1) + 2 * (kp & 1)) * 2;
        LAS unsigned char* qpp = L + PL_QP + (4 * jj) * 272 + 4 * kp;
        float kh[2][4];
#pragma unroll
        for (int i = 0; i < 4; ++i) {
            float qt[2], qp[2], kp1[2], kp0[2];
#pragma unroll
            for (int e = 0; e < 2; ++e) {
                const float bi = (e ? pre.y : pre.x) + cs[e][i], be = e ? bend.y : bend.x, bm = e ? b15.y : b15.x;
                qt[e] = qq[e][i] * __builtin_amdgcn_exp2f(bi);
                kh[e][i] = kk[e][i] * __builtin_amdgcn_exp2f(be - bi);
                qp[e] = (jj < 4) ? qt[e] : qq[e][i] * __builtin_amdgcn_exp2f(bi - bm);
                kp1[e] = kk[e][i] * __builtin_amdgcn_exp2f(fminf(bm - bi, CLAMP2));
                kp0[e] = (jj < 4) ? kk[e][i] * __builtin_amdgcn_exp2f(fminf(-bi, CLAMP2)) : 0.f;
            }
            *(LAS unsigned*)(qfp + i * 16) = cvtpk_hw(qt[0], qt[1]);
            *(LAS unsigned*)(qpp + i * 272) = cvtpk_hw(qp[0], qp[1]);
            *(LAS unsigned*)(qpp + (PL_KP1 - PL_QP) + i * 272) = cvtpk_hw(kp1[0], kp1[1]);
            if (jj < 4) *(LAS unsigned*)(qpp + (PL_KP0 - PL_QP) + i * 272) = cvtpk_hw(kp0[0], kp0[1]);
        }
        {
            const int ka = 2 * kp, fo = ((ka >> 4) * 64 + (jj >> 1) * 16 + (ka & 15)) * 16 + 8 * (jj & 1);
            v2u w0, w1; w0.x = cvtpk_hw(kh[0][0], kh[0][1]); w0.y = cvtpk_hw(kh[0][2], kh[0][3]); w1.x = cvtpk_hw(kh[1][0], kh[1][1]); w1.y = cvtpk_hw(kh[1][2], kh[1][3]);
            *(LAS v2u*)(L + PL_KF + fo) = w0; *(LAS v2u*)(L + PL_KF + fo + 16) = w1;
            *(LAS v2u*)(L + PL_VF + fo) = vfa; *(LAS v2u*)(L + PL_VF + fo + 16) = vfb; }
        if (jj == 0) *(v2f*)(DF + (size_t)it * 128 + 2 * kp) = (v2f){__builtin_amdgcn_exp2f(bend.x), __builtin_amdgcn_exp2f(bend.y)};
        __syncthreads();
        if (wave < 3) {
            const LAS unsigned char* qa = L + PL_QP + ((wave == 0 ? 0 : 16) + l15) * 272 + c4 * 16;
            const LAS unsigned char* kb = (wave == 0 ? L + PL_KP0 + l15 * 272 : L + PL_KP1 + ((wave == 2 ? 16 : 0) + l15) * 272) + c4 * 16;
            v4f p = (v4f){0.f, 0.f, 0.f, 0.f};
#pragma unroll
            for (int s = 0; s < 4; ++s) p = mfma_bf(*(const LAS v4u*)(qa + s * 64), *(const LAS v4u*)(kb + s * 64), p);
            const int mt = wave == 0 ? 0 : 1, sidx = (wave == 2 ? 16 : 0) + l15;
#pragma unroll
            for (int r = 0; r < 4; ++r) { const int tl = 4 * c4 + r; const float v = (wave == 1 || l15 <= tl) ? p[r] : 0.f;
                *(LAS bf16*)(L + PL_PF + (mt * 64 + (sidx >> 3) * 16 + tl) * 16 + (sidx & 7) * 2) = (bf16)bf1(v); }
        } else if (wave == 3) {
            if (lane < 32) { unsigned zz; asm volatile("v_mov_b32 %0, 0" : "=v"(zz)); *(LAS v4u*)(L + PL_PF + (32 + lane) * 16) = (v4u){zz, zz, zz, zz}; }
        }
        __syncthreads();
        *(v4u*)(QF + (size_t)it * 8192 + tid * 16) = *(const LAS v4u*)(L + PL_QF + tid * 16);
        *(v4u*)(KF + (size_t)it * 8192 + tid * 16) = *(const LAS v4u*)(L + PL_KF + tid * 16);
        *(v4u*)(VF + (size_t)it * 8192 + tid * 16) = *(const LAS v4u*)(L + PL_VF + tid * 16);
        if (tid < 128) *(v4u*)(PF + (size_t)it * 2048 + tid * 16) = *(const LAS v4u*)(L + PL_PF + tid * 16);
    }
#undef PRE_LOAD
    __syncthreads();
}
constexpr int HU_Q = 0, HU_K = 8192, HU_P = 16384, HU_D = 18432, HU_SLOT = 18944;
template <bool WITH_OUT>
__device__ __forceinline__ void hgrn_unit2(int chain, int sc, const unsigned char* QF, const unsigned char* KF, const unsigned char* VF, const unsigned char* PF, const float* DF,
                                           float* HS, float* HD, float* HO, LAS unsigned char* L, int tid, int lane, int wave) {
    const int dir = chain & 1, bh = chain >> 1, b = bh >> 2, h = bh & 3, c4 = lane >> 4, l15 = lane & 15;
    v4f acc[8], dprod[8];
    const size_t item0 = (size_t)chain * NCH + sc * SCH;
    v4u rq, rk, rp, rd;
#define HU_LOAD(it_) do { if (WITH_OUT) rq = *(const v4u*)(QF + (it_) * 8192 + tid * 16); rk = *(const v4u*)(KF + (it_) * 8192 + tid * 16); \
        if (WITH_OUT && tid < 128) rp = *(const v4u*)(PF + (it_) * 2048 + tid * 16); if (tid < 32) rd = *(const v4u*)((const unsigned char*)DF + (it_) * 512 + tid * 16); } while (0)
#define HU_WRITE(s_) do { LAS unsigned char* sl_ = L + (s_) * HU_SLOT; if (WITH_OUT) *(LAS v4u*)(sl_ + HU_Q + tid * 16) = rq; *(LAS v4u*)(sl_ + HU_K + tid * 16) = rk; \
        if (WITH_OUT && tid < 128) *(LAS v4u*)(sl_ + HU_P + tid * 16) = rp; if (tid < 32) *(LAS v4u*)(sl_ + HU_D + tid * 16) = rd; } while (0)
    HU_LOAD(item0);
    v4u vf = ((const v4u*)(VF + item0 * 8192))[wave * 64 + lane];
    if (WITH_OUT && sc > 0) {
        const float* slot = HS + (size_t)(chain * NSC + sc - 1) * 16384;
#pragma unroll
        for (int kt = 0; kt < 8; ++kt)
#pragma unroll
            for (int r = 0; r < 4; ++r) acc[kt][r] = slot[(16 * kt + 4 * c4 + r) * 128 + 16 * wave + l15];
    } else {
#pragma unroll
        for (int kt = 0; kt < 8; ++kt) acc[kt] = (v4f){0.f, 0.f, 0.f, 0.f};
    }
#pragma unroll
    for (int kt = 0; kt < 8; ++kt) dprod[kt] = (v4f){1.f, 1.f, 1.f, 1.f};
    HU_WRITE(0);
    __syncthreads();
#pragma unroll 1
    for (int step = 0; step < SCH; ++step) {
        const LAS unsigned char* sl = L + (step & 1) * HU_SLOT;
        v4u vfn = vf;
        if (step < SCH - 1) { HU_LOAD(item0 + step + 1); vfn = ((const v4u*)(VF + (item0 + step + 1) * 8192))[wave * 64 + lane]; }
        if (WITH_OUT) {
            v4u sb[4];
#pragma unroll
            for (int ks = 0; ks < 4; ++ks) { sb[ks].x = cvtpk_hw(acc[2 * ks][0], acc[2 * ks][1]); sb[ks].y = cvtpk_hw(acc[2 * ks][2], acc[2 * ks][3]);
                sb[ks].z = cvtpk_hw(acc[2 * ks + 1][0], acc[2 * ks + 1][1]); sb[ks].w = cvtpk_hw(acc[2 * ks + 1][2], acc[2 * ks + 1][3]); }
#pragma unroll
            for (int mt = 0; mt < 2; ++mt) {
                v4f o = (v4f){0.f, 0.f, 0.f, 0.f};
#pragma unroll
                for (int ks = 0; ks < 4; ++ks) o = mfma_bf(*(const LAS v4u*)(sl + HU_Q + ((mt * 4 + ks) * 64 + lane) * 16), sb[ks], o);
                o = mfma_bf(*(const LAS v4u*)(sl + HU_P + (mt * 64 + lane) * 16), vf, o);
#pragma unroll
                for (int r = 0; r < 4; ++r) { const int row = hg_row(b, dir, 32 * (sc * SCH + step) + 16 * mt + 4 * c4 + r);
                    HO[((size_t)dir * R + row) * 512 + h * 128 + 16 * wave + l15] = o[r]; }
            }
        }
#pragma unroll
        for (int kt = 0; kt < 8; ++kt) { const v4f d = *(const LAS v4f*)(sl + HU_D + (16 * kt + 4 * c4) * 4);
            acc[kt] = acc[kt] * d; acc[kt] = mfma_bf(*(const LAS v4u*)(sl + HU_K + (kt * 64 + lane) * 16), vf, acc[kt]); if (!WITH_OUT) dprod[kt] = dprod[kt] * d; }
        if (step < SCH - 1) HU_WRITE((step + 1) & 1);
        vf = vfn;
        __syncthreads();
    }
#undef HU_LOAD
#undef HU_WRITE
    if (!WITH_OUT) {
        float* slot = HS + (size_t)(chain * NSC + sc) * 16384;
#pragma unroll
        for (int kt = 0; kt < 8; ++kt)
#pragma unroll
            for (int r = 0; r < 4; ++r) slot[(16 * kt + 4 * c4 + r) * 128 + 16 * wave + l15] = acc[kt][r];
        if (wave == 0 && l15 == 0) {
#pragma unroll
            for (int kt = 0; kt < 8; ++kt) *(v4f*)(HD + (chain * NSC + sc) * 128 + 16 * kt + 4 * c4) = dprod[kt];
        }
    }
}
__device__ __forceinline__ void hgrn_scan(float* HS, const float* HD, int gtid, int NT) {
    for (int e = gtid; e < 32 * 4096; e += NT) {
        const int chain = e >> 12, q4 = e & 4095, k = q4 >> 5;
        v4f* p = (v4f*)(HS + (size_t)chain * NSC * 16384) + q4; const float* dp = HD + chain * NSC * 128 + k;
        v4f tmp[NSC - 1]; float dd[NSC - 1];
#pragma unroll
        for (int s = 0; s < NSC - 1; ++s) { tmp[s] = p[(size_t)s * 4096]; dd[s] = dp[s * 128]; }
        v4f st = (v4f){0.f, 0.f, 0.f, 0.f};
#pragma unroll
        for (int s = 0; s < NSC - 1; ++s) { st = st * dd[s] + tmp[s]; p[(size_t)s * 4096] = st; }
    }
}
__device__ __forceinline__ void hg_combine(const float* HO, const bf16* PROJ, bf16* MIX, const float* hgg, bool skip_ctx, int gw, int NGW, int lane) {
    const float g0 = hgg[2 * lane], g1 = hgg[2 * lane + 1];
#pragma unroll 1
    for (int m0 = 4 * gw; m0 < R; m0 += 4 * NGW) {
        const int b = m0 / TB, t = m0 - b * TB; if (t >= SEQ && skip_ctx) continue;
        v2f a[4][4], c[4][4]; unsigned w2[4][4];
#pragma unroll
        for (int rr = 0; rr < 4; ++rr)
#pragma unroll
            for (int h = 0; h < 4; ++h) { const float* p0 = HO + (size_t)(m0 + rr) * 512 + h * 128 + 2 * lane;
                a[rr][h] = *(const v2f*)p0; c[rr][h] = *(const v2f*)(p0 + (size_t)R * 512);
                w2[rr][h] = *(const unsigned*)(PROJ + (size_t)(m0 + rr) * INC + C_HGT + h * 128 + 2 * lane); }
#pragma unroll
        for (int rr = 0; rr < 4; ++rr)
#pragma unroll
            for (int h = 0; h < 4; ++h) {
                const float o0 = a[rr][h].x + c[rr][h].x, o1 = a[rr][h].y + c[rr][h].y;
                const float rstd = __builtin_amdgcn_rsqf(wave_sum(o0 * o0 + o1 * o1) * (1.f / 128.f) + EPS);
                const float y0 = o0 * rstd * g0 * silu_f(bf2f(w2[rr][h] & 0xffffu)), y1 = o1 * rstd * g1 * silu_f(bf2f(w2[rr][h] >> 16));
                *(unsigned*)(MIX + (size_t)(m0 + rr) * DM + 1024 + h * 128 + 2 * lane) = cvtpk_rne(y0, y1);
            }
    }
}
__device__ __forceinline__ void conv_act_phase(const bf16* UP, bf16* ACT, const float* cw, const float* cb, bool skip_ctx, int gtid, int NT) {
    constexpr int NOCT = DFF / 8, NSTRIP = R / 32;
    for (int it = gtid; it < NSTRIP * NOCT; it += NT) {
        const int strip = it / NOCT, oc = it - strip * NOCT, wi = strip % (TB / 32), c0 = oc * 8;
        if (skip_ctx && wi >= SEQ / 32) continue;
        const bool seg_start = (wi == 0 || wi == SEQ / 32), seg_end = (wi == SEQ / 32 - 1 || wi == TB / 32 - 1);
        float w[2][3][8], bb[2][8];
#pragma unroll
        for (int hlf = 0; hlf < 2; ++hlf) {
#pragma unroll
            for (int jj = 0; jj < 3; ++jj) { const v4f a0 = *(const v4f*)(cw + (size_t)jj * UPC + hlf * DFF + c0), a1 = *(const v4f*)(cw + (size_t)jj * UPC + hlf * DFF + c0 + 4);
                w[hlf][jj][0] = a0.x; w[hlf][jj][1] = a0.y; w[hlf][jj][2] = a0.z; w[hlf][jj][3] = a0.w; w[hlf][jj][4] = a1.x; w[hlf][jj][5] = a1.y; w[hlf][jj][6] = a1.z; w[hlf][jj][7] = a1.w; }
            const v4f b0 = *(const v4f*)(cb + hlf * DFF + c0), b1 = *(const v4f*)(cb + hlf * DFF + c0 + 4);
            bb[hlf][0] = b0.x; bb[hlf][1] = b0.y; bb[hlf][2] = b0.z; bb[hlf][3] = b0.w; bb[hlf][4] = b1.x; bb[hlf][5] = b1.y; bb[hlf][6] = b1.z; bb[hlf][7] = b1.w;
        }
        const size_t r0 = (size_t)strip * 32;
        v4u pg = (v4u){0u, 0u, 0u, 0u}, pv = pg, cg, cvv, ng, nv;
        if (!seg_start) { pg = *(const v4u*)(UP + (r0 - 1) * UPC + c0); pv = *(const v4u*)(UP + (r0 - 1) * UPC + DFF + c0); }
        cg = *(const v4u*)(UP + r0 * UPC + c0); cvv = *(const v4u*)(UP + r0 * UPC + DFF + c0);
#pragma unroll 2
        for (int i = 0; i < 32; ++i) {
            if (i < 31 || !seg_end) { ng = *(const v4u*)(UP + (r0 + i + 1) * UPC + c0); nv = *(const v4u*)(UP + (r0 + i + 1) * UPC + DFF + c0); }
            else { ng = (v4u){0u, 0u, 0u, 0u}; nv = ng; }
            v4u o;
#pragma unroll
            for (int q = 0; q < 4; ++q) {
                float res[2];
#pragma unroll
                for (int e = 0; e < 2; ++e) {
                    const int ci = 2 * q + e;
                    const float gp = e ? bf2f(pg[q] >> 16) : bf2f(pg[q] & 0xffffu), gc = e ? bf2f(cg[q] >> 16) : bf2f(cg[q] & 0xffffu), gn = e ? bf2f(ng[q] >> 16) : bf2f(ng[q] & 0xffffu);
                    const float vp = e ? bf2f(pv[q] >> 16) : bf2f(pv[q] & 0xffffu), vc = e ? bf2f(cvv[q] >> 16) : bf2f(cvv[q] & 0xffffu), vn = e ? bf2f(nv[q] >> 16) : bf2f(nv[q] & 0xffffu);
                    const float yg = bb[0][ci] + w[0][0][ci] * gp + w[0][1][ci] * gc + w[0][2][ci] * gn;
                    const float yv = bb[1][ci] + w[1][0][ci] * vp + w[1][1][ci] * vc + w[1][2][ci] * vn;
                    res[e] = silu_f(yg) * yv;
                }
                o[q] = pk2(res[0], res[1]);
            }
            *(v4u*)(ACT + (r0 + i) * DFF + c0) = o;
            pg = cg; pv = cvv; cg = ng; cvv = nv;
        }
    }
}

__device__ __forceinline__ kptr_t kargs_fresh() { kptr_t p = (kptr_t)__builtin_amdgcn_kernarg_segment_ptr(); asm volatile("" : "+s"(p)); return p; }
#define KIN(i)  (*(const float* const AS4*)(kp + 8 * (i)))
#define KOUT()  (*(float* const AS4*)(kp + 176))
#define KWS()   (*(unsigned char* const AS4*)(kp + 184))
#define PH_BEGIN \
    int tid = threadIdx.x; asm volatile("" : "+v"(tid)); \
    const int lane = tid & 63, wave = __builtin_amdgcn_readfirstlane(tid >> 6); \
    int bx = blockIdx.x; asm volatile("" : "+s"(bx)); int G = gridDim.x; asm volatile("" : "+s"(G)); \
    const int gw = bx * NWAVES + wave, NGW = G * NWAVES, gtid = bx * NTHR + tid, NT = G * NTHR; \
    const kptr_t kp = kargs_fresh(); unsigned char* const ws = KWS(); \
    (void)lane; (void)gw; (void)NGW; (void)gtid; (void)NT; (void)ws;

template <int SEL>
__device__ __forceinline__ void convert_item(int l, int r, kptr_t kp, unsigned char* ws, LAS float* scr, int lane) {
    unsigned char* wb = ws + WS_W + (size_t)l * W_LAYER; const float* MOD = (const float*)(ws + WS_MOD) + (size_t)l * 5 * NMODC;
    if (SEL & 1) { if (r < CI_IN) { p0_transpose_item<true>(KIN(I_WIN) + (size_t)l * DM * INC, DM, INC, (bf16*)(wb + W_IN), scr, r, lane, (float*)(ws + WS_SWIN) + (size_t)l * 5 * INC, MOD + 0 * DM); return; } r -= CI_IN; }
    if (SEL & 2) { if (r < CI_OUT) { p0_transpose_item<false>(KIN(I_WOUT) + (size_t)l * DM * DM, DM, DM, (bf16*)(wb + W_OUT), scr, r, lane, nullptr, nullptr); return; } r -= CI_OUT; }
    if (SEL & 4) { if (r < CI_UP) { p0_transpose_item<true>(KIN(I_WUP) + (size_t)l * DM * UPC, DM, UPC, (bf16*)(wb + W_UP), scr, r, lane, (float*)(ws + WS_SWUP) + (size_t)l * 5 * UPC, MOD + 3 * DM); return; } r -= CI_UP; }
    if (SEL & 8) { p0_transpose_item<false>(KIN(I_WDN) + (size_t)l * DFF * DM, DFF, DM, (bf16*)(wb + W_DN), scr, r, lane, nullptr, nullptr); }
}

__global__ void __launch_bounds__(NTHR, 2) mk_fwd(Args a_unused) {
    extern __shared__ __attribute__((aligned(16))) unsigned char lds[];
    LAS unsigned char* ldsp = (LAS unsigned char*)lds;
    int lo, hi;
    { const kptr_t kp = kargs_fresh(); lo = *(const int AS4*)(kp + 192); hi = *(const int AS4*)(kp + 196); }
    for (int u = threadIdx.x; u < (LDS_BYTES - LDSCTL_OFF) / 4; u += NTHR) ((LAS unsigned*)(ldsp + LDSCTL_OFF))[u] = 0u;
    __syncthreads();
#if MK_ONE_LAUNCH
    XcdBarrier bar;
    { const kptr_t kp = kargs_fresh(); bar = xcd_barrier_post((unsigned*)(KWS() + WS_CTL) + CW_BAR, (volatile LAS unsigned*)(ldsp + MISC_OFF) + 8); }
#define GRID_BAR() xcd_barrier(bar)
#else
#define GRID_BAR() do { } while (0)
#endif
#define IN(k) (lo <= (k) && (k) < hi)

    if (IN(0)) {
        PH_BEGIN
        float* MOD = (float*)(ws + WS_MOD);
        p0_mod(KIN(I_C), KIN(I_CCTX), KIN(I_WADA), KIN(I_BADA), ldsp, MOD, tid, lane, wave, bx, G);
        if (bx == G - 1) {
            float* LBS = (float*)(ws + WS_MISC); float* RCOS = (float*)(ws + WS_MISC + 16384); float* RSIN = (float*)(ws + WS_MISC + 24576);
            const float* lbp = KIN(I_LBP);
            for (int i = tid; i < 1024; i += NTHR) { const int dir = i >> 9, ci = i & 511; float v[DEPTH], mx = -3.0e38f;
#pragma unroll
                for (int l = 0; l < DEPTH; ++l) { v[l] = lbp[(dir * DEPTH + l) * 512 + ci]; mx = fmaxf(mx, v[l]); }
                float s = 0.f;
#pragma unroll
                for (int l = 0; l < DEPTH; ++l) { v[l] = expf(v[l] - mx); s += v[l]; }
                float cum = 0.f;
#pragma unroll
                for (int l = 0; l < DEPTH; ++l) { if (l > 0) cum += v[l] / s; LBS[(dir * DEPTH + l) * 512 + ci] = cum; } }
            for (int i = tid; i < 2048; i += NTHR) { const int pos = i >> 5, fi = i & 31; const float inv = powf(10000.f, -(float)fi / 32.f); const float ang = (float)pos * inv; RCOS[i] = cosf(ang); RSIN[i] = sinf(ang); }
        }
        __syncthreads();
        {
            LAS float* scr = (LAS float*)(ldsp + wave * 16384);
            for (int it = gw; it < convert_count<2 | 8>(); it += NGW) convert_item<2 | 8>(0, it, kp, ws, scr, lane);
        }
        GRID_BAR();
    }

    if (IN(1)) { PH_BEGIN
        const float* MOD = (const float*)(ws + WS_MOD);
        {
            const float* xin = KIN(I_X); const float* cin = KIN(I_CTX); bf16* H = (bf16*)(ws + WS_H); float* RS0 = (float*)(ws + WS_RS); const float* g = KIN(I_N1G);
            for (int m = gw; m < R; m += NGW) {
                const int b = m / TB, t = m - b * TB; const float* mrow = MOD + (size_t)(t >= SEQ ? 4 : b) * NMODC;
                const v4f* xr = (const v4f*)(t < SEQ ? xin + ((size_t)b * SEQ + t) * DM : cin + ((size_t)b * CTXL + (t - SEQ)) * DM) + lane; float ss = 0.f;
#pragma unroll
                for (int j = 0; j < 8; ++j) { const v4f v = xr[64 * j]; ss += (v.x * v.x + v.y * v.y) + (v.z * v.z + v.w * v.w); const int c = 4 * lane + 256 * j;
                    const v4f y = v * *(const v4f*)(g + c) * (1.f + *(const v4f*)(mrow + 1 * DM + c));
                    v2u w; w.x = pk2(y.x, y.y); w.y = pk2(y.z, y.w); *(v2u*)(H + (size_t)m * DM + c) = w; }
                ss = wave_sum(ss); if (lane == 0) RS0[m] = ss;
            } }
        {
            float* GS = (float*)(ws + WS_GS); const float* g1 = KIN(I_N1G); const float* g2 = KIN(I_N2G);
            for (int i = gtid; i < DEPTH * 2 * 5 * DM; i += NT) { const int c = i & (DM - 1), r = (i >> 11) % 5, wl = i / (5 * DM), which = wl & 1, l = wl >> 1;
                GS[i] = (which ? g2 : g1)[l * DM + c] * (1.f + MOD[(size_t)(l * 5 + r) * NMODC + (which ? 4 : 1) * DM + c]); } }
        {
            LAS float* scr = (LAS float*)(ldsp + wave * 16384);
            for (int it = gw; it < convert_count<1 | 4>(); it += NGW) convert_item<1 | 4>(0, it, kp, ws, scr, lane);
        }
        GRID_BAR();
    }

#pragma unroll 1
    for (int l = 0; l < DEPTH; ++l) {
        const int pb = 2 + 10 * l; const bool last = (l == DEPTH - 1);
#define MODL ((const float*)(ws + WS_MOD) + (size_t)l * 5 * NMODC)
#define WB   (ws + WS_W + (size_t)l * W_LAYER)
#define RSL(s_) ((float*)(ws + WS_RS) + (size_t)(s_) * R)
#define GSL(l_, which_) ((const float*)(ws + WS_GS) + (size_t)((l_) * 2 + (which_)) * 5 * DM)
        if (IN(pb + 0)) { PH_BEGIN
            pg8::Gemm g{(const bf16*)(ws + WS_H), (const bf16*)(WB + W_IN), R, INC, DM}; TileOrder S; S.init2(INC, G, bx, false);
            EpiBf16N E{(bf16*)(ws + WS_PROJ), INC, RSL(2 * l), (const float*)(ws + WS_SWIN) + (size_t)l * 5 * INC};
            pg8::gemm_phase<EpiBf16N, TileOrder, true, true>(ldsp, g, S, E);
            GRID_BAR();
        }
        if (IN(pb + 1)) { PH_BEGIN
            const bf16* PROJ = (const bf16*)(ws + WS_PROJ);
            qknorm_phase(PROJ, (bf16*)(ws + WS_QN), (bf16*)(ws + WS_KN), KIN(I_QG) + l * 128, KIN(I_KG) + l * 128, (const float*)(ws + WS_MISC + 16384), (const float*)(ws + WS_MISC + 24576), gw, NGW, lane);
            {   const int nch = last ? 32 : 34, nU = NB * nch * 4;
                for (int u = bx; u < nU; u += G) { const int g = u & 3, bn = u >> 2, b = bn / nch, n = bn - b * nch;
                    sg_unit(b, n, g, l, PROJ, (bf16*)(ws + WS_MIX), KIN(I_SGG) + l * 512, KIN(I_SGW), KIN(I_SGB), ldsp, tid, lane, wave); } }
            hgrn_pre(l, PROJ, (const float*)(ws + WS_MISC), ws + WS_QF, ws + WS_KF, ws + WS_VF, ws + WS_PF, (float*)(ws + WS_DF), ldsp, bx, G, tid, lane, wave);
            GRID_BAR();
        }
        if (IN(pb + 2)) { PH_BEGIN
            for (int u = bx; u < 32 * (NSC - 1); u += G) hgrn_unit2<false>(u / (NSC - 1), u % (NSC - 1), ws + WS_QF, ws + WS_KF, ws + WS_VF, ws + WS_PF, (const float*)(ws + WS_DF), (float*)(ws + WS_HS), (float*)(ws + WS_HD), (float*)(ws + WS_HO), ldsp, tid, lane, wave);
            GRID_BAR();
        }
        if (IN(pb + 3)) { PH_BEGIN
            hgrn_scan((float*)(ws + WS_HS), (const float*)(ws + WS_HD), gtid, NT);
            const int nU = last ? 512 : 544;
            for (int u = bx; u < nU; u += G) {
                int b, hq, row_q, row_k, seq;
                if (u < 512) { const int xcd = u & 7, idx = u >> 3; b = xcd >> 1; hq = (xcd & 1) * 4 + (idx >> 4); row_k = b * TB; row_q = row_k + (idx & 15) * 256; seq = TB; }
                else { const int uc = u - 512; b = uc >> 3; hq = uc & 7; row_k = b * TB + SEQ; row_q = row_k; seq = CTXL; }
                const int kvh = hq >> 2;
                att::attn_dense_body((const bf16*)(ws + WS_QN) + (size_t)row_q * 1024 + hq * 128, (const bf16*)(ws + WS_KN) + (size_t)row_k * 256 + kvh * 128,
                                     (const bf16*)(ws + WS_PROJ) + (size_t)row_k * INC + C_AV + kvh * 128, (bf16*)(ws + WS_MIX) + (size_t)row_q * DM + hq * 128, seq, (char*)lds);
            }
            GRID_BAR();
        }
        if (IN(pb + 4)) { PH_BEGIN
            for (int u = bx; u < 32 * NSC; u += G) hgrn_unit2<true>(u & 31, u >> 5, ws + WS_QF, ws + WS_KF, ws + WS_VF, ws + WS_PF, (const float*)(ws + WS_DF), (float*)(ws + WS_HS), (float*)(ws + WS_HD), (float*)(ws + WS_HO), ldsp, tid, lane, wave);
            GRID_BAR();
        }
        if (IN(pb + 5)) { PH_BEGIN hg_combine((const float*)(ws + WS_HO), (const bf16*)(ws + WS_PROJ), (bf16*)(ws + WS_MIX), KIN(I_HGG) + l * 128, last, gw, NGW, lane); GRID_BAR(); }
        if (IN(pb + 6)) { PH_BEGIN
            pg8::Gemm g{(const bf16*)(ws + WS_MIX), (const bf16*)(WB + W_OUT), R, DM, DM}; TileOrder S; S.init2(DM, G, bx, last);
            EpiResGate<true> E{(float*)(ws + WS_X), MODL, 2, (bf16*)(ws + WS_H), GSL(l, 1), RSL(2 * l + 1), l == 0 ? KIN(I_X) : nullptr, l == 0 ? KIN(I_CTX) : nullptr};
            pg8::gemm_phase<EpiResGate<true>, TileOrder, true, true>(ldsp, g, S, E);
            if (!last) {
                const int nfull = (G == 256) ? 32 : 0; LAS float* scr = (LAS float*)(ldsp + wave * 16384);
                if (bx >= nfull) for (int it = (bx - nfull) * NWAVES + wave; it < convert_count<1 | 2>(); it += (G - nfull) * NWAVES) convert_item<1 | 2>(l + 1, it, kp, ws, scr, lane);
            }
            GRID_BAR();
        }
        if (IN(pb + 7)) { PH_BEGIN
            pg8::Gemm g{(const bf16*)(ws + WS_H), (const bf16*)(WB + W_UP), R, UPC, DM}; TileOrder S; S.init2(UPC, G, bx, last);
            EpiBf16N E{(bf16*)(ws + WS_UP), UPC, RSL(2 * l + 1), (const float*)(ws + WS_SWUP) + (size_t)l * 5 * UPC};
            pg8::gemm_phase<EpiBf16N, TileOrder, true, true>(ldsp, g, S, E);
            GRID_BAR();
        }
        if (IN(pb + 8)) { PH_BEGIN conv_act_phase((const bf16*)(ws + WS_UP), (bf16*)(ws + WS_ACT), KIN(I_CW) + (size_t)l * 3 * UPC, KIN(I_CB) + (size_t)l * UPC, last, gtid, NT); GRID_BAR(); }
        if (IN(pb + 9)) { PH_BEGIN
            pg8::Gemm g{(const bf16*)(ws + WS_ACT), (const bf16*)(WB + W_DN), R, DM, DFF}; TileOrder S; S.init2(DM, G, bx, last);
            if (!last) { EpiResGate<true> E{(float*)(ws + WS_X), MODL, 5, (bf16*)(ws + WS_H), GSL(l + 1, 0), RSL(2 * l + 2), nullptr, nullptr};
                pg8::gemm_phase<EpiResGate<true>, TileOrder, true, true>(ldsp, g, S, E);
                const int nfull = (G == 256) ? 32 : 0; LAS float* scr = (LAS float*)(ldsp + wave * 16384);
                if (bx >= nfull) for (int it = (bx - nfull) * NWAVES + wave; it < convert_count<4 | 8>(); it += (G - nfull) * NWAVES) convert_item<4 | 8>(l + 1, it, kp, ws, scr, lane); }
            else { EpiResGate<false> E{(float*)(ws + WS_X), MODL, 5, nullptr, nullptr, nullptr, nullptr, nullptr};
                pg8::gemm_phase<EpiResGate<false>, TileOrder, true, true>(ldsp, g, S, E); }
            GRID_BAR();
        }
    }
    if (IN(NPHASE - 1)) { PH_BEGIN
        const float* g = KIN(I_FNG); const float* X = (const float*)(ws + WS_X); float* out = KOUT();
        for (int m = gw; m < NB * SEQ; m += NGW) {
            const int b = m >> 12, t = m & 4095;
            const v4f* xr = (const v4f*)(X + (size_t)(b * TB + t) * DM) + lane;
            v4f v[8]; float ss = 0.f;
#pragma unroll
            for (int j = 0; j < 8; ++j) { v[j] = xr[64 * j]; ss += (v[j].x * v[j].x + v[j].y * v[j].y) + (v[j].z * v[j].z + v[j].w * v[j].w); }
            const float rstd = 1.0f / sqrtf(wave_sum(ss) * (1.f / DM) + EPS);
            v4f* orow = (v4f*)(out + (size_t)m * DM) + lane;
#pragma unroll
            for (int j = 0; j < 8; ++j) orow[64 * j] = v[j] * rstd * *(const v4f*)(g + 4 * lane + 256 * j);
        }
    }
#undef IN
}

extern "C" void kernel_launch(void* const* d_in, const int* in_sizes, int n_in, void* d_out, int out_size, void* d_ws, size_t ws_size, hipStream_t stream) {
    static int grid = 0;
    if (grid == 0) {
        if (n_in != 22 || in_sizes[0] != NB * SEQ * DM || out_size != NB * SEQ * DM || ws_size < WS_END) {
            fprintf(stderr, "kernel_launch: unexpected shapes (n_in %d in0 %d out %d ws %zu, need ws >= %zu); nothing launched\n", n_in, n_in > 0 ? in_sizes[0] : -1, out_size, ws_size, (size_t)WS_END); grid = -1; return; }
        int dev = 0, cus = 0, per_cu = 0;
        if (hipGetDevice(&dev) != hipSuccess || hipDeviceGetAttribute(&cus, hipDeviceAttributeMultiprocessorCount, dev) != hipSuccess) { grid = -1; return; }
        if (hipFuncSetAttribute((const void*)mk_fwd, hipFuncAttributeMaxDynamicSharedMemorySize, LDS_BYTES) != hipSuccess) { fprintf(stderr, "kernel_launch: hipFuncSetAttribute failed\n"); grid = -1; return; }
        if (hipOccupancyMaxActiveBlocksPerMultiprocessor(&per_cu, (const void*)mk_fwd, NTHR, LDS_BYTES) != hipSuccess || per_cu < 1)
            fprintf(stderr, "kernel_launch: note: occupancy query reports %d workgroups per CU\n", per_cu);
        (void)hipGetLastError();
        grid = cus;
    }
    if (grid < 0) return;
    if (hipMemsetAsync((char*)d_ws + WS_CTL, 0, CTL_ZERO_BYTES, stream) != hipSuccess) return;
    Args a{};
    for (int i = 0; i < 22; ++i) a.in[i] = (const float*)d_in[i];
    a.out = (float*)d_out; a.ws = (unsigned char*)d_ws;
#if MK_ONE_LAUNCH
    a.ph_lo = 0; a.ph_hi = NPHASE;
    hipLaunchKernelGGL(mk_fwd, dim3(grid), dim3(NTHR), LDS_BYTES, stream, a);
#else
    for (int p = 0; p < NPHASE; ++p) { a.ph_lo = p; a.ph_hi = p + 1; hipLaunchKernelGGL(mk_fwd, dim3(grid), dim3(NTHR), LDS_BYTES, stream, a); }
#endif
    const hipError_t le = hipPeekAtLastError();
    if (le != hipSuccess) fprintf(stderr, "kernel_launch: launch failed: %s\n", hipGetErrorName(le));
}
```

```cpp
#include <hip/hip_runtime.h>
#include <cstdio>
#include <cstdint>
#ifndef MK_ONE_LAUNCH
#define MK_ONE_LAUNCH 1
#endif
namespace pg8 {
#define PG8_LAS __attribute__((address_space(3)))
typedef unsigned short bf16_t;
typedef short bf16x8 __attribute__((ext_vector_type(8)));
typedef float f32x4 __attribute__((ext_vector_type(4)));
typedef unsigned u32x4 __attribute__((ext_vector_type(4)));
constexpr int BM = 256, BK = 64, HALF = 128, HTB = HALF * BK * 2  , STAGE_BYTES = 8 * HTB, NXCD = 8, WGM = 8;

__host__ __device__ __forceinline__ int lds_byte(int r, int c) { const int st = (r >> 4) * 2 + (c >> 5), rr = r & 15, cc = c & 31, ob = rr * 64 + cc * 2; return st * 1024 + (ob ^ (((ob >> 9) & 1) << 5)); }
__host__ __device__ __forceinline__ void stage_rc(int b, int& R, int& C) { const int st = b / 1024, sb = b % 1024, swz = sb ^ (((sb >> 9) & 1) << 5); R = (st >> 1) * 16 + swz / 64; C = (st & 1) * 32 + (swz % 64) / 2; }
__host__ __device__ __forceinline__ int perm32(int rho) { const int n = rho >> 4, i = rho & 15; return 8 * (i >> 2) + 4 * n + (i & 3); }

struct Unit { int pm, pn; };
struct Gemm { const bf16_t* A; const bf16_t* Bt; int M, N, K; };

struct StaticOrder {
    int nM, nN, nwg, G, c;
    __host__ __device__ void init(int M, int N, int G_, int c_) { nM = M / BM; nN = N / BM; nwg = nM * nN; G = G_; c = c_; }
    __host__ __device__ bool next(int i, Unit& u) const {
        const long L = (long)i * G + c; if (L >= nwg) return false;
        int wgid = (int)L; { const int q = nwg / NXCD, r = nwg % NXCD, xcd = wgid % NXCD, off = wgid / NXCD; wgid = (xcd < r ? xcd * (q + 1) : r * (q + 1) + (xcd - r) * q) + off; }
        const int nig = WGM * nN, gid = wgid / nig, fm = gid * WGM, gsz = (nM - fm) < WGM ? (nM - fm) : WGM;
        u.pm = fm + ((wgid % nig) % gsz); u.pn = (wgid % nig) / gsz; return true;
    }
    __device__ __forceinline__ void a_ready(const Unit&) const {}
    __device__ __forceinline__ void done(const Unit&) const {}
};

__device__ __forceinline__ unsigned cvt_pk_bf16(float lo, float hi) { unsigned r; asm volatile("v_cvt_pk_bf16_f32 %0, %1, %2" : "=v"(r) : "v"(lo), "v"(hi)); return r; }
typedef float f32x2 __attribute__((ext_vector_type(2)));
__device__ __forceinline__ f32x2 gelu_pk(f32x2 v) {
    const f32x2 av = __builtin_elementwise_abs(v), d = av * 0.2316418882f + 1.0f;
    f32x2 t; t.x = __builtin_amdgcn_rcpf(d.x); t.y = __builtin_amdgcn_rcpf(d.y);
    f32x2 q = t * 0.5307027145f + (-0.7265760135f); q = q * t + 0.7107068705f; q = q * t + (-0.142248368f); q = q * t + 0.127414796f; q = q * t;
    const f32x2 s = (v * v) * (-0.72134752044f);
    f32x2 e; e.x = __builtin_amdgcn_exp2f(s.x); e.y = __builtin_amdgcn_exp2f(s.y);
    const f32x2 m = v * (q * e), r = v - m;
    f32x2 o; o.x = v.x < 0.f ? m.x : r.x; o.y = v.y < 0.f ? m.y : r.y; return o;
}

template <int ACT  > struct EpiBf16 {
    static constexpr bool PERM = true, AFTER_DRAIN = false; static_assert(ACT == 0 || ACT == 1, "EpiBf16: ACT is 0 (none) or 1 (gelu_pk)");
    bf16_t* O; int ldc; const float* bias; int split_cols; size_t split_stride; float scale0;
    __device__ __forceinline__ void operator()(const f32x4 (&acc)[2][2][4][2], const Unit& u, int wr, int wc, int fr, int fq) const {
        const int row0 = u.pm * BM + wr * 64 + fr; int colt = u.pn * BM; bf16_t* base = O;
        float sc = 1.f; if (split_cols) { const int t = colt / split_cols; base += (size_t)t * split_stride; colt -= t * split_cols; if (t == 0) sc = scale0; }
        const int col0 = colt + wc * 32 + 8 * fq, bcol0 = u.pn * BM + wc * 32 + 8 * fq;
        f32x4 bv[2][2];
#pragma unroll
        for (int bj = 0; bj < 2; ++bj)
#pragma unroll
            for (int n = 0; n < 2; ++n) bv[bj][n] = bias ? *(const f32x4*)(bias + bcol0 + bj * HALF + 4 * n) : (f32x4){0.f, 0.f, 0.f, 0.f};
#pragma unroll
        for (int ai = 0; ai < 2; ++ai)
#pragma unroll
            for (int m = 0; m < 4; ++m) { bf16_t* rowp = base + (size_t)(row0 + ai * HALF + m * 16) * ldc + col0;
#pragma unroll
                for (int bj = 0; bj < 2; ++bj) { f32x4 v0 = acc[ai][bj][m][0] + bv[bj][0], v1 = acc[ai][bj][m][1] + bv[bj][1];
                    if (ACT == 1) { f32x2 a = gelu_pk((f32x2){v0[0], v0[1]}), b = gelu_pk((f32x2){v0[2], v0[3]}), c = gelu_pk((f32x2){v1[0], v1[1]}), d = gelu_pk((f32x2){v1[2], v1[3]});
                        v0 = (f32x4){a.x, a.y, b.x, b.y}; v1 = (f32x4){c.x, c.y, d.x, d.y}; }
                    v0 = v0 * sc; v1 = v1 * sc; u32x4 w; w.x = cvt_pk_bf16(v0[0], v0[1]); w.y = cvt_pk_bf16(v0[2], v0[3]); w.z = cvt_pk_bf16(v1[0], v1[1]); w.w = cvt_pk_bf16(v1[2], v1[3]);
                    *(u32x4*)(rowp + bj * HALF) = w; } }
    }
};
template <class Epi, class Sched, bool ALIGN_EPI = false, bool SP2 = false>
__device__ __forceinline__ void gemm_phase(PG8_LAS unsigned char* lds, const Gemm g, const Sched& S, const Epi& E) {
    int tid_l = threadIdx.x; asm volatile("" : "+v"(tid_l)); const int tid = tid_l, wid = __builtin_amdgcn_readfirstlane(tid >> 6), lane = tid & 63, wr = wid >> 2, wc = wid & 3, fr = lane & 15, fq = lane >> 4;
    const int K = g.K, nt = K / BK;
    unsigned voffA[2], voffB[2];
#pragma unroll
    for (int i = 0; i < 2; ++i) { int R, C; stage_rc(tid * 16 + i * 8192, R, C); const int Rb = Epi::PERM ? ((R & ~31) + perm32(R & 31)) : R;
        voffA[i] = (unsigned)(R * K + C) * 2u; voffB[i] = (unsigned)(Rb * K + C) * 2u; }
    const size_t kstep = (size_t)(BK * 2);
    const size_t hstep = (size_t)HALF * K * 2;
    const size_t tstep = 2 * hstep;
    const unsigned ldsw = (unsigned)wid * 1024u;
    const int aoff = lds_byte(wr * 64 + fr, fq * 8), boff = lds_byte(wc * 32 + fr, fq * 8);
#define PG8_SA(b, h) (((b) * 2 + (h)) * HTB)
#define PG8_SB(b, h) ((4 + (b) * 2 + (h)) * HTB)
#define PG8_STAGE(bufoff, gbase, voff) do { _Pragma("unroll") for (int _i = 0; _i < 2; ++_i) \
        __builtin_amdgcn_global_load_lds((const unsigned*)((const char*)(gbase) + (voff)[_i]), (PG8_LAS unsigned*)(lds + (bufoff) + ldsw + _i * 8192), 16, 0, 0); } while (0)
#define PG8_LDA(dst, b, h) do { _Pragma("unroll") for (int m = 0; m < 4; ++m) _Pragma("unroll") for (int k = 0; k < 2; ++k) dst[m][k] = *(const PG8_LAS bf16x8*)(lds + PG8_SA(b, h) + aoff + m * 2048 + k * 1024); } while (0)
#define PG8_LDB(dst, b, h) do { _Pragma("unroll") for (int n = 0; n < 2; ++n) _Pragma("unroll") for (int k = 0; k < 2; ++k) dst[n][k] = *(const PG8_LAS bf16x8*)(lds + PG8_SB(b, h) + boff + n * 2048 + k * 1024); } while (0)
#define PG8_MMA(ai, bj, At, Bt) do { __builtin_amdgcn_s_setprio(1); _Pragma("unroll") for (int m = 0; m < 4; ++m) _Pragma("unroll") for (int n = 0; n < 2; ++n) _Pragma("unroll") for (int k = 0; k < 2; ++k) \
        acc[ai][bj][m][n] = __builtin_amdgcn_mfma_f32_16x16x32_bf16(Bt[n][k], At[m][k], acc[ai][bj][m][n], 0, 0, 0); __builtin_amdgcn_s_setprio(0); } while (0)
#define PG8_WAIT_V(n) asm volatile("s_waitcnt vmcnt(" #n ")" ::: "memory")
#define PG8_WAIT_L(n) asm volatile("s_waitcnt lgkmcnt(" #n ")" ::: "memory")
#define PG8_BAR __builtin_amdgcn_s_barrier()
#define PG8_SCHED __builtin_amdgcn_sched_barrier(0)
    Unit cur, nxt; int ui = 0;
    if (!S.next(0, cur)) return;
    f32x4 acc[2][2][4][2];
#pragma unroll
    for (int a = 0; a < 2; ++a)
#pragma unroll
        for (int b = 0; b < 2; ++b)
#pragma unroll
            for (int m = 0; m < 4; ++m)
#pragma unroll
                for (int n = 0; n < 2; ++n) acc[a][b][m][n] = (f32x4){0.f, 0.f, 0.f, 0.f};
    bf16x8 At[4][2], B0[2][2], B1[2][2];
    const char* cA = (const char*)g.A + (size_t)cur.pm * tstep; const char* cB = (const char*)g.Bt + (size_t)cur.pn * tstep;
    S.a_ready(cur);
    if constexpr (SP2) {
        PG8_STAGE(PG8_SB(0, 0), cB, voffB); PG8_STAGE(PG8_SB(0, 1), cB + hstep, voffB); PG8_STAGE(PG8_SA(0, 0), cA, voffA); PG8_STAGE(PG8_SA(0, 1), cA + hstep, voffA);
        if (wr == 1) PG8_BAR;
        PG8_WAIT_V(2); PG8_BAR;
        PG8_STAGE(PG8_SB(1, 0), cB + kstep, voffB); PG8_STAGE(PG8_SA(1, 0), cA + kstep, voffA); PG8_STAGE(PG8_SB(1, 1), cB + hstep + kstep, voffB);
        PG8_WAIT_V(6); PG8_BAR;
    } else {
        PG8_STAGE(PG8_SB(0, 0), cB, voffB); PG8_STAGE(PG8_SA(0, 0), cA, voffA); PG8_STAGE(PG8_SB(0, 1), cB + hstep, voffB); PG8_STAGE(PG8_SA(0, 1), cA + hstep, voffA);
        if (wr == 1) PG8_BAR;
        PG8_WAIT_V(4); PG8_BAR;
        PG8_STAGE(PG8_SB(1, 0), cB + kstep, voffB); PG8_STAGE(PG8_SA(1, 0), cA + kstep, voffA); PG8_STAGE(PG8_SB(1, 1), cB + hstep + kstep, voffB);
        PG8_WAIT_V(6); PG8_BAR;
    }
    for (;;) {
        const bool has_next = S.next(ui + 1, nxt);
        const char* nA = has_next ? (const char*)g.A + (size_t)nxt.pm * tstep : cA; const char* nB = has_next ? (const char*)g.Bt + (size_t)nxt.pn * tstep : cB;
        for (int t = 0; t < nt; t += 2) {
            const bool last = (t == nt - 2);
            const char* a1 = cA + (size_t)(t + 1) * kstep;
            const char* a2 = last ? nA : cA + (size_t)(t + 2) * kstep; const char* b2 = last ? nB : cB + (size_t)(t + 2) * kstep;
            const char* a3 = a2 + kstep; const char* b3 = b2 + kstep;
            if (last && has_next) S.a_ready(nxt);
            if constexpr (SP2) {
            PG8_LDB(B0, 0, 0); PG8_LDB(B1, 0, 1); PG8_SCHED; PG8_LDA(At, 0, 0); PG8_STAGE(PG8_SA(1, 1), a1 + hstep, voffA);
            PG8_WAIT_V(8); PG8_WAIT_L(0); PG8_BAR; PG8_MMA(0, 0, At, B0); PG8_MMA(0, 1, At, B1); PG8_BAR; PG8_SCHED;
            PG8_LDA(At, 0, 1); PG8_STAGE(PG8_SB(0, 0), b2, voffB); PG8_STAGE(PG8_SB(0, 1), b2 + hstep, voffB); PG8_STAGE(PG8_SA(0, 0), a2, voffA);
            PG8_WAIT_V(8); PG8_WAIT_L(0); PG8_BAR; PG8_MMA(1, 0, At, B0); PG8_MMA(1, 1, At, B1); PG8_BAR; PG8_SCHED;
            PG8_LDB(B0, 1, 0); PG8_LDB(B1, 1, 1); PG8_SCHED; PG8_LDA(At, 1, 0); PG8_STAGE(PG8_SA(0, 1), a2 + hstep, voffA);
            PG8_WAIT_V(8); PG8_WAIT_L(0); PG8_BAR; PG8_MMA(0, 0, At, B0); PG8_MMA(0, 1, At, B1); PG8_BAR; PG8_SCHED;
            PG8_LDA(At, 1, 1); PG8_STAGE(PG8_SB(1, 0), b3, voffB); PG8_STAGE(PG8_SB(1, 1), b3 + hstep, voffB); PG8_STAGE(PG8_SA(1, 0), a3, voffA);
            PG8_WAIT_V(8); PG8_WAIT_L(0); PG8_BAR; PG8_MMA(1, 0, At, B0); PG8_MMA(1, 1, At, B1); PG8_BAR; PG8_SCHED;
            } else {
            PG8_LDB(B0, 0, 0); PG8_SCHED; PG8_LDA(At, 0, 0); PG8_STAGE(PG8_SA(1, 1), a1 + hstep, voffA);
            PG8_WAIT_L(8); PG8_BAR; PG8_WAIT_L(0); PG8_MMA(0, 0, At, B0); PG8_BAR; PG8_SCHED;
            PG8_LDB(B1, 0, 1); PG8_STAGE(PG8_SB(0, 0), b2, voffB);
            PG8_BAR; PG8_WAIT_L(0); PG8_MMA(0, 1, At, B1); PG8_BAR;
            PG8_LDA(At, 0, 1); PG8_STAGE(PG8_SA(0, 0), a2, voffA);
            PG8_BAR; PG8_WAIT_L(0); PG8_MMA(1, 0, At, B0); PG8_BAR; PG8_SCHED;
            PG8_STAGE(PG8_SB(0, 1), b2 + hstep, voffB);
            PG8_WAIT_V(6); PG8_BAR; PG8_MMA(1, 1, At, B1); PG8_BAR;
            PG8_LDB(B0, 1, 0); PG8_SCHED; PG8_LDA(At, 1, 0); PG8_STAGE(PG8_SA(0, 1), a2 + hstep, voffA);
            PG8_WAIT_L(8); PG8_BAR; PG8_WAIT_L(0); PG8_MMA(0, 0, At, B0); PG8_BAR; PG8_SCHED;
            PG8_LDB(B1, 1, 1); PG8_STAGE(PG8_SB(1, 0), b3, voffB);
            PG8_BAR; PG8_WAIT_L(0); PG8_MMA(0, 1, At, B1); PG8_BAR;
            PG8_LDA(At, 1, 1); PG8_STAGE(PG8_SA(1, 0), a3, voffA);
            PG8_BAR; PG8_WAIT_L(0); PG8_MMA(1, 0, At, B0); PG8_BAR; PG8_SCHED;
            PG8_STAGE(PG8_SB(1, 1), b3 + hstep, voffB);
            PG8_WAIT_V(6); PG8_BAR; PG8_MMA(1, 1, At, B1); PG8_BAR;
            }
        }
        if constexpr (ALIGN_EPI) { if (wr == 0) PG8_BAR; }
        if constexpr (!Epi::AFTER_DRAIN) { E(acc, cur, wr, wc, fr, fq); S.done(cur); }
        if (!has_next) break;
#pragma unroll
        for (int a = 0; a < 2; ++a)
#pragma unroll
            for (int b = 0; b < 2; ++b)
#pragma unroll
                for (int m = 0; m < 4; ++m)
#pragma unroll
                    for (int n = 0; n < 2; ++n) acc[a][b][m][n] = (f32x4){0.f, 0.f, 0.f, 0.f};
        cur = nxt; cA = nA; cB = nB; ++ui;
        if constexpr (ALIGN_EPI) { if (wr == 1) PG8_BAR; }
    }
    PG8_WAIT_V(0);
    if constexpr (!ALIGN_EPI) { if (wr == 0) PG8_BAR; }
    PG8_BAR;
    if constexpr (Epi::AFTER_DRAIN) { E.fused(acc, cur, wr, wc, fr, fq, lds, wid, lane); S.done(cur); }
#undef PG8_SA
#undef PG8_SB
#undef PG8_STAGE
#undef PG8_LDA
#undef PG8_LDB
#undef PG8_MMA
#undef PG8_WAIT_V
#undef PG8_WAIT_L
#undef PG8_BAR
#undef PG8_SCHED
}
}
constexpr int DM = 2048, NB = 4, SEQ = 4096, CTXL = 256, DEPTH = 4;
constexpr int TB = SEQ + CTXL;
constexpr int R = NB * TB;
constexpr int INC = 5120, DFF = 5632, UPC = 2 * DFF, NMODC = 6 * DM;
constexpr int C_AQ = 0, C_AK = 1024, C_AV = 1280, C_HQ = 1536, C_HFF = 2048, C_HFB = 2560, C_HI = 3072, C_HGT = 3584, C_SU = 4096, C_SV = 4608;
constexpr float EPS = 1e-6f;
constexpr int NWAVES = 8, NTHR = 512;
constexpr int NPHASE = 3 + 9 * DEPTH;

constexpr size_t MiB = 1u << 20;
constexpr size_t WS_CTL = 0, CTL_ZERO_BYTES = 4 * MiB;
constexpr size_t WS_MOD = 3 * MiB;
constexpr size_t WS_MISC = 1146 * MiB;
constexpr size_t WS_W = 4 * MiB, W_LAYER = 94 * MiB, W_IN = 0, W_OUT = 20 * MiB, W_UP = 28 * MiB, W_DN = 72 * MiB;
constexpr size_t WS_X = 380 * MiB;
constexpr size_t WS_H = 516 * MiB;
constexpr size_t WS_PROJ = 584 * MiB;
constexpr size_t WS_QN = 754 * MiB;
constexpr size_t WS_KN = 788 * MiB;
constexpr size_t WS_MIX = 797 * MiB;
constexpr size_t WS_HS = 865 * MiB;
constexpr size_t WS_HD = 897 * MiB;
constexpr size_t WS_HO = 898 * MiB;
constexpr size_t WS_UP = 584 * MiB;
constexpr size_t WS_ACT = 958 * MiB;
constexpr size_t WS_SWIN = 1 * MiB;
constexpr size_t WS_SWUP = WS_SWIN + 512 * 1024;
constexpr size_t WS_GS = 1145 * MiB;
constexpr size_t WS_END = 1147 * MiB;
constexpr size_t WS_RS = 65536;
static_assert(WS_RS + (size_t)2 * DEPTH * R * 4 <= WS_SWIN && WS_SWIN + (size_t)DEPTH * 5 * INC * 4 <= WS_SWUP && WS_SWUP + (size_t)DEPTH * 5 * UPC * 4 <= WS_MOD && WS_MOD + (size_t)DEPTH * 5 * NMODC * 4 <= CTL_ZERO_BYTES && WS_GS + (size_t)DEPTH * 2 * 5 * DM * 4 <= WS_MISC && WS_MISC + 65536 <= WS_END && WS_MOD + (size_t)DEPTH * 5 * NMODC * 4 <= WS_W, "ws map 4");
static_assert(WS_HO + (size_t)2 * R * 512 * 4 <= 966 * MiB && WS_UP + (size_t)R * UPC * 2 <= WS_ACT && WS_ACT + (size_t)R * DFF * 2 <= WS_GS, "ws map");
static_assert(WS_PROJ + (size_t)R * INC * 2 <= WS_QN && WS_QN + (size_t)R * 1024 * 2 <= WS_KN && WS_KN + (size_t)R * 256 * 2 <= WS_MIX && WS_MIX + (size_t)R * DM * 2 <= WS_HS, "ws map 2");
static_assert(WS_X + (size_t)R * DM * 4 <= WS_H && WS_H + (size_t)R * DM * 2 <= WS_PROJ && WS_W + DEPTH * W_LAYER <= WS_X, "ws map 3");
constexpr int CW_BAR = 4096;
constexpr int CW_Q0 = 64;

constexpr int RING_BYTES = 131072, LDSCTL_OFF = RING_BYTES, MISC_OFF = LDSCTL_OFF + 320, LDS_BYTES = 147456;

#define GAS __attribute__((address_space(1)))
#define LAS __attribute__((address_space(3)))
typedef unsigned short bf16;
typedef float v4f __attribute__((ext_vector_type(4)));
typedef unsigned v4u __attribute__((ext_vector_type(4)));
typedef unsigned v2u __attribute__((ext_vector_type(2)));
typedef float v2f __attribute__((ext_vector_type(2)));
typedef GAS unsigned gu32;
#define AS4 __attribute__((address_space(4)))
typedef const AS4 unsigned char* kptr_t;
#define LDS_WAIT() asm volatile("s_waitcnt lgkmcnt(0)" ::: "memory")
__device__ __forceinline__ float bf2f(unsigned u) { return __uint_as_float(u << 16); }
__device__ __forceinline__ unsigned f2bf(float f) { unsigned u = __float_as_uint(f); return (u + 0x7fffu + ((u >> 16) & 1u)) >> 16; }
__device__ __forceinline__ unsigned pk2(float lo, float hi) { return f2bf(lo) | (f2bf(hi) << 16); }
__device__ __forceinline__ unsigned cvtpk_rne(float lo, float hi) { unsigned r; asm volatile("v_cvt_pk_bf16_f32 %0, %1, %2" : "=v"(r) : "v"(lo), "v"(hi)); return r; }
__device__ __forceinline__ float dpp_f(float v, const int ctrl_unused) { return v; }
#define DPP_ADD(v, ctrl) ((v) + __builtin_bit_cast(float, __builtin_amdgcn_update_dpp(0, __builtin_bit_cast(int, (v)), (ctrl), 0xf, 0xf, false)))
__device__ __forceinline__ float wave_sum(float v) {
    v = DPP_ADD(v, 0xB1);
    v = DPP_ADD(v, 0x4E);
    v = DPP_ADD(v, 0x141);
    v = DPP_ADD(v, 0x140);
    { auto rr = __builtin_amdgcn_permlane16_swap(__float_as_uint(v), __float_as_uint(v), false, false); v = __uint_as_float(rr[0]) + __uint_as_float(rr[1]); }
    { auto rr = __builtin_amdgcn_permlane32_swap(__float_as_uint(v), __float_as_uint(v), false, false); v = __uint_as_float(rr[0]) + __uint_as_float(rr[1]); }
    return v;
}
__device__ __forceinline__ float sigm(float z) { return __builtin_amdgcn_rcpf(1.f + __expf(-z)); }
__device__ __forceinline__ float silu_f(float z) { return z * sigm(z); }
__device__ __forceinline__ float gelu_tanh(float x) {
    const float u = 0.7978845608028654f * (x + 0.044715f * x * x * x);
    const float th = 1.f - 2.f * __builtin_amdgcn_rcpf(1.f + __expf(2.f * u));
    return 0.5f * x * (1.f + th);
}
__device__ __forceinline__ v4f mfma4(float a, float b, v4f c) { return __builtin_amdgcn_mfma_f32_16x16x4f32(a, b, c, 0, 0, 0); }

#define XB_TMO      128
#define XB_XCNT(j)  (256  + 64 * (j))
#define XB_XSUB(j)  (1280 + 64 * (j))
#define XB_XGEN(j)  (2304 + 64 * (j))
#define XB_TOP      3328
#define XB_TOPGEN   3392
#define XCD_BAR_WORDS 3456
#define XB_SPIN_CAP (1u << 18)
__device__ __forceinline__ unsigned xb_ld(unsigned* p)              { return __hip_atomic_load(p, __ATOMIC_RELAXED, __HIP_MEMORY_SCOPE_AGENT); }
__device__ __forceinline__ unsigned xb_add(unsigned* p, unsigned v) { return __hip_atomic_fetch_add(p, v, __ATOMIC_RELAXED, __HIP_MEMORY_SCOPE_AGENT); }
__device__ __forceinline__ unsigned xb_xcc_id() { return (unsigned)__builtin_amdgcn_s_getreg((3 << 11) | 20) & 0xFu; }
#define XB_SPIN(cond, bar) do { unsigned _sp = 0; while (cond) { __builtin_amdgcn_s_sleep(1); \
    if ((++_sp & 255u) == 0u) { if (xb_ld(&(bar)[XB_TMO])) break; if (_sp > XB_SPIN_CAP) { atomicAdd(&(bar)[XB_TMO], 1u); break; } } } } while (0)
struct XcdBarrier { unsigned* bar; unsigned x; volatile LAS unsigned* st; };
__device__ __forceinline__ XcdBarrier xcd_barrier_post(unsigned* bar, volatile LAS unsigned* st) {
    XcdBarrier b; b.bar = bar; b.x = xb_xcc_id(); b.st = st;
    if (threadIdx.x == 0) (void)xb_add(&bar[XB_XCNT(b.x)], 1u);
    return b;
}
__device__ __forceinline__ void xcd_barrier_complete(unsigned* bar, unsigned x, unsigned& nloc, unsigned& nx) {
    const unsigned G = gridDim.x * gridDim.y * gridDim.z;
    unsigned sum, cnt, mine, sp = 0u;
    for (;;) {
        sum = 0u; cnt = 0u; mine = 0u;
#pragma unroll
        for (unsigned j = 0; j < 16; ++j) { const unsigned c = xb_ld(&bar[XB_XCNT(j)]); sum += c; cnt += (c > 0u) ? 1u : 0u; mine = (j == x) ? c : mine; }
        if (sum == G) break;
        __builtin_amdgcn_s_sleep(1);
        if ((++sp & 255u) == 0u) { if (xb_ld(&bar[XB_TMO])) break; if (sp > XB_SPIN_CAP) { atomicAdd(&bar[XB_TMO], 1u); break; } }
    }
    nloc = mine > 0u ? mine : 1u; nx = cnt > 0u ? cnt : 1u;
}
__device__ __forceinline__ void xcd_barrier(const XcdBarrier& b) {
    asm volatile("s_waitcnt vmcnt(0)" ::: "memory");
    __syncthreads();
    if (threadIdx.x == 0) {
        unsigned* bar = b.bar;
        __builtin_amdgcn_s_waitcnt(0);
        unsigned nloc = b.st[0], nx = b.st[1];
        if (nloc == 0u) { xcd_barrier_complete(bar, b.x, nloc, nx); b.st[0] = nloc; b.st[1] = nx; }
        const unsigned old = xb_add(&bar[XB_XSUB(b.x)], 1u);
        const unsigned gen = old / nloc;
        if (old + 1u == (gen + 1u) * nloc) {
            __builtin_amdgcn_fence(__ATOMIC_RELEASE, "agent");
            asm volatile("s_waitcnt vmcnt(0)" ::: "memory");
            const unsigned og = xb_add(&bar[XB_TOP], 1u);
            const unsigned tg = og / nx;
            if (og + 1u == (tg + 1u) * nx) xb_add(&bar[XB_TOPGEN], 1u);
            else XB_SPIN(xb_ld(&bar[XB_TOPGEN]) == tg, bar);
            __builtin_amdgcn_fence(__ATOMIC_ACQUIRE, "agent");
            xb_add(&bar[XB_XGEN(b.x)], 1u);
            asm volatile("s_waitcnt vmcnt(0)" ::: "memory");
        } else {
            XB_SPIN(xb_ld(&bar[XB_XGEN(b.x)]) == gen, bar);
            __builtin_amdgcn_fence(__ATOMIC_ACQUIRE, "agent");
            asm volatile("s_waitcnt vmcnt(0)" ::: "memory");
        }
    }
    __syncthreads();
}

struct TileOrder : pg8::StaticOrder {
    bool skip;
    __device__ void init2(int N, int G_, int c_, bool skip_) { skip = skip_; init(skip_ ? NB * SEQ : R, N, G_, c_); }
    __device__ bool next(int i, pg8::Unit& u) const { if (!pg8::StaticOrder::next(i, u)) return false; if (skip) u.pm += u.pm >> 4; return true; }
};
__device__ __forceinline__ unsigned cvt_pk2(float lo, float hi) { unsigned r; asm volatile("v_cvt_pk_bf16_f32 %0, %1, %2" : "=v"(r) : "v"(lo), "v"(hi)); return r; }
template <bool MAKE_H>
struct EpiResGate {
    static constexpr bool PERM = false, AFTER_DRAIN = false;
    float* X; const float* mod_l; int jg; bf16* H; const float* gs; float* rs;
    const float* xin; const float* cin;
    __device__ __forceinline__ void operator()(const pg8::f32x4 (&acc)[2][2][4][2], const pg8::Unit& u, int wr, int wc, int fr, int fq) const {
        const int b = u.pm / 17, jt = u.pm - b * 17, mrow = (jt == 16 ? 4 : b);
        const float* gp = mod_l + (size_t)mrow * NMODC + (size_t)jg * DM;
        const float* gsp = gs + (size_t)mrow * DM;
        const int col0 = u.pn * 256 + wc * 32 + 4 * fq;
        pg8::f32x4 gv[2][2];
#pragma unroll
        for (int bj = 0; bj < 2; ++bj)
#pragma unroll
            for (int n = 0; n < 2; ++n) gv[bj][n] = *(const pg8::f32x4*)(gp + col0 + bj * 128 + n * 16);
#pragma unroll
        for (int ai = 0; ai < 2; ++ai)
#pragma unroll
            for (int m = 0; m < 4; ++m) { const int row = u.pm * 256 + ai * 128 + wr * 64 + m * 16 + fr; const size_t off = (size_t)row * DM + col0; float ss = 0.f;
                const float* src = xin ? (jt == 16 ? cin + ((size_t)b * CTXL + (row - u.pm * 256)) * DM : xin + ((size_t)b * SEQ + jt * 256 + (row - u.pm * 256)) * DM) + col0 : X + off;
#pragma unroll
                for (int bj = 0; bj < 2; ++bj)
#pragma unroll
                    for (int n = 0; n < 2; ++n) { pg8::f32x4* p = (pg8::f32x4*)(X + off + bj * 128 + n * 16); const pg8::f32x4 xn = *(const pg8::f32x4*)(src + bj * 128 + n * 16) + gv[bj][n] * acc[ai][bj][m][n]; *p = xn;
                        if (MAKE_H) { ss += (xn[0] * xn[0] + xn[1] * xn[1]) + (xn[2] * xn[2] + xn[3] * xn[3]);
                            const pg8::f32x4 hv = xn * *(const pg8::f32x4*)(gsp + col0 + bj * 128 + n * 16);
                            v2u w; w.x = cvt_pk2(hv[0], hv[1]); w.y = cvt_pk2(hv[2], hv[3]); *(v2u*)(H + off + bj * 128 + n * 16) = w; } }
                if (MAKE_H) { ss += __shfl_xor(ss, 16); ss += __shfl_xor(ss, 32); if (fq == 0) unsafeAtomicAdd(rs + row, ss); }
                if (m & 1) asm volatile("" ::: "memory"); }
    }
};
struct EpiBf16N {
    static constexpr bool PERM = true, AFTER_DRAIN = false;
    bf16* O; int ldc; const float* rs; const float* sw;
    __device__ __forceinline__ void operator()(const pg8::f32x4 (&acc)[2][2][4][2], const pg8::Unit& u, int wr, int wc, int fr, int fq) const {
        const int b = u.pm / 17, jt = u.pm - b * 17, mrow = (jt == 16 ? 4 : b);
        const int row0 = u.pm * 256 + wr * 64 + fr, col0 = u.pn * 256 + wc * 32 + 8 * fq;
        const float* swp = sw + (size_t)mrow * ldc + col0;
        pg8::f32x4 bv[2][2];
#pragma unroll
        for (int bj = 0; bj < 2; ++bj)
#pragma unroll
            for (int n = 0; n < 2; ++n) bv[bj][n] = *(const pg8::f32x4*)(swp + bj * 128 + 4 * n);
#pragma unroll
        for (int ai = 0; ai < 2; ++ai)
#pragma unroll
            for (int m = 0; m < 4; ++m) { const int row = row0 + ai * 128 + m * 16; const float rstd = 1.0f / sqrtf(rs[row] * (1.f / DM) + EPS);
                bf16* rowp = O + (size_t)row * ldc + col0;
#pragma unroll
                for (int bj = 0; bj < 2; ++bj) { const pg8::f32x4 v0 = acc[ai][bj][m][0] * rstd + bv[bj][0], v1 = acc[ai][bj][m][1] * rstd + bv[bj][1];
                    pg8::u32x4 w; w.x = cvt_pk2(v0[0], v0[1]); w.y = cvt_pk2(v0[2], v0[3]); w.z = cvt_pk2(v1[0], v1[1]); w.w = cvt_pk2(v1[2], v1[3]);
                    *(pg8::u32x4*)(rowp + bj * 128) = w; } }
    }
};

namespace att {
using bf16x8 = __attribute__((ext_vector_type(8))) short;
using s16x4  = __attribute__((ext_vector_type(4))) short;
using f32x16 = __attribute__((ext_vector_type(16))) float;
using u32x4  = __attribute__((ext_vector_type(4))) unsigned;
constexpr int   D = 128, NW = 8, QBLK = 32, KVBLK = 64;
constexpr float SCALE = 0.088388347648318440f;
constexpr float THR = 8.f;
constexpr int LDQ = 1024, LDK = 256, LDV = INC, LDO = DM;
constexpr size_t SHM_V = KVBLK * D * 2, SHM_K = KVBLK * D * 2, SHM_ATTN = 2 * SHM_V + 2 * SHM_K + NW * 64 * 4;
#define KSWZ(row, colB) ((row) * 256 + ((colB) ^ (((row) & 7) << 4)))
#define SBAR() __builtin_amdgcn_sched_barrier(0)
__device__ __forceinline__ int crow(int r, int hi) { return (r & 3) + 8 * (r >> 2) + 4 * hi; }
__device__ __forceinline__ unsigned cvtpk(float lo, float hi) { unsigned r; asm volatile("v_cvt_pk_bf16_f32 %0, %1, %2" : "=v"(r) : "v"(lo), "v"(hi)); return r; }
__device__ __forceinline__ void partialSM(f32x16& p0, f32x16& p1, float& m_reg, float& mn, float& alpha) {
  constexpr float C = SCALE * 1.4426950408889634f;
  float pmax = p0[0]; for (int r = 1; r < 16; ++r) pmax = fmaxf(pmax, p0[r]); for (int r = 0; r < 16; ++r) pmax = fmaxf(pmax, p1[r]);
  { auto rr = __builtin_amdgcn_permlane32_swap(__float_as_uint(pmax), __float_as_uint(pmax), false, false);
    pmax = fmaxf(__uint_as_float(rr[0]), __uint_as_float(rr[1])); }
  if (__builtin_expect(__all(pmax - m_reg <= THR / SCALE), 1)) { mn = m_reg; alpha = 1.f; }
  else { mn = fmaxf(m_reg, pmax); alpha = __builtin_amdgcn_exp2f((m_reg - mn) * C); m_reg = mn; }
  float mnC = -mn * C;
  for (int r = 0; r < 16; ++r) p0[r] = fmaf(p0[r], C, mnC); for (int r = 0; r < 16; ++r) p1[r] = fmaf(p1[r], C, mnC);
  for (int r = 0; r < 16; ++r) p0[r] = __builtin_amdgcn_exp2f(p0[r]);
}
__device__ __forceinline__ void finishSM(f32x16& p0, f32x16& p1, float alpha, float& l_reg, bf16x8& pa0, bf16x8& pa1, bf16x8& pa2, bf16x8& pa3) {
  for (int r = 0; r < 16; ++r) p1[r] = __builtin_amdgcn_exp2f(p1[r]);
  float ps = 0; for (int r = 0; r < 16; ++r) ps += p0[r]; for (int r = 0; r < 16; ++r) ps += p1[r];
  { auto rr = __builtin_amdgcn_permlane32_swap(__float_as_uint(ps), __float_as_uint(ps), false, false);
    ps = __uint_as_float(rr[0]) + __uint_as_float(rr[1]); }
  l_reg = l_reg * alpha + ps;
#define PK4(P, BASE, OUT) do { unsigned a0 = cvtpk(P[BASE + 0], P[BASE + 1]), a1 = cvtpk(P[BASE + 2], P[BASE + 3]);   \
    unsigned b0 = cvtpk(P[BASE + 4], P[BASE + 5]), b1 = cvtpk(P[BASE + 6], P[BASE + 7]);                              \
    auto r0 = __builtin_amdgcn_permlane32_swap(a0, b0, false, false); auto r1 = __builtin_amdgcn_permlane32_swap(a1, b1, false, false); \
    u32x4 w = {r0[0], r1[0], r0[1], r1[1]}; OUT = *reinterpret_cast<bf16x8*>(&w); } while (0)
  PK4(p0, 0, pa0); PK4(p0, 8, pa1); PK4(p1, 0, pa2); PK4(p1, 8, pa3);
#undef PK4
}
__device__ __forceinline__ void qkt(f32x16& p0, f32x16& p1, const bf16* Ks, const bf16x8* qr, int r32, int hi) {
  p0 = f32x16{}; p1 = f32x16{};
  for (int d0 = 0; d0 < 8; ++d0) { int cb = (d0 * 16 + hi * 8) * 2;
    bf16x8 b0 = *reinterpret_cast<const bf16x8*>((const char*)Ks + KSWZ(r32, cb));
    bf16x8 b1 = *reinterpret_cast<const bf16x8*>((const char*)Ks + KSWZ(32 + r32, cb));
    p0 = __builtin_amdgcn_mfma_f32_32x32x16_bf16(b0, qr[d0], p0, 0, 0, 0);
    p1 = __builtin_amdgcn_mfma_f32_32x32x16_bf16(b1, qr[d0], p1, 0, 0, 0); }
}
__device__ __forceinline__ int v_st(int k, int c) { const int kk = (k & ~0xC) | ((k & 4) << 1) | ((k & 8) >> 1); return ((kk >> 3) * 4 + (c >> 5)) * 512 + ((kk & 7) * 32 + (c & 31)) * 2; }
__device__ __forceinline__ int v_rd_base(int lane) { return ((lane & 3) << 3) | (((lane >> 2) & 3) << 6) | (((lane >> 4) & 1) << 5) | (((lane >> 5) & 1) << 8); }
constexpr int v_rd_off(int d0, int ks, int half) { return d0 * 512 + ks * 4096 + half * 2048; }
template <int OFF> __device__ __forceinline__ s16x4 tr_read(int vb) {
  s16x4 r; asm volatile("ds_read_b64_tr_b16 %0, %1 offset:%2" : "=&v"(r) : "v"(vb), "i"(OFF) : "memory"); return r;
}
template <int D0> __device__ __forceinline__ void pv_one(f32x16& od, int vb, bf16x8 pa0, bf16x8 pa1, bf16x8 pa2, bf16x8 pa3) {
  const s16x4 l0 = tr_read<v_rd_off(D0, 0, 0)>(vb), h0 = tr_read<v_rd_off(D0, 0, 1)>(vb), l1 = tr_read<v_rd_off(D0, 1, 0)>(vb), h1 = tr_read<v_rd_off(D0, 1, 1)>(vb);
  const s16x4 l2 = tr_read<v_rd_off(D0, 2, 0)>(vb), h2 = tr_read<v_rd_off(D0, 2, 1)>(vb), l3 = tr_read<v_rd_off(D0, 3, 0)>(vb), h3 = tr_read<v_rd_off(D0, 3, 1)>(vb);
  asm volatile("s_waitcnt lgkmcnt(0)" ::: "memory"); SBAR();
#define PK(L, H) (bf16x8){L[0], L[1], L[2], L[3], H[0], H[1], H[2], H[3]}
  od = __builtin_amdgcn_mfma_f32_32x32x16_bf16(pa0, PK(l0, h0), od, 0, 0, 0);
  od = __builtin_amdgcn_mfma_f32_32x32x16_bf16(pa1, PK(l1, h1), od, 0, 0, 0);
  od = __builtin_amdgcn_mfma_f32_32x32x16_bf16(pa2, PK(l2, h2), od, 0, 0, 0);
  od = __builtin_amdgcn_mfma_f32_32x32x16_bf16(pa3, PK(l3, h3), od, 0, 0, 0);
#undef PK
}
__device__ __forceinline__ void pv_d0(f32x16* o, int vb, bf16x8 pa0, bf16x8 pa1, bf16x8 pa2, bf16x8 pa3) {
  pv_one<0>(o[0], vb, pa0, pa1, pa2, pa3); pv_one<1>(o[1], vb, pa0, pa1, pa2, pa3); pv_one<2>(o[2], vb, pa0, pa1, pa2, pa3); pv_one<3>(o[3], vb, pa0, pa1, pa2, pa3);
}
__device__ __forceinline__ void attn_dense_body(const bf16* __restrict__ Qb, const bf16* __restrict__ Kh, const bf16* __restrict__ Vh,
                                                bf16* __restrict__ Ob, int seq, char* lds) {
  int tid_l = threadIdx.x; asm volatile("" : "+v"(tid_l)); const int tid = tid_l, wid = tid >> 6, lane = tid & 63, r32 = lane & 31, hi = lane >> 5;
  bf16* V_lds = (bf16*)lds; bf16* K_lds = (bf16*)(lds + 2 * SHM_V);
  float* ws = (float*)(lds + 2 * SHM_V + 2 * SHM_K) + wid * 64; float* li_l = ws; float* al_l = ws + 32;
  float m_reg = -1e30f, l_reg = 0; f32x16 o[4] = {}; bf16x8 qr[8];
  const bf16* Qw = Qb + (long)(wid * QBLK + r32) * LDQ + hi * 8;
#pragma unroll
  for (int d0 = 0; d0 < 8; ++d0) qr[d0] = *reinterpret_cast<const bf16x8*>(Qw + d0 * 16);
  const int sr = tid >> 4, sc = (tid & 15) * 8, vst0 = v_st(sr, sc), vst1 = v_st(32 + sr, sc);
  const int vb0 = (int)(uintptr_t)V_lds + v_rd_base(lane);
  struct { bf16x8 vs0, vs1, ks0, ks1; } sr_[2];
#define SLOAD(i, k0) do { sr_[i].vs0 = *reinterpret_cast<const bf16x8*>(&Vh[(long)((k0) + sr) * LDV + sc]); sr_[i].vs1 = *reinterpret_cast<const bf16x8*>(&Vh[(long)((k0) + 32 + sr) * LDV + sc]); \
    sr_[i].ks0 = *reinterpret_cast<const bf16x8*>(&Kh[(long)((k0) + sr) * LDK + sc]); sr_[i].ks1 = *reinterpret_cast<const bf16x8*>(&Kh[(long)((k0) + 32 + sr) * LDK + sc]); } while (0)
#define SWRITE(b, i) do { *(bf16x8*)((char*)V_lds + (b) * SHM_V + vst0) = sr_[i].vs0;          \
    *(bf16x8*)((char*)V_lds + (b) * SHM_V + vst1) = sr_[i].vs1; int kc = sc * 2;               \
    *(bf16x8*)((char*)K_lds + (b) * SHM_K + KSWZ(sr, kc)) = sr_[i].ks0;                       \
    *(bf16x8*)((char*)K_lds + (b) * SHM_K + KSWZ(32 + sr, kc)) = sr_[i].ks1; } while (0)
#define SWAIT() asm volatile("s_waitcnt vmcnt(4)" ::: "memory")
#define RESC(a) do { if (__any((a) < 1.f)) { if (hi == 0) al_l[r32] = (a); asm volatile("s_waitcnt lgkmcnt(0)" ::: "memory"); \
    for (int d = 0; d < 4; ++d) for (int r = 0; r < 16; ++r) o[d][r] *= al_l[crow(r, hi)]; } } while (0)
  f32x16 pA0, pA1, pB0, pB1; float mnA, mnB, alA, alB; bf16x8 pa0, pa1, pa2, pa3; const int NT = seq / KVBLK;
  constexpr int SE = 0, SO = 1;
  SLOAD(SE, 0); asm volatile("s_waitcnt vmcnt(0)" ::: "memory"); SWRITE(0, SE); __syncthreads();
  qkt(pA0, pA1, K_lds, qr, r32, hi); partialSM(pA0, pA1, m_reg, mnA, alA);
  SLOAD(SO, KVBLK); if (2 < NT) SLOAD(SE, 2 * KVBLK);
  SWAIT(); SWRITE(1, SO); __syncthreads();
  for (int j = 1; j + 1 < NT; j += 2) {
    SBAR(); qkt(pB0, pB1, (bf16*)((char*)K_lds + SHM_K), qr, r32, hi);
    finishSM(pA0, pA1, alA, l_reg, pa0, pa1, pa2, pa3); SBAR();
    SLOAD(SO, (j + 2) * KVBLK); SBAR();
    pv_d0(o, vb0, pa0, pa1, pa2, pa3); partialSM(pB0, pB1, m_reg, mnB, alB);
    __syncthreads(); SWAIT(); SWRITE(0, SE);
    RESC(alB); __syncthreads();
    SBAR(); qkt(pA0, pA1, K_lds, qr, r32, hi);
    finishSM(pB0, pB1, alB, l_reg, pa0, pa1, pa2, pa3); SBAR();
    if (j + 3 < NT) SLOAD(SE, (j + 3) * KVBLK); SBAR();
    pv_d0(o, vb0 + (int)SHM_V, pa0, pa1, pa2, pa3); partialSM(pA0, pA1, m_reg, mnA, alA);
    __syncthreads(); SWAIT(); SWRITE(1, SO);
    RESC(alA); __syncthreads();
  }
  SBAR(); qkt(pB0, pB1, (bf16*)((char*)K_lds + SHM_K), qr, r32, hi);
  finishSM(pA0, pA1, alA, l_reg, pa0, pa1, pa2, pa3); SBAR();
  pv_d0(o, vb0, pa0, pa1, pa2, pa3); partialSM(pB0, pB1, m_reg, mnB, alB);
  __syncthreads(); RESC(alB);
  finishSM(pB0, pB1, alB, l_reg, pa0, pa1, pa2, pa3); SBAR();
  pv_d0(o, vb0 + (int)SHM_V, pa0, pa1, pa2, pa3);
  if (hi == 0) li_l[r32] = l_reg; asm volatile("s_waitcnt lgkmcnt(0)" ::: "memory");
  float rli[16];
#pragma unroll
  for (int r = 0; r < 16; ++r) rli[r] = __builtin_amdgcn_rcpf(li_l[crow(r, hi)]);
  bf16* Ow = Ob + (long)(wid * QBLK) * LDO;
#pragma unroll
  for (int r = 0; r < 16; ++r) { int orow = crow(r, hi);
    for (int d0 = 0; d0 < 4; ++d0) Ow[(long)orow * LDO + d0 * 32 + r32] = (bf16)f2bf(o[d0][r] * rli[r]); }
  __syncthreads();
#undef SLOAD
#undef SWRITE
#undef SWAIT
#undef RESC
}
}

struct Args { const float* in[22]; float* out; unsigned char* ws; int ph_lo, ph_hi; };
enum { I_X = 0, I_C, I_CTX, I_CCTX, I_WADA, I_BADA, I_N1G, I_WIN, I_QG, I_KG, I_LBP, I_HGG, I_SGG, I_SGW, I_SGB, I_WOUT, I_N2G, I_WUP, I_CW, I_CB, I_WDN, I_FNG };

__device__ __forceinline__ void p0_mod(const float* cin, const float* ccin, const float* wada, const float* bada, LAS unsigned char* lds, float* MOD, int tid, int lane, int wave, int bx, int G) {
    LAS float* sc = (LAS float*)lds;
    LAS float* red = (LAS float*)(lds + 40960);
    for (int i = tid; i < 5 * DM; i += NTHR) { const int r = i >> 11, k = i & 2047; const float v = r < 4 ? cin[r * DM + k] : ccin[k]; sc[i] = silu_f(v); }
    __syncthreads();
    for (int it = bx; it < 768; it += G) {
        const int cb = it >> 2, kq = it & 3, l = cb / 48, n0 = (cb % 48) * 256, kbase = 512 * kq + 64 * wave;
        const float* wp = wada + ((size_t)l * DM + kbase) * NMODC + n0 + 4 * lane;
        v4f acc[5];
#pragma unroll
        for (int r = 0; r < 5; ++r) acc[r] = (v4f){0.f, 0.f, 0.f, 0.f};
#pragma unroll 16
        for (int k = 0; k < 64; ++k) {
            const v4f w = *(const v4f*)(wp + (size_t)k * NMODC);
#pragma unroll
            for (int r = 0; r < 5; ++r) { const float s = sc[r * DM + kbase + k]; acc[r] += w * s; }
        }
#pragma unroll
        for (int r = 0; r < 5; ++r) *(LAS v4f*)(red + (wave * 5 + r) * 256 + 4 * lane) = acc[r];
        __syncthreads();
        for (int o = tid; o < 1280; o += NTHR) { const int r = o >> 8, ci = o & 255; float s = (kq == 0) ? bada[l * NMODC + n0 + ci] : 0.f;
#pragma unroll
            for (int w = 0; w < 8; ++w) s += red[(w * 5 + r) * 256 + ci];
            unsafeAtomicAdd(MOD + (size_t)(l * 5 + r) * NMODC + n0 + ci, s); }
        __syncthreads();
    }
}
template <bool SWACC>
__device__ __forceinline__ void p0_transpose_item(const float* W, int K, int N, bf16* WT, LAS float* scr, int item, int lane, float* sw, const float* sh) {
    const int nblk = N / 32, kb = item / nblk, nb = item % nblk, k0 = 64 * kb, n0 = 32 * nb;
#pragma unroll 8
    for (int i = 0; i < 32; ++i) { const int kk = 2 * i + (lane >> 5); scr[kk * 33 + (lane & 31)] = W[(size_t)(k0 + kk) * N + n0 + (lane & 31)]; }
    LDS_WAIT(); asm volatile("" ::: "memory");
    const int c = lane & 7;
#pragma unroll
    for (int j = 0; j < 4; ++j) { const int n = (lane >> 3) + 8 * j; const LAS float* s = scr + (8 * c) * 33 + n;
        v4u o; o.x = pk2(s[0 * 33], s[1 * 33]); o.y = pk2(s[2 * 33], s[3 * 33]); o.z = pk2(s[4 * 33], s[5 * 33]); o.w = pk2(s[6 * 33], s[7 * 33]);
        *(GAS v4u*)(WT + (size_t)(n0 + n) * K + k0 + 8 * c) = o; }
    if (SWACC) {
        const int n = lane & 31, kh = lane >> 5; float s5[5] = {0.f, 0.f, 0.f, 0.f, 0.f};
        const float* shp = sh + k0 + 32 * kh; const LAS float* tp = scr + (32 * kh) * 33 + n;
#pragma unroll
        for (int q = 0; q < 8; ++q) { const float w0 = tp[(4 * q) * 33], w1 = tp[(4 * q + 1) * 33], w2 = tp[(4 * q + 2) * 33], w3 = tp[(4 * q + 3) * 33];
#pragma unroll
            for (int r = 0; r < 5; ++r) { const v4f s = *(const v4f*)(shp + (size_t)r * NMODC + 4 * q); s5[r] += (s.x * w0 + s.y * w1) + (s.z * w2 + s.w * w3); } }
#pragma unroll
        for (int r = 0; r < 5; ++r) { s5[r] += __shfl_xor(s5[r], 32); if (lane < 32) unsafeAtomicAdd(sw + (size_t)r * N + n0 + n, s5[r]); }
    }
    LDS_WAIT(); asm volatile("" ::: "memory");
}
constexpr int CI_IN = (DM / 64) * (INC / 32), CI_OUT = (DM / 64) * (DM / 32), CI_UP = (DM / 64) * (UPC / 32), CI_DN = (DFF / 64) * (DM / 32);
template <int SEL>
__device__ __forceinline__ void convert_item(int l, int r, kptr_t kp, unsigned char* ws, LAS float* scr, int lane);
template <int SEL> constexpr int convert_count() { return ((SEL & 1) ? CI_IN : 0) + ((SEL & 2) ? CI_OUT : 0) + ((SEL & 4) ? CI_UP : 0) + ((SEL & 8) ? CI_DN : 0); }
__device__ __forceinline__ void norm_phase(const float* X, bf16* H, const float* g, const float* mod_l, int jshift, int jscale, bool skip_ctx, int gw, int NGW, int lane) {
    for (int m = gw; m < R; m += NGW) {
        const int b = m / TB, t = m - b * TB; const bool isc = t >= SEQ; if (isc && skip_ctx) continue;
        const float* mrow = mod_l + (size_t)(isc ? 4 : b) * NMODC;
        const v4f* xr = (const v4f*)(X + (size_t)m * DM) + lane;
        v4f v[8]; float ss = 0.f;
#pragma unroll
        for (int j = 0; j < 8; ++j) { v[j] = xr[64 * j]; ss += (v[j].x * v[j].x + v[j].y * v[j].y) + (v[j].z * v[j].z + v[j].w * v[j].w); }
        const float rstd = 1.0f / sqrtf(wave_sum(ss) * (1.f / DM) + EPS);
#pragma unroll
        for (int j = 0; j < 8; ++j) { const int c = 4 * lane + 256 * j;
            const v4f gg = *(const v4f*)(g + c), sh = *(const v4f*)(mrow + jshift * DM + c), sc = *(const v4f*)(mrow + jscale * DM + c);
            const v4f y = v[j] * rstd * gg * (1.f + sc) + sh;
            v2u w; w.x = pk2(y.x, y.y); w.y = pk2(y.z, y.w);
            *(v2u*)(H + (size_t)m * DM + c) = w; }
    }
}
__device__ __forceinline__ void qknorm_phase(const bf16* PROJ, bf16* QN, bf16* KN, const float* qg, const float* kg, const float* rcos, const float* rsin, int gw, int NGW, int lane) {
    const float qg0 = qg[2 * lane], qg1 = qg[2 * lane + 1], kg0 = kg[2 * lane], kg1 = kg[2 * lane + 1];
#pragma unroll 1
    for (int m0 = 4 * gw; m0 < R; m0 += 4 * NGW) {
        unsigned w2[4][10];
#pragma unroll
        for (int rr = 0; rr < 4; ++rr)
#pragma unroll
            for (int hh = 0; hh < 10; ++hh) w2[rr][hh] = *(const unsigned*)(PROJ + (size_t)(m0 + rr) * INC + hh * 128 + 2 * lane);
#pragma unroll
        for (int rr = 0; rr < 4; ++rr) {
            const int m = m0 + rr, b = m / TB, t = m - b * TB; const bool lat = t < SEQ;
            float cs = 1.f, sn = 0.f;
            if (lat) { const int pos = (lane < 32) ? (t >> 6) : (t & 63); cs = rcos[pos * 32 + (lane & 31)]; sn = rsin[pos * 32 + (lane & 31)]; }
#pragma unroll
            for (int hh = 0; hh < 10; ++hh) {
                const float x1 = bf2f(w2[rr][hh] & 0xffffu), x2 = bf2f(w2[rr][hh] >> 16);
                const float rstd = __builtin_amdgcn_rsqf(wave_sum(x1 * x1 + x2 * x2) * (1.f / 128.f) + EPS);
                const float y1 = x1 * rstd * (hh < 8 ? qg0 : kg0), y2 = x2 * rstd * (hh < 8 ? qg1 : kg1);
                const float o1 = y1 * cs - y2 * sn, o2 = y1 * sn + y2 * cs;
                bf16* dst = hh < 8 ? QN + (size_t)m * 1024 + hh * 128 + 2 * lane : KN + (size_t)m * 256 + (hh - 8) * 128 + 2 * lane;
                *(unsigned*)dst = cvtpk_rne(o1, o2);
            }
        }
    }
}
typedef short hbf16x8 __attribute__((ext_vector_type(8)));
__device__ __forceinline__ v4f mfma_bf(v4u a, v4u b, v4f c) { return __builtin_amdgcn_mfma_f32_16x16x32_bf16(__builtin_bit_cast(hbf16x8, a), __builtin_bit_cast(hbf16x8, b), c, 0, 0, 0); }
__device__ __forceinline__ unsigned cvtpk_hw(float lo, float hi) { unsigned r; asm volatile("v_cvt_pk_bf16_f32 %0, %1, %2" : "=v"(r) : "v"(lo), "v"(hi)); return r; }
constexpr int SG_PB = 272;
__device__ __forceinline__ void sg_unit(int b, int n, int g, int l, const bf16* PROJ, bf16* MIX, const float* sgg, const float* sgw, const float* sgb, LAS unsigned char* Vt, int tid, int lane, int wave) {
    const int row0 = b * TB + n * 128, c4 = lane >> 4, l15 = lane & 15;
    v4u wf[4];
    {   const float* W = sgw + ((size_t)(l * 4 + g) * 128 + 16 * wave + l15) * 128 + 8 * c4;
#pragma unroll
        for (int ks = 0; ks < 4; ++ks) { const v4f a0 = *(const v4f*)(W + 32 * ks), a1 = *(const v4f*)(W + 32 * ks + 4);
            wf[ks].x = cvtpk_hw(a0.x, a0.y); wf[ks].y = cvtpk_hw(a0.z, a0.w); wf[ks].z = cvtpk_hw(a1.x, a1.y); wf[ks].w = cvtpk_hw(a1.z, a1.w); } }
    const size_t orow = (size_t)(row0 + 16 * wave + l15);
    v2u uraw[8];
#pragma unroll
    for (int dt = 0; dt < 8; ++dt) uraw[dt] = *(const v2u*)(PROJ + orow * INC + C_SU + g * 128 + 16 * dt + 4 * c4);
    const float bsv = sgb[(l * 4 + g) * 128 + 16 * wave + l15];
    {
        const int s = tid >> 2, q = tid & 3;
        const v4u* src = (const v4u*)(PROJ + (size_t)(row0 + s) * INC + C_SV + g * 128 + 32 * q);
        float ge[32]; float ss = 0.f;
#pragma unroll
        for (int i = 0; i < 4; ++i) { const v4u w = src[i];
#pragma unroll
            for (int e = 0; e < 4; ++e) { const float a0 = gelu_tanh(bf2f(w[e] & 0xffffu)), a1 = gelu_tanh(bf2f(w[e] >> 16)); ge[8 * i + 2 * e] = a0; ge[8 * i + 2 * e + 1] = a1; ss += a0 * a0 + a1 * a1; } }
        ss += __shfl_xor(ss, 1); ss += __shfl_xor(ss, 2);
        const float rstd = 1.0f / sqrtf(ss * (1.f / 128.f) + EPS);
        const float* gp = sgg + g * 128 + 32 * q;
#pragma unroll
        for (int i = 0; i < 32; ++i) *(LAS bf16*)(Vt + (32 * q + i) * SG_PB + 2 * s) = (bf16)(cvtpk_hw(ge[i] * rstd * gp[i], 0.f) & 0xffffu);
    }
    __syncthreads();
#pragma unroll
    for (int dt = 0; dt < 8; ++dt) {
        v4f acc = (v4f){0.f, 0.f, 0.f, 0.f};
#pragma unroll
        for (int ks = 0; ks < 4; ++ks) acc = mfma_bf(*(const LAS v4u*)(Vt + (16 * dt + l15) * SG_PB + (32 * ks + 8 * c4) * 2), wf[ks], acc);
        const float u0 = gelu_tanh(bf2f(uraw[dt].x & 0xffffu)), u1 = gelu_tanh(bf2f(uraw[dt].x >> 16)), u2 = gelu_tanh(bf2f(uraw[dt].y & 0xffffu)), u3 = gelu_tanh(bf2f(uraw[dt].y >> 16));
        v2u o; o.x = cvtpk_hw(u0 * (acc[0] + bsv), u1 * (acc[1] + bsv)); o.y = cvtpk_hw(u2 * (acc[2] + bsv), u3 * (acc[3] + bsv));
        *(v2u*)(MIX + orow * DM + 1536 + g * 128 + 16 * dt + 4 * c4) = o;
    }
    __syncthreads();
}

__device__ __forceinline__ int hg_row(int b, int dir, int P) {
    if (P < CTXL) return b * TB + SEQ + (dir ? CTXL - 1 - P : P);
    const int t = P - CTXL; return b * TB + (dir ? SEQ - 1 - t : t);
}
constexpr int NCH = 136, SCH = 17, NSC = NCH / SCH;
constexpr size_t WS_QF = 966 * MiB, WS_KF = 1000 * MiB, WS_VF = 1034 * MiB, WS_PF = 1068 * MiB, WS_DF = 1077 * MiB;
static_assert(WS_DF + (size_t)32 * NCH * 512 <= WS_GS, "fragment buffers inside the mixer-half scratch");
constexpr int PL_DD = 53248  , PL_T = 0, PL_QF = 4096, PL_KF = PL_QF + 8192, PL_VF = PL_KF + 8192, PL_PF = PL_VF + 8192, PL_QP = PL_PF + 2048, PL_KP1 = PL_QP + 8704, PL_KP0 = PL_KP1 + 8704;

__device__ __forceinline__ unsigned bf1(float x) { return cvtpk_hw(x, 0.f) & 0xffffu; }
__device__ __forceinline__ void hgrn_pre(int l, const bf16* PROJ, const float* LBS, unsigned char* QF, unsigned char* KF, unsigned char* VF, unsigned char* PF, float* DF, float* HS, float* HD,
                                         LAS unsigned char* L, int bx, int G, int tid, int lane, int wave) {
    const int kp = lane, jj = wave, c4 = lane >> 4, l15 = lane & 15;
    constexpr float LOG2E = 1.4426950408889634f, CLAMP2 = 115.f;
    LAS v2f* T = (LAS v2f*)(L + PL_T);
    unsigned zr[4], qr[4], vr[4];
#define PRE_LOAD(it_) do { const int ch_ = (it_) / NCH, ci_ = (it_) - ch_ * NCH, dir_ = ch_ & 1, bh_ = ch_ >> 1, h_ = bh_ & 3; \
        const bf16* pr_ = PROJ + (size_t)hg_row(bh_ >> 2, dir_, 32 * ci_ + 4 * jj) * INC + h_ * 128 + 2 * kp; const long st_ = dir_ ? -(long)INC : (long)INC; const int cf_ = dir_ ? C_HFB : C_HFF; \
        _Pragma("unroll") for (int i = 0; i < 4; ++i) { zr[i] = *(const unsigned*)(pr_ + cf_); qr[i] = *(const unsigned*)(pr_ + C_HQ); vr[i] = *(const unsigned*)(pr_ + C_HI); pr_ += st_; } } while (0)
#pragma unroll 1
    for (int s = bx; s < 32 * NSC; s += G) {
    v4f acc[8], dprod[8];
#pragma unroll
    for (int kt = 0; kt < 8; ++kt) { acc[kt] = (v4f){0.f, 0.f, 0.f, 0.f}; dprod[kt] = (v4f){1.f, 1.f, 1.f, 1.f}; }
    const int it0 = (s >> 3) * NCH + (s & 7) * SCH;
    PRE_LOAD(it0);
#pragma unroll 1
    for (int it = it0; it < it0 + SCH; ++it) {
        const int chain = it / NCH;
        const int dir = chain & 1, h = (chain >> 1) & 3;
        const v2f lb2 = *(const v2f*)(LBS + (dir * DEPTH + l) * 512 + h * 128 + 2 * kp);
        float cs[2][4], kk[2][4], qq[2][4];
#pragma unroll
        for (int i = 0; i < 4; ++i)
#pragma unroll
            for (int e = 0; e < 2; ++e) {
                float z = bf2f(e ? zr[i] >> 16 : zr[i] & 0xffffu); z = fminf(fmaxf(z, -40.f), 40.f);
                const float q = bf2f(e ? qr[i] >> 16 : qr[i] & 0xffffu);
                qq[e][i] = q * __builtin_amdgcn_rcpf(1.f + __builtin_amdgcn_exp2f(-q * LOG2E));
                const float lb = e ? lb2.y : lb2.x, oml = 1.f - lb;
                const float ez = __builtin_amdgcn_exp2f(-z * LOG2E), sg = __builtin_amdgcn_rcpf(1.f + ez);
                cs[e][i] = __builtin_amdgcn_logf(fmaxf(lb + oml * sg, 1e-30f)); kk[e][i] = oml * ez * sg;
            }
        v2u vfa, vfb;
        vfa.x = (vr[0] & 0xffffu) | (vr[1] << 16); vfa.y = (vr[2] & 0xffffu) | (vr[3] << 16);
        vfb.x = (vr[0] >> 16) | (vr[1] & 0xffff0000u); vfb.y = (vr[2] >> 16) | (vr[3] & 0xffff0000u);
        if (it + 1 < it0 + SCH) PRE_LOAD(it + 1);
#pragma unroll
        for (int e = 0; e < 2; ++e)
#pragma unroll
            for (int i = 1; i < 4; ++i) cs[e][i] += cs[e][i - 1];
        T[jj * 64 + kp] = (v2f){cs[0][3], cs[1][3]};
        __syncthreads();
        v2f pre = (v2f){0.f, 0.f}, bend = pre, b15 = pre;
#pragma unroll
        for (int w = 0; w < 8; ++w) { const v2f t = T[w * 64 + kp]; bend += t; if (w < 4) b15 += t; if (w < jj) pre += t; }
        LAS unsigned char* qfp = L + PL_QF + (((jj >> 2) * 4 + (kp >> 4)) * 64 + ((kp >> 1) & 3) * 16 + 4 * (jj & 3)) * 16 + (4 * ((kp >> 3) & 1) + 2 * (kp & 1)) * 2;
        LAS unsigned char* qpp = L + PL_QP + (4 * jj) * 272 + 4 * kp;
        float kh[2][4];
#pragma unroll
        for (int i = 0; i < 4; ++i) {
            float qt[2], qp[2], kp1[2], kp0[2];
#pragma unroll
            for (int e = 0; e < 2; ++e) {
                const float bi = (e ? pre.y : pre.x) + cs[e][i], be = e ? bend.y : bend.x, bm = e ? b15.y : b15.x;
                qt[e] = qq[e][i] * __builtin_amdgcn_exp2f(bi);
                kh[e][i] = kk[e][i] * __builtin_amdgcn_exp2f(be - bi);
                qp[e] = (jj < 4) ? qt[e] : qq[e][i] * __builtin_amdgcn_exp2f(bi - bm);
                kp1[e] = kk[e][i] * __builtin_amdgcn_exp2f(fminf(bm - bi, CLAMP2));
                kp0[e] = (jj < 4) ? kk[e][i] * __builtin_amdgcn_exp2f(fminf(-bi, CLAMP2)) : 0.f;
            }
            *(LAS unsigned*)(qfp + i * 16) = cvtpk_hw(qt[0], qt[1]);
            *(LAS unsigned*)(qpp + i * 272) = cvtpk_hw(qp[0], qp[1]);
            *(LAS unsigned*)(qpp + (PL_KP1 - PL_QP) + i * 272) = cvtpk_hw(kp1[0], kp1[1]);
            if (jj < 4) *(LAS unsigned*)(qpp + (PL_KP0 - PL_QP) + i * 272) = cvtpk_hw(kp0[0], kp0[1]);
        }
        {
            const int ka = 2 * kp, fo = ((ka >> 4) * 64 + (jj >> 1) * 16 + (ka & 15)) * 16 + 8 * (jj & 1);
            v2u w0, w1; w0.x = cvtpk_hw(kh[0][0], kh[0][1]); w0.y = cvtpk_hw(kh[0][2], kh[0][3]); w1.x = cvtpk_hw(kh[1][0], kh[1][1]); w1.y = cvtpk_hw(kh[1][2], kh[1][3]);
            *(LAS v2u*)(L + PL_KF + fo) = w0; *(LAS v2u*)(L + PL_KF + fo + 16) = w1;
            *(LAS v2u*)(L + PL_VF + fo) = vfa; *(LAS v2u*)(L + PL_VF + fo + 16) = vfb; }
        if (jj == 0) { const v2f dd = (v2f){__builtin_amdgcn_exp2f(bend.x), __builtin_amdgcn_exp2f(bend.y)}; *(v2f*)(DF + (size_t)it * 128 + 2 * kp) = dd; *(LAS v2f*)(L + PL_DD + 8 * kp) = dd; }
        __syncthreads();
        if (wave < 3) {
            const LAS unsigned char* qa = L + PL_QP + ((wave == 0 ? 0 : 16) + l15) * 272 + c4 * 16;
            const LAS unsigned char* kb = (wave == 0 ? L + PL_KP0 + l15 * 272 : L + PL_KP1 + ((wave == 2 ? 16 : 0) + l15) * 272) + c4 * 16;
            v4f p = (v4f){0.f, 0.f, 0.f, 0.f};
#pragma unroll
            for (int s = 0; s < 4; ++s) p = mfma_bf(*(const LAS v4u*)(qa + s * 64), *(const LAS v4u*)(kb + s * 64), p);
            const int mt = wave == 0 ? 0 : 1, sidx = (wave == 2 ? 16 : 0) + l15;
#pragma unroll
            for (int r = 0; r < 4; ++r) { const int tl = 4 * c4 + r; const float v = (wave == 1 || l15 <= tl) ? p[r] : 0.f;
                *(LAS bf16*)(L + PL_PF + (mt * 64 + (sidx >> 3) * 16 + tl) * 16 + (sidx & 7) * 2) = (bf16)bf1(v); }
        } else if (wave == 3) {
            if (lane < 32) { unsigned zz; asm volatile("v_mov_b32 %0, 0" : "=v"(zz)); *(LAS v4u*)(L + PL_PF + (32 + lane) * 16) = (v4u){zz, zz, zz, zz}; }
        }
        __syncthreads();
        if ((s & 7) < NSC - 1) {
            const v4u vfr = *(const LAS v4u*)(L + PL_VF + (wave * 64 + lane) * 16);
#pragma unroll
            for (int kt = 0; kt < 8; ++kt) { const v4f d = *(const LAS v4f*)(L + PL_DD + (16 * kt + 4 * c4) * 4);
                acc[kt] = acc[kt] * d; acc[kt] = mfma_bf(*(const LAS v4u*)(L + PL_KF + (kt * 64 + lane) * 16), vfr, acc[kt]); dprod[kt] = dprod[kt] * d; }
        }
        *(v4u*)(QF + (size_t)it * 8192 + tid * 16) = *(const LAS v4u*)(L + PL_QF + tid * 16);
        *(v4u*)(KF + (size_t)it * 8192 + tid * 16) = *(const LAS v4u*)(L + PL_KF + tid * 16);
        *(v4u*)(VF + (size_t)it * 8192 + tid * 16) = *(const LAS v4u*)(L + PL_VF + tid * 16);
        if (tid < 128) *(v4u*)(PF + (size_t)it * 2048 + tid * 16) = *(const LAS v4u*)(L + PL_PF + tid * 16);
    }
    if ((s & 7) < NSC - 1) {
        float* slot = HS + (size_t)s * 16384;
#pragma unroll
        for (int kt = 0; kt < 8; ++kt)
#pragma unroll
            for (int r = 0; r < 4; ++r) slot[(16 * kt + 4 * c4 + r) * 128 + 16 * wave + l15] = acc[kt][r];
        if (wave == 0 && l15 == 0) {
#pragma unroll
            for (int kt = 0; kt < 8; ++kt) *(v4f*)(HD + (size_t)s * 128 + 16 * kt + 4 * c4) = dprod[kt];
        }
    }
    __syncthreads();
    }
#undef PRE_LOAD
}
constexpr int HU_Q = 0, HU_K = 8192, HU_P = 16384, HU_D = 18432, HU_SLOT = 18944;
template <bool WITH_OUT>
__device__ __forceinline__ void hgrn_unit2(int chain, int sc, const unsigned char* QF, const unsigned char* KF, const unsigned char* VF, const unsigned char* PF, const float* DF,
                                           float* HS, float* HD, float* HO, LAS unsigned char* L, int tid, int lane, int wave) {
    const int dir = chain & 1, bh = chain >> 1, b = bh >> 2, h = bh & 3, c4 = lane >> 4, l15 = lane & 15;
    v4f acc[8], dprod[8];
    const size_t item0 = (size_t)chain * NCH + sc * SCH;
    v4u rq, rk, rp, rd;
#define HU_LOAD(it_) do { if (WITH_OUT) rq = *(const v4u*)(QF + (it_) * 8192 + tid * 16); rk = *(const v4u*)(KF + (it_) * 8192 + tid * 16); \
        if (WITH_OUT && tid < 128) rp = *(const v4u*)(PF + (it_) * 2048 + tid * 16); if (tid < 32) rd = *(const v4u*)((const unsigned char*)DF + (it_) * 512 + tid * 16); } while (0)
#define HU_WRITE(s_) do { LAS unsigned char* sl_ = L + (s_) * HU_SLOT; if (WITH_OUT) *(LAS v4u*)(sl_ + HU_Q + tid * 16) = rq; *(LAS v4u*)(sl_ + HU_K + tid * 16) = rk; \
        if (WITH_OUT && tid < 128) *(LAS v4u*)(sl_ + HU_P + tid * 16) = rp; if (tid < 32) *(LAS v4u*)(sl_ + HU_D + tid * 16) = rd; } while (0)
    HU_LOAD(item0);
    v4u vf = ((const v4u*)(VF + item0 * 8192))[wave * 64 + lane];
    if (WITH_OUT && sc > 0) {
        const float* slot = HS + (size_t)(chain * NSC + sc - 1) * 16384;
#pragma unroll
        for (int kt = 0; kt < 8; ++kt)
#pragma unroll
            for (int r = 0; r < 4; ++r) acc[kt][r] = slot[(16 * kt + 4 * c4 + r) * 128 + 16 * wave + l15];
    } else {
#pragma unroll
        for (int kt = 0; kt < 8; ++kt) acc[kt] = (v4f){0.f, 0.f, 0.f, 0.f};
    }
#pragma unroll
    for (int kt = 0; kt < 8; ++kt) dprod[kt] = (v4f){1.f, 1.f, 1.f, 1.f};
    HU_WRITE(0);
    __syncthreads();
#pragma unroll 1
    for (int step = 0; step < SCH; ++step) {
        const LAS unsigned char* sl = L + (step & 1) * HU_SLOT;
        v4u vfn = vf;
        if (step < SCH - 1) { HU_LOAD(item0 + step + 1); vfn = ((const v4u*)(VF + (item0 + step + 1) * 8192))[wave * 64 + lane]; }
        if (WITH_OUT) {
            v4u sb[4];
#pragma unroll
            for (int ks = 0; ks < 4; ++ks) { sb[ks].x = cvtpk_hw(acc[2 * ks][0], acc[2 * ks][1]); sb[ks].y = cvtpk_hw(acc[2 * ks][2], acc[2 * ks][3]);
                sb[ks].z = cvtpk_hw(acc[2 * ks + 1][0], acc[2 * ks + 1][1]); sb[ks].w = cvtpk_hw(acc[2 * ks + 1][2], acc[2 * ks + 1][3]); }
#pragma unroll
            for (int mt = 0; mt < 2; ++mt) {
                v4f o = (v4f){0.f, 0.f, 0.f, 0.f};
#pragma unroll
                for (int ks = 0; ks < 4; ++ks) o = mfma_bf(*(const LAS v4u*)(sl + HU_Q + ((mt * 4 + ks) * 64 + lane) * 16), sb[ks], o);
                o = mfma_bf(*(const LAS v4u*)(sl + HU_P + (mt * 64 + lane) * 16), vf, o);
#pragma unroll
                for (int r = 0; r < 4; ++r) { const int row = hg_row(b, dir, 32 * (sc * SCH + step) + 16 * mt + 4 * c4 + r);
                    HO[((size_t)dir * R + row) * 512 + h * 128 + 16 * wave + l15] = o[r]; }
            }
        }
#pragma unroll
        for (int kt = 0; kt < 8; ++kt) { const v4f d = *(const LAS v4f*)(sl + HU_D + (16 * kt + 4 * c4) * 4);
            acc[kt] = acc[kt] * d; acc[kt] = mfma_bf(*(const LAS v4u*)(sl + HU_K + (kt * 64 + lane) * 16), vf, acc[kt]); if (!WITH_OUT) dprod[kt] = dprod[kt] * d; }
        if (step < SCH - 1) HU_WRITE((step + 1) & 1);
        vf = vfn;
        __syncthreads();
    }
#undef HU_LOAD
#undef HU_WRITE
    if (!WITH_OUT) {
        float* slot = HS + (size_t)(chain * NSC + sc) * 16384;
#pragma unroll
        for (int kt = 0; kt < 8; ++kt)
#pragma unroll
            for (int r = 0; r < 4; ++r) slot[(16 * kt + 4 * c4 + r) * 128 + 16 * wave + l15] = acc[kt][r];
        if (wave == 0 && l15 == 0) {
#pragma unroll
            for (int kt = 0; kt < 8; ++kt) *(v4f*)(HD + (chain * NSC + sc) * 128 + 16 * kt + 4 * c4) = dprod[kt];
        }
    }
}
__device__ __forceinline__ void hgrn_scan(float* HS, const float* HD, int gtid, int NT) {
    for (int e = gtid; e < 32 * 4096; e += NT) {
        const int chain = e >> 12, q4 = e & 4095, k = q4 >> 5;
        v4f* p = (v4f*)(HS + (size_t)chain * NSC * 16384) + q4; const float* dp = HD + chain * NSC * 128 + k;
        v4f tmp[NSC - 1]; float dd[NSC - 1];
#pragma unroll
        for (int s = 0; s < NSC - 1; ++s) { tmp[s] = p[(size_t)s * 4096]; dd[s] = dp[s * 128]; }
        v4f st = (v4f){0.f, 0.f, 0.f, 0.f};
#pragma unroll
        for (int s = 0; s < NSC - 1; ++s) { st = st * dd[s] + tmp[s]; p[(size_t)s * 4096] = st; }
    }
}
__device__ __forceinline__ void hg_combine(const float* HO, const bf16* PROJ, bf16* MIX, const float* hgg, bool skip_ctx, int gw, int NGW, int lane) {
    const float g0 = hgg[2 * lane], g1 = hgg[2 * lane + 1];
#pragma unroll 1
    for (int m0 = 4 * gw; m0 < R; m0 += 4 * NGW) {
        const int b = m0 / TB, t = m0 - b * TB; if (t >= SEQ && skip_ctx) continue;
        v2f a[4][4], c[4][4]; unsigned w2[4][4];
#pragma unroll
        for (int rr = 0; rr < 4; ++rr)
#pragma unroll
            for (int h = 0; h < 4; ++h) { const float* p0 = HO + (size_t)(m0 + rr) * 512 + h * 128 + 2 * lane;
                a[rr][h] = *(const v2f*)p0; c[rr][h] = *(const v2f*)(p0 + (size_t)R * 512);
                w2[rr][h] = *(const unsigned*)(PROJ + (size_t)(m0 + rr) * INC + C_HGT + h * 128 + 2 * lane); }
#pragma unroll
        for (int rr = 0; rr < 4; ++rr)
#pragma unroll
            for (int h = 0; h < 4; ++h) {
                const float o0 = a[rr][h].x + c[rr][h].x, o1 = a[rr][h].y + c[rr][h].y;
                const float rstd = __builtin_amdgcn_rsqf(wave_sum(o0 * o0 + o1 * o1) * (1.f / 128.f) + EPS);
                const float y0 = o0 * rstd * g0 * silu_f(bf2f(w2[rr][h] & 0xffffu)), y1 = o1 * rstd * g1 * silu_f(bf2f(w2[rr][h] >> 16));
                *(unsigned*)(MIX + (size_t)(m0 + rr) * DM + 1024 + h * 128 + 2 * lane) = cvtpk_rne(y0, y1);
            }
    }
}
__device__ __forceinline__ void conv_act_phase(const bf16* UP, bf16* ACT, const float* cw, const float* cb, bool skip_ctx, int gtid, int NT) {
    constexpr int NOCT = DFF / 8, NSTRIP = R / 32;
    for (int it = gtid; it < NSTRIP * NOCT; it += NT) {
        const int strip = it / NOCT, oc = it - strip * NOCT, wi = strip % (TB / 32), c0 = oc * 8;
        if (skip_ctx && wi >= SEQ / 32) continue;
        const bool seg_start = (wi == 0 || wi == SEQ / 32), seg_end = (wi == SEQ / 32 - 1 || wi == TB / 32 - 1);
        float w[2][3][8], bb[2][8];
#pragma unroll
        for (int hlf = 0; hlf < 2; ++hlf) {
#pragma unroll
            for (int jj = 0; jj < 3; ++jj) { const v4f a0 = *(const v4f*)(cw + (size_t)jj * UPC + hlf * DFF + c0), a1 = *(const v4f*)(cw + (size_t)jj * UPC + hlf * DFF + c0 + 4);
                w[hlf][jj][0] = a0.x; w[hlf][jj][1] = a0.y; w[hlf][jj][2] = a0.z; w[hlf][jj][3] = a0.w; w[hlf][jj][4] = a1.x; w[hlf][jj][5] = a1.y; w[hlf][jj][6] = a1.z; w[hlf][jj][7] = a1.w; }
            const v4f b0 = *(const v4f*)(cb + hlf * DFF + c0), b1 = *(const v4f*)(cb + hlf * DFF + c0 + 4);
            bb[hlf][0] = b0.x; bb[hlf][1] = b0.y; bb[hlf][2] = b0.z; bb[hlf][3] = b0.w; bb[hlf][4] = b1.x; bb[hlf][5] = b1.y; bb[hlf][6] = b1.z; bb[hlf][7] = b1.w;
        }
        const size_t r0 = (size_t)strip * 32;
        v4u pg = (v4u){0u, 0u, 0u, 0u}, pv = pg, cg, cvv, ng, nv;
        if (!seg_start) { pg = *(const v4u*)(UP + (r0 - 1) * UPC + c0); pv = *(const v4u*)(UP + (r0 - 1) * UPC + DFF + c0); }
        cg = *(const v4u*)(UP + r0 * UPC + c0); cvv = *(const v4u*)(UP + r0 * UPC + DFF + c0);
#pragma unroll 2
        for (int i = 0; i < 32; ++i) {
            if (i < 31 || !seg_end) { ng = *(const v4u*)(UP + (r0 + i + 1) * UPC + c0); nv = *(const v4u*)(UP + (r0 + i + 1) * UPC + DFF + c0); }
            else { ng = (v4u){0u, 0u, 0u, 0u}; nv = ng; }
            v4u o;
#pragma unroll
            for (int q = 0; q < 4; ++q) {
                float res[2];
#pragma unroll
                for (int e = 0; e < 2; ++e) {
                    const int ci = 2 * q + e;
                    const float gp = e ? bf2f(pg[q] >> 16) : bf2f(pg[q] & 0xffffu), gc = e ? bf2f(cg[q] >> 16) : bf2f(cg[q] & 0xffffu), gn = e ? bf2f(ng[q] >> 16) : bf2f(ng[q] & 0xffffu);
                    const float vp = e ? bf2f(pv[q] >> 16) : bf2f(pv[q] & 0xffffu), vc = e ? bf2f(cvv[q] >> 16) : bf2f(cvv[q] & 0xffffu), vn = e ? bf2f(nv[q] >> 16) : bf2f(nv[q] & 0xffffu);
                    const float yg = bb[0][ci] + w[0][0][ci] * gp + w[0][1][ci] * gc + w[0][2][ci] * gn;
                    const float yv = bb[1][ci] + w[1][0][ci] * vp + w[1][1][ci] * vc + w[1][2][ci] * vn;
                    res[e] = silu_f(yg) * yv;
                }
                o[q] = pk2(res[0], res[1]);
            }
            *(v4u*)(ACT + (r0 + i) * DFF + c0) = o;
            pg = cg; pv = cvv; cg = ng; cvv = nv;
        }
    }
}

__device__ __forceinline__ kptr_t kargs_fresh() { kptr_t p = (kptr_t)__builtin_amdgcn_kernarg_segment_ptr(); asm volatile("" : "+s"(p)); return p; }
#define KIN(i)  (*(const float* const AS4*)(kp + 8 * (i)))
#define KOUT()  (*(float* const AS4*)(kp + 176))
#define KWS()   (*(unsigned char* const AS4*)(kp + 184))
#define PH_BEGIN \
    int tid = threadIdx.x; asm volatile("" : "+v"(tid)); \
    const int lane = tid & 63, wave = __builtin_amdgcn_readfirstlane(tid >> 6); \
    int bx = blockIdx.x; asm volatile("" : "+s"(bx)); int G = gridDim.x; asm volatile("" : "+s"(G)); \
    const int gw = bx * NWAVES + wave, NGW = G * NWAVES, gtid = bx * NTHR + tid, NT = G * NTHR; \
    const kptr_t kp = kargs_fresh(); unsigned char* const ws = KWS(); \
    (void)lane; (void)gw; (void)NGW; (void)gtid; (void)NT; (void)ws;

template <int SEL>
__device__ __forceinline__ void convert_item(int l, int r, kptr_t kp, unsigned char* ws, LAS float* scr, int lane) {
    unsigned char* wb = ws + WS_W + (size_t)l * W_LAYER; const float* MOD = (const float*)(ws + WS_MOD) + (size_t)l * 5 * NMODC;
    if (SEL & 1) { if (r < CI_IN) { p0_transpose_item<true>(KIN(I_WIN) + (size_t)l * DM * INC, DM, INC, (bf16*)(wb + W_IN), scr, r, lane, (float*)(ws + WS_SWIN) + (size_t)l * 5 * INC, MOD + 0 * DM); return; } r -= CI_IN; }
    if (SEL & 2) { if (r < CI_OUT) { p0_transpose_item<false>(KIN(I_WOUT) + (size_t)l * DM * DM, DM, DM, (bf16*)(wb + W_OUT), scr, r, lane, nullptr, nullptr); return; } r -= CI_OUT; }
    if (SEL & 4) { if (r < CI_UP) { p0_transpose_item<true>(KIN(I_WUP) + (size_t)l * DM * UPC, DM, UPC, (bf16*)(wb + W_UP), scr, r, lane, (float*)(ws + WS_SWUP) + (size_t)l * 5 * UPC, MOD + 3 * DM); return; } r -= CI_UP; }
    if (SEL & 8) { p0_transpose_item<false>(KIN(I_WDN) + (size_t)l * DFF * DM, DFF, DM, (bf16*)(wb + W_DN), scr, r, lane, nullptr, nullptr); }
}

__global__ void __launch_bounds__(NTHR, 2) mk_fwd(Args a_unused) {
    extern __shared__ __attribute__((aligned(16))) unsigned char lds[];
    LAS unsigned char* ldsp = (LAS unsigned char*)lds;
    int lo, hi;
    { const kptr_t kp = kargs_fresh(); lo = *(const int AS4*)(kp + 192); hi = *(const int AS4*)(kp + 196); }
    for (int u = threadIdx.x; u < (LDS_BYTES - LDSCTL_OFF) / 4; u += NTHR) ((LAS unsigned*)(ldsp + LDSCTL_OFF))[u] = 0u;
    __syncthreads();
#if MK_ONE_LAUNCH
    XcdBarrier bar;
    { const kptr_t kp = kargs_fresh(); bar = xcd_barrier_post((unsigned*)(KWS() + WS_CTL) + CW_BAR, (volatile LAS unsigned*)(ldsp + MISC_OFF) + 8); }
#define GRID_BAR() xcd_barrier(bar)
#else
#define GRID_BAR() do { } while (0)
#endif
#define IN(k) (lo <= (k) && (k) < hi)

    if (IN(0)) {
        PH_BEGIN
        float* MOD = (float*)(ws + WS_MOD);
        p0_mod(KIN(I_C), KIN(I_CCTX), KIN(I_WADA), KIN(I_BADA), ldsp, MOD, tid, lane, wave, bx, G);
        if (bx == G - 1) {
            float* LBS = (float*)(ws + WS_MISC); float* RCOS = (float*)(ws + WS_MISC + 16384); float* RSIN = (float*)(ws + WS_MISC + 24576);
            const float* lbp = KIN(I_LBP);
            for (int i = tid; i < 1024; i += NTHR) { const int dir = i >> 9, ci = i & 511; float v[DEPTH], mx = -3.0e38f;
#pragma unroll
                for (int l = 0; l < DEPTH; ++l) { v[l] = lbp[(dir * DEPTH + l) * 512 + ci]; mx = fmaxf(mx, v[l]); }
                float s = 0.f;
#pragma unroll
                for (int l = 0; l < DEPTH; ++l) { v[l] = expf(v[l] - mx); s += v[l]; }
                float cum = 0.f;
#pragma unroll
                for (int l = 0; l < DEPTH; ++l) { if (l > 0) cum += v[l] / s; LBS[(dir * DEPTH + l) * 512 + ci] = cum; } }
            for (int i = tid; i < 2048; i += NTHR) { const int pos = i >> 5, fi = i & 31; const float inv = powf(10000.f, -(float)fi / 32.f); const float ang = (float)pos * inv; RCOS[i] = cosf(ang); RSIN[i] = sinf(ang); }
        }
        __syncthreads();
        {
            LAS float* scr = (LAS float*)(ldsp + wave * 16384);
            for (int it = gw; it < convert_count<2 | 8>(); it += NGW) convert_item<2 | 8>(0, it, kp, ws, scr, lane);
        }
        GRID_BAR();
    }

    if (IN(1)) { PH_BEGIN
        const float* MOD = (const float*)(ws + WS_MOD);
        {
            const float* xin = KIN(I_X); const float* cin = KIN(I_CTX); bf16* H = (bf16*)(ws + WS_H); float* RS0 = (float*)(ws + WS_RS); const float* g = KIN(I_N1G);
            for (int m = gw; m < R; m += NGW) {
                const int b = m / TB, t = m - b * TB; const float* mrow = MOD + (size_t)(t >= SEQ ? 4 : b) * NMODC;
                const v4f* xr = (const v4f*)(t < SEQ ? xin + ((size_t)b * SEQ + t) * DM : cin + ((size_t)b * CTXL + (t - SEQ)) * DM) + lane; float ss = 0.f;
#pragma unroll
                for (int j = 0; j < 8; ++j) { const v4f v = xr[64 * j]; ss += (v.x * v.x + v.y * v.y) + (v.z * v.z + v.w * v.w); const int c = 4 * lane + 256 * j;
                    const v4f y = v * *(const v4f*)(g + c) * (1.f + *(const v4f*)(mrow + 1 * DM + c));
                    v2u w; w.x = pk2(y.x, y.y); w.y = pk2(y.z, y.w); *(v2u*)(H + (size_t)m * DM + c) = w; }
                ss = wave_sum(ss); if (lane == 0) RS0[m] = ss;
            } }
        {
            float* GS = (float*)(ws + WS_GS); const float* g1 = KIN(I_N1G); const float* g2 = KIN(I_N2G);
            for (int i = gtid; i < DEPTH * 2 * 5 * DM; i += NT) { const int c = i & (DM - 1), r = (i >> 11) % 5, wl = i / (5 * DM), which = wl & 1, l = wl >> 1;
                GS[i] = (which ? g2 : g1)[l * DM + c] * (1.f + MOD[(size_t)(l * 5 + r) * NMODC + (which ? 4 : 1) * DM + c]); } }
        {
            LAS float* scr = (LAS float*)(ldsp + wave * 16384);
            for (int it = gw; it < convert_count<1 | 4>(); it += NGW) convert_item<1 | 4>(0, it, kp, ws, scr, lane);
        }
        GRID_BAR();
    }

#pragma unroll 1
    for (int l = 0; l < DEPTH; ++l) {
        const int pb = 2 + 9 * l; const bool last = (l == DEPTH - 1);
#define MODL ((const float*)(ws + WS_MOD) + (size_t)l * 5 * NMODC)
#define WB   (ws + WS_W + (size_t)l * W_LAYER)
#define RSL(s_) ((float*)(ws + WS_RS) + (size_t)(s_) * R)
#define GSL(l_, which_) ((const float*)(ws + WS_GS) + (size_t)((l_) * 2 + (which_)) * 5 * DM)
        if (IN(pb + 0)) { PH_BEGIN
            pg8::Gemm g{(const bf16*)(ws + WS_H), (const bf16*)(WB + W_IN), R, INC, DM}; TileOrder S; S.init2(INC, G, bx, false);
            EpiBf16N E{(bf16*)(ws + WS_PROJ), INC, RSL(2 * l), (const float*)(ws + WS_SWIN) + (size_t)l * 5 * INC};
            pg8::gemm_phase<EpiBf16N, TileOrder, true, true>(ldsp, g, S, E);
            GRID_BAR();
        }
        if (IN(pb + 1)) { PH_BEGIN
            const bf16* PROJ = (const bf16*)(ws + WS_PROJ);
            qknorm_phase(PROJ, (bf16*)(ws + WS_QN), (bf16*)(ws + WS_KN), KIN(I_QG) + l * 128, KIN(I_KG) + l * 128, (const float*)(ws + WS_MISC + 16384), (const float*)(ws + WS_MISC + 24576), gw, NGW, lane);
            {   const int nch = last ? 32 : 34, nU = NB * nch * 4;
                for (int u = bx; u < nU; u += G) { const int g = u & 3, bn = u >> 2, b = bn / nch, n = bn - b * nch;
                    sg_unit(b, n, g, l, PROJ, (bf16*)(ws + WS_MIX), KIN(I_SGG) + l * 512, KIN(I_SGW), KIN(I_SGB), ldsp, tid, lane, wave); } }
            hgrn_pre(l, PROJ, (const float*)(ws + WS_MISC), ws + WS_QF, ws + WS_KF, ws + WS_VF, ws + WS_PF, (float*)(ws + WS_DF), (float*)(ws + WS_HS), (float*)(ws + WS_HD), ldsp, bx, G, tid, lane, wave);
            GRID_BAR();
        }
        if (IN(pb + 2)) { PH_BEGIN
            hgrn_scan((float*)(ws + WS_HS), (const float*)(ws + WS_HD), gtid, NT);
            const int nU = last ? 512 : 544;
            for (int u = bx; u < nU; u += G) {
                int b, hq, row_q, row_k, seq;
                if (u < 512) { const int xcd = u & 7, idx = u >> 3; b = xcd >> 1; hq = (xcd & 1) * 4 + (idx >> 4); row_k = b * TB; row_q = row_k + (idx & 15) * 256; seq = TB; }
                else { const int uc = u - 512; b = uc >> 3; hq = uc & 7; row_k = b * TB + SEQ; row_q = row_k; seq = CTXL; }
                const int kvh = hq >> 2;
                att::attn_dense_body((const bf16*)(ws + WS_QN) + (size_t)row_q * 1024 + hq * 128, (const bf16*)(ws + WS_KN) + (size_t)row_k * 256 + kvh * 128,
                                     (const bf16*)(ws + WS_PROJ) + (size_t)row_k * INC + C_AV + kvh * 128, (bf16*)(ws + WS_MIX) + (size_t)row_q * DM + hq * 128, seq, (char*)lds);
            }
            GRID_BAR();
        }
        if (IN(pb + 3)) { PH_BEGIN
            for (int u = bx; u < 32 * NSC; u += G) hgrn_unit2<true>(u & 31, u >> 5, ws + WS_QF, ws + WS_KF, ws + WS_VF, ws + WS_PF, (const float*)(ws + WS_DF), (float*)(ws + WS_HS), (float*)(ws + WS_HD), (float*)(ws + WS_HO), ldsp, tid, lane, wave);
            GRID_BAR();
        }
        if (IN(pb + 4)) { PH_BEGIN hg_combine((const float*)(ws + WS_HO), (const bf16*)(ws + WS_PROJ), (bf16*)(ws + WS_MIX), KIN(I_HGG) + l * 128, last, gw, NGW, lane); GRID_BAR(); }
        if (IN(pb + 5)) { PH_BEGIN
            pg8::Gemm g{(const bf16*)(ws + WS_MIX), (const bf16*)(WB + W_OUT), R, DM, DM}; TileOrder S; S.init2(DM, G, bx, last);
            EpiResGate<true> E{(float*)(ws + WS_X), MODL, 2, (bf16*)(ws + WS_H), GSL(l, 1), RSL(2 * l + 1), l == 0 ? KIN(I_X) : nullptr, l == 0 ? KIN(I_CTX) : nullptr};
            pg8::gemm_phase<EpiResGate<true>, TileOrder, true, true>(ldsp, g, S, E);
            if (!last) {
                const int nfull = (G == 256) ? 32 : 0; LAS float* scr = (LAS float*)(ldsp + wave * 16384);
                if (bx >= nfull) for (int it = (bx - nfull) * NWAVES + wave; it < convert_count<1 | 2>(); it += (G - nfull) * NWAVES) convert_item<1 | 2>(l + 1, it, kp, ws, scr, lane);
            }
            GRID_BAR();
        }
        if (IN(pb + 6)) { PH_BEGIN
            pg8::Gemm g{(const bf16*)(ws + WS_H), (const bf16*)(WB + W_UP), R, UPC, DM}; TileOrder S; S.init2(UPC, G, bx, last);
            EpiBf16N E{(bf16*)(ws + WS_UP), UPC, RSL(2 * l + 1), (const float*)(ws + WS_SWUP) + (size_t)l * 5 * UPC};
            pg8::gemm_phase<EpiBf16N, TileOrder, true, true>(ldsp, g, S, E);
            GRID_BAR();
        }
        if (IN(pb + 7)) { PH_BEGIN conv_act_phase((const bf16*)(ws + WS_UP), (bf16*)(ws + WS_ACT), KIN(I_CW) + (size_t)l * 3 * UPC, KIN(I_CB) + (size_t)l * UPC, last, gtid, NT); GRID_BAR(); }
        if (IN(pb + 8)) { PH_BEGIN
            pg8::Gemm g{(const bf16*)(ws + WS_ACT), (const bf16*)(WB + W_DN), R, DM, DFF}; TileOrder S; S.init2(DM, G, bx, last);
            if (!last) { EpiResGate<true> E{(float*)(ws + WS_X), MODL, 5, (bf16*)(ws + WS_H), GSL(l + 1, 0), RSL(2 * l + 2), nullptr, nullptr};
                pg8::gemm_phase<EpiResGate<true>, TileOrder, true, true>(ldsp, g, S, E);
                const int nfull = (G == 256) ? 32 : 0; LAS float* scr = (LAS float*)(ldsp + wave * 16384);
                if (bx >= nfull) for (int it = (bx - nfull) * NWAVES + wave; it < convert_count<4 | 8>(); it += (G - nfull) * NWAVES) convert_item<4 | 8>(l + 1, it, kp, ws, scr, lane); }
            else { EpiResGate<false> E{(float*)(ws + WS_X), MODL, 5, nullptr, nullptr, nullptr, nullptr, nullptr};
                pg8::gemm_phase<EpiResGate<false>, TileOrder, true, true>(ldsp, g, S, E); }
            GRID_BAR();
        }
    }
    if (IN(NPHASE - 1)) { PH_BEGIN
        const float* g = KIN(I_FNG); const float* X = (const float*)(ws + WS_X); float* out = KOUT();
        for (int m = gw; m < NB * SEQ; m += NGW) {
            const int b = m >> 12, t = m & 4095;
            const v4f* xr = (const v4f*)(X + (size_t)(b * TB + t) * DM) + lane;
            v4f v[8]; float ss = 0.f;
#pragma unroll
            for (int j = 0; j < 8; ++j) { v[j] = xr[64 * j]; ss += (v[j].x * v[j].x + v[j].y * v[j].y) + (v[j].z * v[j].z + v[j].w * v[j].w); }
            const float rstd = 1.0f / sqrtf(wave_sum(ss) * (1.f / DM) + EPS);
            v4f* orow = (v4f*)(out + (size_t)m * DM) + lane;
#pragma unroll
            for (int j = 0; j < 8; ++j) orow[64 * j] = v[j] * rstd * *(const v4f*)(g + 4 * lane + 256 * j);
        }
    }
#undef IN
}

extern "C" void kernel_launch(void* const* d_in, const int* in_sizes, int n_in, void* d_out, int out_size, void* d_ws, size_t ws_size, hipStream_t stream) {
    static int grid = 0;
    if (grid == 0) {
        if (n_in != 22 || in_sizes[0] != NB * SEQ * DM || out_size != NB * SEQ * DM || ws_size < WS_END) {
            fprintf(stderr, "kernel_launch: unexpected shapes (n_in %d in0 %d out %d ws %zu, need ws >= %zu); nothing launched\n", n_in, n_in > 0 ? in_sizes[0] : -1, out_size, ws_size, (size_t)WS_END); grid = -1; return; }
        int dev = 0, cus = 0, per_cu = 0;
        if (hipGetDevice(&dev) != hipSuccess || hipDeviceGetAttribute(&cus, hipDeviceAttributeMultiprocessorCount, dev) != hipSuccess) { grid = -1; return; }
        if (hipFuncSetAttribute((const void*)mk_fwd, hipFuncAttributeMaxDynamicSharedMemorySize, LDS_BYTES) != hipSuccess) { fprintf(stderr, "kernel_launch: hipFuncSetAttribute failed\n"); grid = -1; return; }
        if (hipOccupancyMaxActiveBlocksPerMultiprocessor(&per_cu, (const void*)mk_fwd, NTHR, LDS_BYTES) != hipSuccess || per_cu < 1)
            fprintf(stderr, "kernel_launch: note: occupancy query reports %d workgroups per CU\n", per_cu);
        (void)hipGetLastError();
        grid = cus;
    }
    if (grid < 0) return;
    if (hipMemsetAsync((char*)d_ws + WS_CTL, 0, CTL_ZERO_BYTES, stream) != hipSuccess) return;
    Args a{};
    for (int i = 0; i < 22; ++i) a.in[i] = (const float*)d_in[i];
    a.out = (float*)d_out; a.ws = (unsigned char*)d_ws;
#if MK_ONE_LAUNCH
    a.ph_lo = 0; a.ph_hi = NPHASE;
    hipLaunchKernelGGL(mk_fwd, dim3(grid), dim3(NTHR), LDS_BYTES, stream, a);
#else
    for (int p = 0; p < NPHASE; ++p) { a.ph_lo = p; a.ph_hi = p + 1; hipLaunchKernelGGL(mk_fwd, dim3(grid), dim3(NTHR), LDS_BYTES, stream, a); }
#endif
    const hipError_t le = hipPeekAtLastError();
    if (le != hipSuccess) fprintf(stderr, "kernel_launch: launch failed: %s\n", hipGetErrorName(le));
}
```

```cpp
#include <hip/hip_runtime.h>
#include <cstdio>
#include <cstdint>
#ifndef MK_ONE_LAUNCH
#define MK_ONE_LAUNCH 1
#endif
namespace pg8 {
#define PG8_LAS __attribute__((address_space(3)))
typedef unsigned short bf16_t;
typedef short bf16x8 __attribute__((ext_vector_type(8)));
typedef float f32x4 __attribute__((ext_vector_type(4)));
typedef unsigned u32x4 __attribute__((ext_vector_type(4)));
constexpr int BM = 256, BK = 64, HALF = 128, HTB = HALF * BK * 2  , STAGE_BYTES = 8 * HTB, NXCD = 8, WGM = 8;

__host__ __device__ __forceinline__ int lds_byte(int r, int c) { const int st = (r >> 4) * 2 + (c >> 5), rr = r & 15, cc = c & 31, ob = rr * 64 + cc * 2; return st * 1024 + (ob ^ (((ob >> 9) & 1) << 5)); }
__host__ __device__ __forceinline__ void stage_rc(int b, int& R, int& C) { const int st = b / 1024, sb = b % 1024, swz = sb ^ (((sb >> 9) & 1) << 5); R = (st >> 1) * 16 + swz / 64; C = (st & 1) * 32 + (swz % 64) / 2; }
__host__ __device__ __forceinline__ int perm32(int rho) { const int n = rho >> 4, i = rho & 15; return 8 * (i >> 2) + 4 * n + (i & 3); }

struct Unit { int pm, pn; };
struct Gemm { const bf16_t* A; const bf16_t* Bt; int M, N, K; };

struct StaticOrder {
    int nM, nN, nwg, G, c;
    __host__ __device__ void init(int M, int N, int G_, int c_) { nM = M / BM; nN = N / BM; nwg = nM * nN; G = G_; c = c_; }
    __host__ __device__ bool next(int i, Unit& u) const {
        const long L = (long)i * G + c; if (L >= nwg) return false;
        int wgid = (int)L; { const int q = nwg / NXCD, r = nwg % NXCD, xcd = wgid % NXCD, off = wgid / NXCD; wgid = (xcd < r ? xcd * (q + 1) : r * (q + 1) + (xcd - r) * q) + off; }
        const int nig = WGM * nN, gid = wgid / nig, fm = gid * WGM, gsz = (nM - fm) < WGM ? (nM - fm) : WGM;
        u.pm = fm + ((wgid % nig) % gsz); u.pn = (wgid % nig) / gsz; return true;
    }
    __device__ __forceinline__ void a_ready(const Unit&) const {}
    __device__ __forceinline__ void done(const Unit&) const {}
};

__device__ __forceinline__ unsigned cvt_pk_bf16(float lo, float hi) { unsigned r; asm volatile("v_cvt_pk_bf16_f32 %0, %1, %2" : "=v"(r) : "v"(lo), "v"(hi)); return r; }
typedef float f32x2 __attribute__((ext_vector_type(2)));
__device__ __forceinline__ f32x2 gelu_pk(f32x2 v) {
    const f32x2 av = __builtin_elementwise_abs(v), d = av * 0.2316418882f + 1.0f;
    f32x2 t; t.x = __builtin_amdgcn_rcpf(d.x); t.y = __builtin_amdgcn_rcpf(d.y);
    f32x2 q = t * 0.5307027145f + (-0.7265760135f); q = q * t + 0.7107068705f; q = q * t + (-0.142248368f); q = q * t + 0.127414796f; q = q * t;
    const f32x2 s = (v * v) * (-0.72134752044f);
    f32x2 e; e.x = __builtin_amdgcn_exp2f(s.x); e.y = __builtin_amdgcn_exp2f(s.y);
    const f32x2 m = v * (q * e), r = v - m;
    f32x2 o; o.x = v.x < 0.f ? m.x : r.x; o.y = v.y < 0.f ? m.y : r.y; return o;
}

template <int ACT  > struct EpiBf16 {
    static constexpr bool PERM = true, AFTER_DRAIN = false; static_assert(ACT == 0 || ACT == 1, "EpiBf16: ACT is 0 (none) or 1 (gelu_pk)");
    bf16_t* O; int ldc; const float* bias; int split_cols; size_t split_stride; float scale0;
    __device__ __forceinline__ void operator()(const f32x4 (&acc)[2][2][4][2], const Unit& u, int wr, int wc, int fr, int fq) const {
        const int row0 = u.pm * BM + wr * 64 + fr; int colt = u.pn * BM; bf16_t* base = O;
        float sc = 1.f; if (split_cols) { const int t = colt / split_cols; base += (size_t)t * split_stride; colt -= t * split_cols; if (t == 0) sc = scale0; }
        const int col0 = colt + wc * 32 + 8 * fq, bcol0 = u.pn * BM + wc * 32 + 8 * fq;
        f32x4 bv[2][2];
#pragma unroll
        for (int bj = 0; bj < 2; ++bj)
#pragma unroll
            for (int n = 0; n < 2; ++n) bv[bj][n] = bias ? *(const f32x4*)(bias + bcol0 + bj * HALF + 4 * n) : (f32x4){0.f, 0.f, 0.f, 0.f};
#pragma unroll
        for (int ai = 0; ai < 2; ++ai)
#pragma unroll
            for (int m = 0; m < 4; ++m) { bf16_t* rowp = base + (size_t)(row0 + ai * HALF + m * 16) * ldc + col0;
#pragma unroll
                for (int bj = 0; bj < 2; ++bj) { f32x4 v0 = acc[ai][bj][m][0] + bv[bj][0], v1 = acc[ai][bj][m][1] + bv[bj][1];
                    if (ACT == 1) { f32x2 a = gelu_pk((f32x2){v0[0], v0[1]}), b = gelu_pk((f32x2){v0[2], v0[3]}), c = gelu_pk((f32x2){v1[0], v1[1]}), d = gelu_pk((f32x2){v1[2], v1[3]});
                        v0 = (f32x4){a.x, a.y, b.x, b.y}; v1 = (f32x4){c.x, c.y, d.x, d.y}; }
                    v0 = v0 * sc; v1 = v1 * sc; u32x4 w; w.x = cvt_pk_bf16(v0[0], v0[1]); w.y = cvt_pk_bf16(v0[2], v0[3]); w.z = cvt_pk_bf16(v1[0], v1[1]); w.w = cvt_pk_bf16(v1[2], v1[3]);
                    *(u32x4*)(rowp + bj * HALF) = w; } }
    }
};
template <class Epi, class Sched, bool ALIGN_EPI = false, bool SP2 = false>
__device__ __forceinline__ void gemm_phase(PG8_LAS unsigned char* lds, const Gemm g, const Sched& S, const Epi& E) {
    int tid_l = threadIdx.x; asm volatile("" : "+v"(tid_l)); const int tid = tid_l, wid = __builtin_amdgcn_readfirstlane(tid >> 6), lane = tid & 63, wr = wid >> 2, wc = wid & 3, fr = lane & 15, fq = lane >> 4;
    const int K = g.K, nt = K / BK;
    unsigned voffA[2], voffB[2];
#pragma unroll
    for (int i = 0; i < 2; ++i) { int R, C; stage_rc(tid * 16 + i * 8192, R, C); const int Rb = Epi::PERM ? ((R & ~31) + perm32(R & 31)) : R;
        voffA[i] = (unsigned)(R * K + C) * 2u; voffB[i] = (unsigned)(Rb * K + C) * 2u; }
    const size_t kstep = (size_t)(BK * 2);
    const size_t hstep = (size_t)HALF * K * 2;
    const size_t tstep = 2 * hstep;
    const unsigned ldsw = (unsigned)wid * 1024u;
    const int aoff = lds_byte(wr * 64 + fr, fq * 8), boff = lds_byte(wc * 32 + fr, fq * 8);
#define PG8_SA(b, h) (((b) * 2 + (h)) * HTB)
#define PG8_SB(b, h) ((4 + (b) * 2 + (h)) * HTB)
#define PG8_STAGE(bufoff, gbase, voff) do { _Pragma("unroll") for (int _i = 0; _i < 2; ++_i) \
        __builtin_amdgcn_global_load_lds((const unsigned*)((const char*)(gbase) + (voff)[_i]), (PG8_LAS unsigned*)(lds + (bufoff) + ldsw + _i * 8192), 16, 0, 0); } while (0)
#define PG8_LDA(dst, b, h) do { _Pragma("unroll") for (int m = 0; m < 4; ++m) _Pragma("unroll") for (int k = 0; k < 2; ++k) dst[m][k] = *(const PG8_LAS bf16x8*)(lds + PG8_SA(b, h) + aoff + m * 2048 + k * 1024); } while (0)
#define PG8_LDB(dst, b, h) do { _Pragma("unroll") for (int n = 0; n < 2; ++n) _Pragma("unroll") for (int k = 0; k < 2; ++k) dst[n][k] = *(const PG8_LAS bf16x8*)(lds + PG8_SB(b, h) + boff + n * 2048 + k * 1024); } while (0)
#define PG8_MMA(ai, bj, At, Bt) do { __builtin_amdgcn_s_setprio(1); _Pragma("unroll") for (int m = 0; m < 4; ++m) _Pragma("unroll") for (int n = 0; n < 2; ++n) _Pragma("unroll") for (int k = 0; k < 2; ++k) \
        acc[ai][bj][m][n] = __builtin_amdgcn_mfma_f32_16x16x32_bf16(Bt[n][k], At[m][k], acc[ai][bj][m][n], 0, 0, 0); __builtin_amdgcn_s_setprio(0); } while (0)
#define PG8_WAIT_V(n) asm volatile("s_waitcnt vmcnt(" #n ")" ::: "memory")
#define PG8_WAIT_L(n) asm volatile("s_waitcnt lgkmcnt(" #n ")" ::: "memory")
#define PG8_BAR __builtin_amdgcn_s_barrier()
#define PG8_SCHED __builtin_amdgcn_sched_barrier(0)
    Unit cur, nxt; int ui = 0;
    if (!S.next(0, cur)) return;
    f32x4 acc[2][2][4][2];
#pragma unroll
    for (int a = 0; a < 2; ++a)
#pragma unroll
        for (int b = 0; b < 2; ++b)
#pragma unroll
            for (int m = 0; m < 4; ++m)
#pragma unroll
                for (int n = 0; n < 2; ++n) acc[a][b][m][n] = (f32x4){0.f, 0.f, 0.f, 0.f};
    bf16x8 At[4][2], B0[2][2], B1[2][2];
    const char* cA = (const char*)g.A + (size_t)cur.pm * tstep; const char* cB = (const char*)g.Bt + (size_t)cur.pn * tstep;
    S.a_ready(cur);
    if constexpr (SP2) {
        PG8_STAGE(PG8_SB(0, 0), cB, voffB); PG8_STAGE(PG8_SB(0, 1), cB + hstep, voffB); PG8_STAGE(PG8_SA(0, 0), cA, voffA); PG8_STAGE(PG8_SA(0, 1), cA + hstep, voffA);
        if (wr == 1) PG8_BAR;
        PG8_WAIT_V(2); PG8_BAR;
        PG8_STAGE(PG8_SB(1, 0), cB + kstep, voffB); PG8_STAGE(PG8_SA(1, 0), cA + kstep, voffA); PG8_STAGE(PG8_SB(1, 1), cB + hstep + kstep, voffB);
        PG8_WAIT_V(6); PG8_BAR;
    } else {
        PG8_STAGE(PG8_SB(0, 0), cB, voffB); PG8_STAGE(PG8_SA(0, 0), cA, voffA); PG8_STAGE(PG8_SB(0, 1), cB + hstep, voffB); PG8_STAGE(PG8_SA(0, 1), cA + hstep, voffA);
        if (wr == 1) PG8_BAR;
        PG8_WAIT_V(4); PG8_BAR;
        PG8_STAGE(PG8_SB(1, 0), cB + kstep, voffB); PG8_STAGE(PG8_SA(1, 0), cA + kstep, voffA); PG8_STAGE(PG8_SB(1, 1), cB + hstep + kstep, voffB);
        PG8_WAIT_V(6); PG8_BAR;
    }
    for (;;) {
        const bool has_next = S.next(ui + 1, nxt);
        const char* nA = has_next ? (const char*)g.A + (size_t)nxt.pm * tstep : cA; const char* nB = has_next ? (const char*)g.Bt + (size_t)nxt.pn * tstep : cB;
        for (int t = 0; t < nt; t += 2) {
            const bool last = (t == nt - 2);
            const char* a1 = cA + (size_t)(t + 1) * kstep;
            const char* a2 = last ? nA : cA + (size_t)(t + 2) * kstep; const char* b2 = last ? nB : cB + (size_t)(t + 2) * kstep;
            const char* a3 = a2 + kstep; const char* b3 = b2 + kstep;
            if (last && has_next) S.a_ready(nxt);
            if constexpr (SP2) {
            PG8_LDB(B0, 0, 0); PG8_LDB(B1, 0, 1); PG8_SCHED; PG8_LDA(At, 0, 0); PG8_STAGE(PG8_SA(1, 1), a1 + hstep, voffA);
            PG8_WAIT_V(8); PG8_WAIT_L(0); PG8_BAR; PG8_MMA(0, 0, At, B0); PG8_MMA(0, 1, At, B1); PG8_BAR; PG8_SCHED;
            PG8_LDA(At, 0, 1); PG8_STAGE(PG8_SB(0, 0), b2, voffB); PG8_STAGE(PG8_SB(0, 1), b2 + hstep, voffB); PG8_STAGE(PG8_SA(0, 0), a2, voffA);
            PG8_WAIT_V(8); PG8_WAIT_L(0); PG8_BAR; PG8_MMA(1, 0, At, B0); PG8_MMA(1, 1, At, B1); PG8_BAR; PG8_SCHED;
            PG8_LDB(B0, 1, 0); PG8_LDB(B1, 1, 1); PG8_SCHED; PG8_LDA(At, 1, 0); PG8_STAGE(PG8_SA(0, 1), a2 + hstep, voffA);
            PG8_WAIT_V(8); PG8_WAIT_L(0); PG8_BAR; PG8_MMA(0, 0, At, B0); PG8_MMA(0, 1, At, B1); PG8_BAR; PG8_SCHED;
            PG8_LDA(At, 1, 1); PG8_STAGE(PG8_SB(1, 0), b3, voffB); PG8_STAGE(PG8_SB(1, 1), b3 + hstep, voffB); PG8_STAGE(PG8_SA(1, 0), a3, voffA);
            PG8_WAIT_V(8); PG8_WAIT_L(0); PG8_BAR; PG8_MMA(1, 0, At, B0); PG8_MMA(1, 1, At, B1); PG8_BAR; PG8_SCHED;
            } else {
            PG8_LDB(B0, 0, 0); PG8_SCHED; PG8_LDA(At, 0, 0); PG8_STAGE(PG8_SA(1, 1), a1 + hstep, voffA);
            PG8_WAIT_L(8); PG8_BAR; PG8_WAIT_L(0); PG8_MMA(0, 0, At, B0); PG8_BAR; PG8_SCHED;
            PG8_LDB(B1, 0, 1); PG8_STAGE(PG8_SB(0, 0), b2, voffB);
            PG8_BAR; PG8_WAIT_L(0); PG8_MMA(0, 1, At, B1); PG8_BAR;
            PG8_LDA(At, 0, 1); PG8_STAGE(PG8_SA(0, 0), a2, voffA);
            PG8_BAR; PG8_WAIT_L(0); PG8_MMA(1, 0, At, B0); PG8_BAR; PG8_SCHED;
            PG8_STAGE(PG8_SB(0, 1), b2 + hstep, voffB);
            PG8_WAIT_V(6); PG8_BAR; PG8_MMA(1, 1, At, B1); PG8_BAR;
            PG8_LDB(B0, 1, 0); PG8_SCHED; PG8_LDA(At, 1, 0); PG8_STAGE(PG8_SA(0, 1), a2 + hstep, voffA);
            PG8_WAIT_L(8); PG8_BAR; PG8_WAIT_L(0); PG8_MMA(0, 0, At, B0); PG8_BAR; PG8_SCHED;
            PG8_LDB(B1, 1, 1); PG8_STAGE(PG8_SB(1, 0), b3, voffB);
            PG8_BAR; PG8_WAIT_L(0); PG8_MMA(0, 1, At, B1); PG8_BAR;
            PG8_LDA(At, 1, 1); PG8_STAGE(PG8_SA(1, 0), a3, voffA);
            PG8_BAR; PG8_WAIT_L(0); PG8_MMA(1, 0, At, B0); PG8_BAR; PG8_SCHED;
            PG8_STAGE(PG8_SB(1, 1), b3 + hstep, voffB);
            PG8_WAIT_V(6); PG8_BAR; PG8_MMA(1, 1, At, B1); PG8_BAR;
            }
        }
        if constexpr (ALIGN_EPI) { if (wr == 0) PG8_BAR; }
        if constexpr (!Epi::AFTER_DRAIN) { E(acc, cur, wr, wc, fr, fq); S.done(cur); }
        if (!has_next) break;
#pragma unroll
        for (int a = 0; a < 2; ++a)
#pragma unroll
            for (int b = 0; b < 2; ++b)
#pragma unroll
                for (int m = 0; m < 4; ++m)
#pragma unroll
                    for (int n = 0; n < 2; ++n) acc[a][b][m][n] = (f32x4){0.f, 0.f, 0.f, 0.f};
        cur = nxt; cA = nA; cB = nB; ++ui;
        if constexpr (ALIGN_EPI) { if (wr == 1) PG8_BAR; }
    }
    PG8_WAIT_V(0);
    if constexpr (!ALIGN_EPI) { if (wr == 0) PG8_BAR; }
    PG8_BAR;
    if constexpr (Epi::AFTER_DRAIN) { E.fused(acc, cur, wr, wc, fr, fq, lds, wid, lane); S.done(cur); }
#undef PG8_SA
#undef PG8_SB
#undef PG8_STAGE
#undef PG8_LDA
#undef PG8_LDB
#undef PG8_MMA
#undef PG8_WAIT_V
#undef PG8_WAIT_L
#undef PG8_BAR
#undef PG8_SCHED
}
}
constexpr int DM = 2048, NB = 4, SEQ = 4096, CTXL = 256, DEPTH = 4;
constexpr int TB = SEQ + CTXL;
constexpr int R = NB * TB;
constexpr int INC = 5120, DFF = 5632, UPC = 2 * DFF, NMODC = 6 * DM;
constexpr int C_AQ = 0, C_AK = 1024, C_AV = 1280, C_HQ = 1536, C_HFF = 2048, C_HFB = 2560, C_HI = 3072, C_HGT = 3584, C_SU = 4096, C_SV = 4608;
constexpr float EPS = 1e-6f;
constexpr int NWAVES = 8, NTHR = 512;
constexpr int NPHASE = 3 + 9 * DEPTH;

constexpr size_t MiB = 1u << 20;
constexpr size_t WS_CTL = 0, CTL_ZERO_BYTES = 4 * MiB;
constexpr size_t WS_MOD = 3 * MiB;
constexpr size_t WS_MISC = 1146 * MiB;
constexpr size_t WS_W = 4 * MiB, W_LAYER = 94 * MiB, W_IN = 0, W_OUT = 20 * MiB, W_UP = 28 * MiB, W_DN = 72 * MiB;
constexpr size_t WS_X = 380 * MiB;
constexpr size_t WS_H = 516 * MiB;
constexpr size_t WS_PROJ = 584 * MiB;
constexpr size_t WS_QN = 754 * MiB;
constexpr size_t WS_KN = 788 * MiB;
constexpr size_t WS_MIX = 797 * MiB;
constexpr size_t WS_HS = 865 * MiB;
constexpr size_t WS_HD = 897 * MiB;
constexpr size_t WS_HO = 898 * MiB;
constexpr size_t WS_UP = 584 * MiB;
constexpr size_t WS_ACT = 958 * MiB;
constexpr size_t WS_SWIN = 1 * MiB;
constexpr size_t WS_SWUP = WS_SWIN + 512 * 1024;
constexpr size_t WS_GS = 1145 * MiB;
constexpr size_t WS_END = 1147 * MiB;
constexpr size_t WS_RS = 65536;
static_assert(WS_RS + (size_t)2 * DEPTH * R * 4 <= WS_SWIN && WS_SWIN + (size_t)DEPTH * 5 * INC * 4 <= WS_SWUP && WS_SWUP + (size_t)DEPTH * 5 * UPC * 4 <= WS_MOD && WS_MOD + (size_t)DEPTH * 5 * NMODC * 4 <= CTL_ZERO_BYTES && WS_GS + (size_t)DEPTH * 2 * 5 * DM * 4 <= WS_MISC && WS_MISC + 65536 <= WS_END && WS_MOD + (size_t)DEPTH * 5 * NMODC * 4 <= WS_W, "ws map 4");
static_assert(WS_HO + (size_t)2 * R * 512 * 4 <= 966 * MiB && WS_UP + (size_t)R * UPC * 2 <= WS_ACT && WS_ACT + (size_t)R * DFF * 2 <= WS_GS, "ws map");
static_assert(WS_PROJ + (size_t)R * INC * 2 <= WS_QN && WS_QN + (size_t)R * 1024 * 2 <= WS_KN && WS_KN + (size_t)R * 256 * 2 <= WS_MIX && WS_MIX + (size_t)R * DM * 2 <= WS_HS, "ws map 2");
static_assert(WS_X + (size_t)R * DM * 4 <= WS_H && WS_H + (size_t)R * DM * 2 <= WS_PROJ && WS_W + DEPTH * W_LAYER <= WS_X, "ws map 3");
constexpr int CW_BAR = 4096;
constexpr int CW_Q0 = 64;

constexpr int RING_BYTES = 131072, LDSCTL_OFF = RING_BYTES, MISC_OFF = LDSCTL_OFF + 320, LDS_BYTES = 147456;

#define GAS __attribute__((address_space(1)))
#define LAS __attribute__((address_space(3)))
typedef unsigned short bf16;
typedef float v4f __attribute__((ext_vector_type(4)));
typedef unsigned v4u __attribute__((ext_vector_type(4)));
typedef unsigned v2u __attribute__((ext_vector_type(2)));
typedef float v2f __attribute__((ext_vector_type(2)));
typedef GAS unsigned gu32;
#define AS4 __attribute__((address_space(4)))
typedef const AS4 unsigned char* kptr_t;
#define LDS_WAIT() asm volatile("s_waitcnt lgkmcnt(0)" ::: "memory")
#define LDS_BAR() do { asm volatile("s_waitcnt lgkmcnt(0)" ::: "memory"); __builtin_amdgcn_s_barrier(); asm volatile("" ::: "memory"); } while (0)
__device__ __forceinline__ float bf2f(unsigned u) { return __uint_as_float(u << 16); }
__device__ __forceinline__ unsigned f2bf(float f) { unsigned u = __float_as_uint(f); return (u + 0x7fffu + ((u >> 16) & 1u)) >> 16; }
__device__ __forceinline__ unsigned pk2(float lo, float hi) { return f2bf(lo) | (f2bf(hi) << 16); }
typedef float cvt_f32x2 __attribute__((ext_vector_type(2))); typedef __bf16 cvt_bf16x2 __attribute__((ext_vector_type(2)));
__device__ __forceinline__ unsigned cvtpk_rne(float lo, float hi) { const cvt_f32x2 v = {lo, hi}; return __builtin_bit_cast(unsigned, __builtin_convertvector(v, cvt_bf16x2)); }
__device__ __forceinline__ float dpp_f(float v, const int ctrl_unused) { return v; }
#define DPP_ADD(v, ctrl) ((v) + __builtin_bit_cast(float, __builtin_amdgcn_update_dpp(0, __builtin_bit_cast(int, (v)), (ctrl), 0xf, 0xf, false)))
__device__ __forceinline__ float wave_sum(float v) {
    v = DPP_ADD(v, 0xB1);
    v = DPP_ADD(v, 0x4E);
    v = DPP_ADD(v, 0x141);
    v = DPP_ADD(v, 0x140);
    { auto rr = __builtin_amdgcn_permlane16_swap(__float_as_uint(v), __float_as_uint(v), false, false); v = __uint_as_float(rr[0]) + __uint_as_float(rr[1]); }
    { auto rr = __builtin_amdgcn_permlane32_swap(__float_as_uint(v), __float_as_uint(v), false, false); v = __uint_as_float(rr[0]) + __uint_as_float(rr[1]); }
    return v;
}
__device__ __forceinline__ float sigm(float z) { return __builtin_amdgcn_rcpf(1.f + __expf(-z)); }
__device__ __forceinline__ float silu_f(float z) { return z * sigm(z); }
__device__ __forceinline__ float gelu_tanh(float x) {
    const float u = 0.7978845608028654f * (x + 0.044715f * x * x * x);
    const float th = 1.f - 2.f * __builtin_amdgcn_rcpf(1.f + __expf(2.f * u));
    return 0.5f * x * (1.f + th);
}
__device__ __forceinline__ v4f mfma4(float a, float b, v4f c) { return __builtin_amdgcn_mfma_f32_16x16x4f32(a, b, c, 0, 0, 0); }

#define XB_TMO      128
#define XB_XCNT(j)  (256  + 64 * (j))
#define XB_XSUB(j)  (1280 + 64 * (j))
#define XB_XGEN(j)  (2304 + 64 * (j))
#define XB_TOP      3328
#define XB_TOPGEN   3392
#define XCD_BAR_WORDS 3456
#define XB_SPIN_CAP (1u << 18)
__device__ __forceinline__ unsigned xb_ld(unsigned* p)              { return __hip_atomic_load(p, __ATOMIC_RELAXED, __HIP_MEMORY_SCOPE_AGENT); }
__device__ __forceinline__ unsigned xb_add(unsigned* p, unsigned v) { return __hip_atomic_fetch_add(p, v, __ATOMIC_RELAXED, __HIP_MEMORY_SCOPE_AGENT); }
__device__ __forceinline__ unsigned xb_xcc_id() { return (unsigned)__builtin_amdgcn_s_getreg((3 << 11) | 20) & 0xFu; }
#define XB_SPIN(cond, bar) do { unsigned _sp = 0; while (cond) { __builtin_amdgcn_s_sleep(1); \
    if ((++_sp & 255u) == 0u) { if (xb_ld(&(bar)[XB_TMO])) break; if (_sp > XB_SPIN_CAP) { atomicAdd(&(bar)[XB_TMO], 1u); break; } } } } while (0)
struct XcdBarrier { unsigned* bar; unsigned x; volatile LAS unsigned* st; };
__device__ __forceinline__ XcdBarrier xcd_barrier_post(unsigned* bar, volatile LAS unsigned* st) {
    XcdBarrier b; b.bar = bar; b.x = xb_xcc_id(); b.st = st;
    if (threadIdx.x == 0) (void)xb_add(&bar[XB_XCNT(b.x)], 1u);
    return b;
}
__device__ __forceinline__ void xcd_barrier_complete(unsigned* bar, unsigned x, unsigned& nloc, unsigned& nx) {
    const unsigned G = gridDim.x * gridDim.y * gridDim.z;
    unsigned sum, cnt, mine, sp = 0u;
    for (;;) {
        sum = 0u; cnt = 0u; mine = 0u;
#pragma unroll
        for (unsigned j = 0; j < 16; ++j) { const unsigned c = xb_ld(&bar[XB_XCNT(j)]); sum += c; cnt += (c > 0u) ? 1u : 0u; mine = (j == x) ? c : mine; }
        if (sum == G) break;
        __builtin_amdgcn_s_sleep(1);
        if ((++sp & 255u) == 0u) { if (xb_ld(&bar[XB_TMO])) break; if (sp > XB_SPIN_CAP) { atomicAdd(&bar[XB_TMO], 1u); break; } }
    }
    nloc = mine > 0u ? mine : 1u; nx = cnt > 0u ? cnt : 1u;
}
__device__ __forceinline__ void xcd_barrier(const XcdBarrier& b) {
    asm volatile("s_waitcnt vmcnt(0)" ::: "memory");
    __syncthreads();
    if (threadIdx.x == 0) {
        unsigned* bar = b.bar;
        __builtin_amdgcn_s_waitcnt(0);
        unsigned nloc = b.st[0], nx = b.st[1];
        if (nloc == 0u) { xcd_barrier_complete(bar, b.x, nloc, nx); b.st[0] = nloc; b.st[1] = nx; }
        const unsigned old = xb_add(&bar[XB_XSUB(b.x)], 1u);
        const unsigned gen = old / nloc;
        if (old + 1u == (gen + 1u) * nloc) {
            __builtin_amdgcn_fence(__ATOMIC_RELEASE, "agent");
            asm volatile("s_waitcnt vmcnt(0)" ::: "memory");
            const unsigned og = xb_add(&bar[XB_TOP], 1u);
            const unsigned tg = og / nx;
            if (og + 1u == (tg + 1u) * nx) xb_add(&bar[XB_TOPGEN], 1u);
            else XB_SPIN(xb_ld(&bar[XB_TOPGEN]) == tg, bar);
            __builtin_amdgcn_fence(__ATOMIC_ACQUIRE, "agent");
            xb_add(&bar[XB_XGEN(b.x)], 1u);
            asm volatile("s_waitcnt vmcnt(0)" ::: "memory");
        } else {
            XB_SPIN(xb_ld(&bar[XB_XGEN(b.x)]) == gen, bar);
            __builtin_amdgcn_fence(__ATOMIC_ACQUIRE, "agent");
            asm volatile("s_waitcnt vmcnt(0)" ::: "memory");
        }
    }
    __syncthreads();
}

struct TileOrder : pg8::StaticOrder {
    bool skip;
    __device__ void init2(int N, int G_, int c_, bool skip_) { skip = skip_; init(skip_ ? NB * SEQ : R, N, G_, c_); }
    __device__ bool next(int i, pg8::Unit& u) const { if (!pg8::StaticOrder::next(i, u)) return false; if (skip) u.pm += u.pm >> 4; return true; }
};
__device__ __forceinline__ unsigned cvt_pk2(float lo, float hi) { return cvtpk_rne(lo, hi); }
template <bool MAKE_H>
struct EpiResGate {
    static constexpr bool PERM = false, AFTER_DRAIN = false;
    float* X; const float* mod_l; int jg; bf16* H; const float* gs; float* rs;
    const float* xin; const float* cin;
    __device__ __forceinline__ void operator()(const pg8::f32x4 (&acc)[2][2][4][2], const pg8::Unit& u, int wr, int wc, int fr, int fq) const {
        const int b = u.pm / 17, jt = u.pm - b * 17, mrow = (jt == 16 ? 4 : b);
        const float* gp = mod_l + (size_t)mrow * NMODC + (size_t)jg * DM;
        const float* gsp = gs + (size_t)mrow * DM;
        const int col0 = u.pn * 256 + wc * 32 + 4 * fq;
        pg8::f32x4 gv[2][2];
#pragma unroll
        for (int bj = 0; bj < 2; ++bj)
#pragma unroll
            for (int n = 0; n < 2; ++n) gv[bj][n] = *(const pg8::f32x4*)(gp + col0 + bj * 128 + n * 16);
#pragma unroll
        for (int ai = 0; ai < 2; ++ai)
#pragma unroll
            for (int m = 0; m < 4; ++m) { const int row = u.pm * 256 + ai * 128 + wr * 64 + m * 16 + fr; const size_t off = (size_t)row * DM + col0; float ss = 0.f;
                const float* src = xin ? (jt == 16 ? cin + ((size_t)b * CTXL + (row - u.pm * 256)) * DM : xin + ((size_t)b * SEQ + jt * 256 + (row - u.pm * 256)) * DM) + col0 : X + off;
#pragma unroll
                for (int bj = 0; bj < 2; ++bj)
#pragma unroll
                    for (int n = 0; n < 2; ++n) { pg8::f32x4* p = (pg8::f32x4*)(X + off + bj * 128 + n * 16); const pg8::f32x4 xn = *(const pg8::f32x4*)(src + bj * 128 + n * 16) + gv[bj][n] * acc[ai][bj][m][n]; *p = xn;
                        if (MAKE_H) { ss += (xn[0] * xn[0] + xn[1] * xn[1]) + (xn[2] * xn[2] + xn[3] * xn[3]);
                            const pg8::f32x4 hv = xn * *(const pg8::f32x4*)(gsp + col0 + bj * 128 + n * 16);
                            v2u w; w.x = cvt_pk2(hv[0], hv[1]); w.y = cvt_pk2(hv[2], hv[3]); *(v2u*)(H + off + bj * 128 + n * 16) = w; } }
                if (MAKE_H) { ss += __shfl_xor(ss, 16); ss += __shfl_xor(ss, 32); if (fq == 0) unsafeAtomicAdd(rs + row, ss); }
                if (m & 1) asm volatile("" ::: "memory"); }
    }
};
struct EpiBf16N {
    static constexpr bool PERM = true, AFTER_DRAIN = false;
    bf16* O; int ldc; const float* rs; const float* sw;
    __device__ __forceinline__ void operator()(const pg8::f32x4 (&acc)[2][2][4][2], const pg8::Unit& u, int wr, int wc, int fr, int fq) const {
        const int b = u.pm / 17, jt = u.pm - b * 17, mrow = (jt == 16 ? 4 : b);
        const int row0 = u.pm * 256 + wr * 64 + fr, col0 = u.pn * 256 + wc * 32 + 8 * fq;
        const float* swp = sw + (size_t)mrow * ldc + col0;
        pg8::f32x4 bv[2][2];
#pragma unroll
        for (int bj = 0; bj < 2; ++bj)
#pragma unroll
            for (int n = 0; n < 2; ++n) bv[bj][n] = *(const pg8::f32x4*)(swp + bj * 128 + 4 * n);
#pragma unroll
        for (int ai = 0; ai < 2; ++ai)
#pragma unroll
            for (int m = 0; m < 4; ++m) { const int row = row0 + ai * 128 + m * 16; const float rstd = 1.0f / sqrtf(rs[row] * (1.f / DM) + EPS);
                bf16* rowp = O + (size_t)row * ldc + col0;
#pragma unroll
                for (int bj = 0; bj < 2; ++bj) { const pg8::f32x4 v0 = acc[ai][bj][m][0] * rstd + bv[bj][0], v1 = acc[ai][bj][m][1] * rstd + bv[bj][1];
                    pg8::u32x4 w; w.x = cvt_pk2(v0[0], v0[1]); w.y = cvt_pk2(v0[2], v0[3]); w.z = cvt_pk2(v1[0], v1[1]); w.w = cvt_pk2(v1[2], v1[3]);
                    *(pg8::u32x4*)(rowp + bj * 128) = w; } }
    }
};

namespace att {
using bf16x8 = __attribute__((ext_vector_type(8))) short;
using s16x4  = __attribute__((ext_vector_type(4))) short;
using f32x16 = __attribute__((ext_vector_type(16))) float;
using u32x4  = __attribute__((ext_vector_type(4))) unsigned;
constexpr int   D = 128, NW = 8, QBLK = 32, KVBLK = 64;
constexpr float SCALE = 0.088388347648318440f;
constexpr float THR = 8.f;
constexpr int LDQ = 1024, LDK = 256, LDV = INC, LDO = DM;
constexpr size_t SHM_V = KVBLK * D * 2, SHM_K = KVBLK * D * 2, SHM_ATTN = 2 * SHM_V + 2 * SHM_K + NW * 64 * 4;
#define KSWZ(row, colB) ((row) * 256 + ((colB) ^ (((row) & 7) << 4)))
#define SBAR() __builtin_amdgcn_sched_barrier(0)
__device__ __forceinline__ int crow(int r, int hi) { return (r & 3) + 8 * (r >> 2) + 4 * hi; }
__device__ __forceinline__ unsigned cvtpk(float lo, float hi) { unsigned r; asm volatile("v_cvt_pk_bf16_f32 %0, %1, %2" : "=v"(r) : "v"(lo), "v"(hi)); return r; }
__device__ __forceinline__ void partialSM(f32x16& p0, f32x16& p1, float& m_reg, float& mn, float& alpha) {
  constexpr float C = SCALE * 1.4426950408889634f;
  float pmax = p0[0]; for (int r = 1; r < 16; ++r) pmax = fmaxf(pmax, p0[r]); for (int r = 0; r < 16; ++r) pmax = fmaxf(pmax, p1[r]);
  { auto rr = __builtin_amdgcn_permlane32_swap(__float_as_uint(pmax), __float_as_uint(pmax), false, false);
    pmax = fmaxf(__uint_as_float(rr[0]), __uint_as_float(rr[1])); }
  if (__builtin_expect(__all(pmax - m_reg <= THR / SCALE), 1)) { mn = m_reg; alpha = 1.f; }
  else { mn = fmaxf(m_reg, pmax); alpha = __builtin_amdgcn_exp2f((m_reg - mn) * C); m_reg = mn; }
  float mnC = -mn * C;
  for (int r = 0; r < 16; ++r) p0[r] = fmaf(p0[r], C, mnC); for (int r = 0; r < 16; ++r) p1[r] = fmaf(p1[r], C, mnC);
  for (int r = 0; r < 16; ++r) p0[r] = __builtin_amdgcn_exp2f(p0[r]);
}
__device__ __forceinline__ void finishSM(f32x16& p0, f32x16& p1, float alpha, float& l_reg, bf16x8& pa0, bf16x8& pa1, bf16x8& pa2, bf16x8& pa3) {
  for (int r = 0; r < 16; ++r) p1[r] = __builtin_amdgcn_exp2f(p1[r]);
  float ps = 0; for (int r = 0; r < 16; ++r) ps += p0[r]; for (int r = 0; r < 16; ++r) ps += p1[r];
  { auto rr = __builtin_amdgcn_permlane32_swap(__float_as_uint(ps), __float_as_uint(ps), false, false);
    ps = __uint_as_float(rr[0]) + __uint_as_float(rr[1]); }
  l_reg = l_reg * alpha + ps;
#define PK4(P, BASE, OUT) do { unsigned a0 = cvtpk(P[BASE + 0], P[BASE + 1]), a1 = cvtpk(P[BASE + 2], P[BASE + 3]);   \
    unsigned b0 = cvtpk(P[BASE + 4], P[BASE + 5]), b1 = cvtpk(P[BASE + 6], P[BASE + 7]);                              \
    auto r0 = __builtin_amdgcn_permlane32_swap(a0, b0, false, false); auto r1 = __builtin_amdgcn_permlane32_swap(a1, b1, false, false); \
    u32x4 w = {r0[0], r1[0], r0[1], r1[1]}; OUT = *reinterpret_cast<bf16x8*>(&w); } while (0)
  PK4(p0, 0, pa0); PK4(p0, 8, pa1); PK4(p1, 0, pa2); PK4(p1, 8, pa3);
#undef PK4
}
__device__ __forceinline__ void qkt(f32x16& p0, f32x16& p1, const bf16* Ks, const bf16x8* qr, int r32, int hi) {
  p0 = f32x16{}; p1 = f32x16{};
  for (int d0 = 0; d0 < 8; ++d0) { int cb = (d0 * 16 + hi * 8) * 2;
    bf16x8 b0 = *reinterpret_cast<const bf16x8*>((const char*)Ks + KSWZ(r32, cb));
    bf16x8 b1 = *reinterpret_cast<const bf16x8*>((const char*)Ks + KSWZ(32 + r32, cb));
    p0 = __builtin_amdgcn_mfma_f32_32x32x16_bf16(b0, qr[d0], p0, 0, 0, 0);
    p1 = __builtin_amdgcn_mfma_f32_32x32x16_bf16(b1, qr[d0], p1, 0, 0, 0); }
}
__device__ __forceinline__ int v_st(int k, int c) { const int kk = (k & ~0xC) | ((k & 4) << 1) | ((k & 8) >> 1); return ((kk >> 3) * 4 + (c >> 5)) * 512 + ((kk & 7) * 32 + (c & 31)) * 2; }
__device__ __forceinline__ int v_rd_base(int lane) { return ((lane & 3) << 3) | (((lane >> 2) & 3) << 6) | (((lane >> 4) & 1) << 5) | (((lane >> 5) & 1) << 8); }
constexpr int v_rd_off(int d0, int ks, int half) { return d0 * 512 + ks * 4096 + half * 2048; }
template <int OFF> __device__ __forceinline__ s16x4 tr_read(int vb) {
  s16x4 r; asm volatile("ds_read_b64_tr_b16 %0, %1 offset:%2" : "=&v"(r) : "v"(vb), "i"(OFF) : "memory"); return r;
}
template <int D0> __device__ __forceinline__ void pv_one(f32x16& od, int vb, bf16x8 pa0, bf16x8 pa1, bf16x8 pa2, bf16x8 pa3) {
  const s16x4 l0 = tr_read<v_rd_off(D0, 0, 0)>(vb), h0 = tr_read<v_rd_off(D0, 0, 1)>(vb), l1 = tr_read<v_rd_off(D0, 1, 0)>(vb), h1 = tr_read<v_rd_off(D0, 1, 1)>(vb);
  const s16x4 l2 = tr_read<v_rd_off(D0, 2, 0)>(vb), h2 = tr_read<v_rd_off(D0, 2, 1)>(vb), l3 = tr_read<v_rd_off(D0, 3, 0)>(vb), h3 = tr_read<v_rd_off(D0, 3, 1)>(vb);
  asm volatile("s_waitcnt lgkmcnt(0)" ::: "memory"); SBAR();
#define PK(L, H) (bf16x8){L[0], L[1], L[2], L[3], H[0], H[1], H[2], H[3]}
  od = __builtin_amdgcn_mfma_f32_32x32x16_bf16(pa0, PK(l0, h0), od, 0, 0, 0);
  od = __builtin_amdgcn_mfma_f32_32x32x16_bf16(pa1, PK(l1, h1), od, 0, 0, 0);
  od = __builtin_amdgcn_mfma_f32_32x32x16_bf16(pa2, PK(l2, h2), od, 0, 0, 0);
  od = __builtin_amdgcn_mfma_f32_32x32x16_bf16(pa3, PK(l3, h3), od, 0, 0, 0);
#undef PK
}
__device__ __forceinline__ void pv_d0(f32x16* o, int vb, bf16x8 pa0, bf16x8 pa1, bf16x8 pa2, bf16x8 pa3) {
  pv_one<0>(o[0], vb, pa0, pa1, pa2, pa3); pv_one<1>(o[1], vb, pa0, pa1, pa2, pa3); pv_one<2>(o[2], vb, pa0, pa1, pa2, pa3); pv_one<3>(o[3], vb, pa0, pa1, pa2, pa3);
}
__device__ __forceinline__ void attn_dense_body(const bf16* __restrict__ Qb, const bf16* __restrict__ Kh, const bf16* __restrict__ Vh,
                                                bf16* __restrict__ Ob, int seq, char* lds) {
  int tid_l = threadIdx.x; asm volatile("" : "+v"(tid_l)); const int tid = tid_l, wid = tid >> 6, lane = tid & 63, r32 = lane & 31, hi = lane >> 5;
  bf16* V_lds = (bf16*)lds; bf16* K_lds = (bf16*)(lds + 2 * SHM_V);
  float* ws = (float*)(lds + 2 * SHM_V + 2 * SHM_K) + wid * 64; float* li_l = ws; float* al_l = ws + 32;
  float m_reg = -1e30f, l_reg = 0; f32x16 o[4] = {}; bf16x8 qr[8];
  const bf16* Qw = Qb + (long)(wid * QBLK + r32) * LDQ + hi * 8;
#pragma unroll
  for (int d0 = 0; d0 < 8; ++d0) qr[d0] = *reinterpret_cast<const bf16x8*>(Qw + d0 * 16);
  const int sr = tid >> 4, sc = (tid & 15) * 8, vst0 = v_st(sr, sc), vst1 = v_st(32 + sr, sc);
  const int vb0 = (int)(uintptr_t)V_lds + v_rd_base(lane);
  struct { bf16x8 vs0, vs1, ks0, ks1; } sr_[2];
#define SLOAD(i, k0) do { sr_[i].vs0 = *reinterpret_cast<const bf16x8*>(&Vh[(long)((k0) + sr) * LDV + sc]); sr_[i].vs1 = *reinterpret_cast<const bf16x8*>(&Vh[(long)((k0) + 32 + sr) * LDV + sc]); \
    sr_[i].ks0 = *reinterpret_cast<const bf16x8*>(&Kh[(long)((k0) + sr) * LDK + sc]); sr_[i].ks1 = *reinterpret_cast<const bf16x8*>(&Kh[(long)((k0) + 32 + sr) * LDK + sc]); } while (0)
#define SWRITE(b, i) do { *(bf16x8*)((char*)V_lds + (b) * SHM_V + vst0) = sr_[i].vs0;          \
    *(bf16x8*)((char*)V_lds + (b) * SHM_V + vst1) = sr_[i].vs1; int kc = sc * 2;               \
    *(bf16x8*)((char*)K_lds + (b) * SHM_K + KSWZ(sr, kc)) = sr_[i].ks0;                       \
    *(bf16x8*)((char*)K_lds + (b) * SHM_K + KSWZ(32 + sr, kc)) = sr_[i].ks1; } while (0)
#define SWAIT() asm volatile("s_waitcnt vmcnt(4)" ::: "memory")
#define RESC(a) do { if (__any((a) < 1.f)) { if (hi == 0) al_l[r32] = (a); asm volatile("s_waitcnt lgkmcnt(0)" ::: "memory"); \
    for (int d = 0; d < 4; ++d) for (int r = 0; r < 16; ++r) o[d][r] *= al_l[crow(r, hi)]; } } while (0)
  f32x16 pA0, pA1, pB0, pB1; float mnA, mnB, alA, alB; bf16x8 pa0, pa1, pa2, pa3; const int NT = seq / KVBLK;
  constexpr int SE = 0, SO = 1;
  SLOAD(SE, 0); asm volatile("s_waitcnt vmcnt(0)" ::: "memory"); SWRITE(0, SE); __syncthreads();
  qkt(pA0, pA1, K_lds, qr, r32, hi); partialSM(pA0, pA1, m_reg, mnA, alA);
  SLOAD(SO, KVBLK); if (2 < NT) SLOAD(SE, 2 * KVBLK);
  SWAIT(); SWRITE(1, SO); __syncthreads();
  for (int j = 1; j + 1 < NT; j += 2) {
    SBAR(); qkt(pB0, pB1, (bf16*)((char*)K_lds + SHM_K), qr, r32, hi);
    finishSM(pA0, pA1, alA, l_reg, pa0, pa1, pa2, pa3); SBAR();
    SLOAD(SO, (j + 2) * KVBLK); SBAR();
    pv_d0(o, vb0, pa0, pa1, pa2, pa3); partialSM(pB0, pB1, m_reg, mnB, alB);
    __syncthreads(); SWAIT(); SWRITE(0, SE);
    RESC(alB); __syncthreads();
    SBAR(); qkt(pA0, pA1, K_lds, qr, r32, hi);
    finishSM(pB0, pB1, alB, l_reg, pa0, pa1, pa2, pa3); SBAR();
    if (j + 3 < NT) SLOAD(SE, (j + 3) * KVBLK); SBAR();
    pv_d0(o, vb0 + (int)SHM_V, pa0, pa1, pa2, pa3); partialSM(pA0, pA1, m_reg, mnA, alA);
    __syncthreads(); SWAIT(); SWRITE(1, SO);
    RESC(alA); __syncthreads();
  }
  SBAR(); qkt(pB0, pB1, (bf16*)((char*)K_lds + SHM_K), qr, r32, hi);
  finishSM(pA0, pA1, alA, l_reg, pa0, pa1, pa2, pa3); SBAR();
  pv_d0(o, vb0, pa0, pa1, pa2, pa3); partialSM(pB0, pB1, m_reg, mnB, alB);
  __syncthreads(); RESC(alB);
  finishSM(pB0, pB1, alB, l_reg, pa0, pa1, pa2, pa3); SBAR();
  pv_d0(o, vb0 + (int)SHM_V, pa0, pa1, pa2, pa3);
  if (hi == 0) li_l[r32] = l_reg; asm volatile("s_waitcnt lgkmcnt(0)" ::: "memory");
  float rli[16];
#pragma unroll
  for (int r = 0; r < 16; ++r) rli[r] = __builtin_amdgcn_rcpf(li_l[crow(r, hi)]);
  bf16* Ow = Ob + (long)(wid * QBLK) * LDO;
#pragma unroll
  for (int r = 0; r < 16; ++r) { int orow = crow(r, hi);
    for (int d0 = 0; d0 < 4; ++d0) Ow[(long)orow * LDO + d0 * 32 + r32] = (bf16)f2bf(o[d0][r] * rli[r]); }
  __syncthreads();
#undef SLOAD
#undef SWRITE
#undef SWAIT
#undef RESC
}
}

struct Args { const float* in[22]; float* out; unsigned char* ws; int ph_lo, ph_hi; };
enum { I_X = 0, I_C, I_CTX, I_CCTX, I_WADA, I_BADA, I_N1G, I_WIN, I_QG, I_KG, I_LBP, I_HGG, I_SGG, I_SGW, I_SGB, I_WOUT, I_N2G, I_WUP, I_CW, I_CB, I_WDN, I_FNG };

__device__ __forceinline__ void p0_mod(const float* cin, const float* ccin, const float* wada, const float* bada, LAS unsigned char* lds, float* MOD, int tid, int lane, int wave, int bx, int G) {
    LAS float* sc = (LAS float*)lds;
    LAS float* red0 = (LAS float*)(lds + 40960);
    for (int i = tid; i < 5 * DM; i += NTHR) { const int r = i >> 11, k = i & 2047; const float v = r < 4 ? cin[r * DM + k] : ccin[k]; sc[i] = silu_f(v); }
    LDS_BAR();
    int par = 0;
    for (int it = bx; it < 768; it += G, par ^= 1) {
        const int cb = it >> 2, kq = it & 3, l = cb / 48, n0 = (cb % 48) * 256, kbase = 512 * kq + 64 * wave;
        const float* wp = wada + ((size_t)l * DM + kbase) * NMODC + n0 + 4 * lane;
        LAS float* red = red0 + par * (8 * 5 * 256);
        v4f acc[5];
#pragma unroll
        for (int r = 0; r < 5; ++r) acc[r] = (v4f){0.f, 0.f, 0.f, 0.f};
#pragma unroll 16
        for (int k = 0; k < 64; ++k) {
            const v4f w = *(const v4f*)(wp + (size_t)k * NMODC);
#pragma unroll
            for (int r = 0; r < 5; ++r) { const float s = sc[r * DM + kbase + k]; acc[r] += w * s; }
        }
#pragma unroll
        for (int r = 0; r < 5; ++r) *(LAS v4f*)(red + (wave * 5 + r) * 256 + 4 * lane) = acc[r];
        LDS_BAR();
        for (int o = tid; o < 1280; o += NTHR) { const int r = o >> 8, ci = o & 255; float s = (kq == 0) ? bada[l * NMODC + n0 + ci] : 0.f;
#pragma unroll
            for (int w = 0; w < 8; ++w) s += red[(w * 5 + r) * 256 + ci];
            unsafeAtomicAdd(MOD + (size_t)(l * 5 + r) * NMODC + n0 + ci, s); }
    }
    LDS_BAR();
}
template <bool SWACC>
__device__ __forceinline__ void p0_transpose_item(const float* W, int K, int N, bf16* WT, LAS float* scr, int item, int lane, float* sw, const float* sh) {
    const int nblk = N / 32, kb = item / nblk, nb = item % nblk, k0 = 64 * kb, n0 = 32 * nb;
#pragma unroll 8
    for (int i = 0; i < 32; ++i) { const int kk = 2 * i + (lane >> 5); scr[kk * 33 + (lane & 31)] = W[(size_t)(k0 + kk) * N + n0 + (lane & 31)]; }
    LDS_WAIT(); asm volatile("" ::: "memory");
    const int c = lane & 7;
#pragma unroll
    for (int j = 0; j < 4; ++j) { const int n = (lane >> 3) + 8 * j; const LAS float* s = scr + (8 * c) * 33 + n;
        v4u o; o.x = pk2(s[0 * 33], s[1 * 33]); o.y = pk2(s[2 * 33], s[3 * 33]); o.z = pk2(s[4 * 33], s[5 * 33]); o.w = pk2(s[6 * 33], s[7 * 33]);
        *(GAS v4u*)(WT + (size_t)(n0 + n) * K + k0 + 8 * c) = o; }
    if (SWACC) {
        const int n = lane & 31, kh = lane >> 5; float s5[5] = {0.f, 0.f, 0.f, 0.f, 0.f};
        const float* shp = sh + k0 + 32 * kh; const LAS float* tp = scr + (32 * kh) * 33 + n;
#pragma unroll
        for (int q = 0; q < 8; ++q) { const float w0 = tp[(4 * q) * 33], w1 = tp[(4 * q + 1) * 33], w2 = tp[(4 * q + 2) * 33], w3 = tp[(4 * q + 3) * 33];
#pragma unroll
            for (int r = 0; r < 5; ++r) { const v4f s = *(const v4f*)(shp + (size_t)r * NMODC + 4 * q); s5[r] += (s.x * w0 + s.y * w1) + (s.z * w2 + s.w * w3); } }
#pragma unroll
        for (int r = 0; r < 5; ++r) { s5[r] += __shfl_xor(s5[r], 32); if (lane < 32) unsafeAtomicAdd(sw + (size_t)r * N + n0 + n, s5[r]); }
    }
    LDS_WAIT(); asm volatile("" ::: "memory");
}
constexpr int CI_IN = (DM / 64) * (INC / 32), CI_OUT = (DM / 64) * (DM / 32), CI_UP = (DM / 64) * (UPC / 32), CI_DN = (DFF / 64) * (DM / 32);
template <int SEL>
__device__ __forceinline__ void convert_item(int l, int r, kptr_t kp, unsigned char* ws, LAS float* scr, int lane);
template <int SEL> constexpr int convert_count() { return ((SEL & 1) ? CI_IN : 0) + ((SEL & 2) ? CI_OUT : 0) + ((SEL & 4) ? CI_UP : 0) + ((SEL & 8) ? CI_DN : 0); }
__device__ __forceinline__ void norm_phase(const float* X, bf16* H, const float* g, const float* mod_l, int jshift, int jscale, bool skip_ctx, int gw, int NGW, int lane) {
    for (int m = gw; m < R; m += NGW) {
        const int b = m / TB, t = m - b * TB; const bool isc = t >= SEQ; if (isc && skip_ctx) continue;
        const float* mrow = mod_l + (size_t)(isc ? 4 : b) * NMODC;
        const v4f* xr = (const v4f*)(X + (size_t)m * DM) + lane;
        v4f v[8]; float ss = 0.f;
#pragma unroll
        for (int j = 0; j < 8; ++j) { v[j] = xr[64 * j]; ss += (v[j].x * v[j].x + v[j].y * v[j].y) + (v[j].z * v[j].z + v[j].w * v[j].w); }
        const float rstd = 1.0f / sqrtf(wave_sum(ss) * (1.f / DM) + EPS);
#pragma unroll
        for (int j = 0; j < 8; ++j) { const int c = 4 * lane + 256 * j;
            const v4f gg = *(const v4f*)(g + c), sh = *(const v4f*)(mrow + jshift * DM + c), sc = *(const v4f*)(mrow + jscale * DM + c);
            const v4f y = v[j] * rstd * gg * (1.f + sc) + sh;
            v2u w; w.x = pk2(y.x, y.y); w.y = pk2(y.z, y.w);
            *(v2u*)(H + (size_t)m * DM + c) = w; }
    }
}
__device__ __forceinline__ void qknorm_phase(const bf16* PROJ, bf16* QN, bf16* KN, const float* qg, const float* kg, const float* rcos, const float* rsin, int gw, int NGW, int lane) {
    const float qg0 = qg[2 * lane], qg1 = qg[2 * lane + 1], kg0 = kg[2 * lane], kg1 = kg[2 * lane + 1];
#pragma unroll 1
    for (int m0 = 4 * gw; m0 < R; m0 += 4 * NGW) {
        unsigned w2[4][10];
#pragma unroll
        for (int rr = 0; rr < 4; ++rr)
#pragma unroll
            for (int hh = 0; hh < 10; ++hh) w2[rr][hh] = *(const unsigned*)(PROJ + (size_t)(m0 + rr) * INC + hh * 128 + 2 * lane);
#pragma unroll
        for (int rr = 0; rr < 4; ++rr) {
            const int m = m0 + rr, b = m / TB, t = m - b * TB; const bool lat = t < SEQ;
            float cs = 1.f, sn = 0.f;
            if (lat) { const int pos = (lane < 32) ? (t >> 6) : (t & 63); cs = rcos[pos * 32 + (lane & 31)]; sn = rsin[pos * 32 + (lane & 31)]; }
#pragma unroll
            for (int hh = 0; hh < 10; ++hh) {
                const float x1 = bf2f(w2[rr][hh] & 0xffffu), x2 = bf2f(w2[rr][hh] >> 16);
                const float rstd = __builtin_amdgcn_rsqf(wave_sum(x1 * x1 + x2 * x2) * (1.f / 128.f) + EPS);
                const float y1 = x1 * rstd * (hh < 8 ? qg0 : kg0), y2 = x2 * rstd * (hh < 8 ? qg1 : kg1);
                const float o1 = y1 * cs - y2 * sn, o2 = y1 * sn + y2 * cs;
                bf16* dst = hh < 8 ? QN + (size_t)m * 1024 + hh * 128 + 2 * lane : KN + (size_t)m * 256 + (hh - 8) * 128 + 2 * lane;
                *(unsigned*)dst = cvtpk_rne(o1, o2);
            }
        }
    }
}
typedef short hbf16x8 __attribute__((ext_vector_type(8)));
__device__ __forceinline__ v4f mfma_bf(v4u a, v4u b, v4f c) { return __builtin_amdgcn_mfma_f32_16x16x32_bf16(__builtin_bit_cast(hbf16x8, a), __builtin_bit_cast(hbf16x8, b), c, 0, 0, 0); }
__device__ __forceinline__ unsigned cvtpk_hw(float lo, float hi) { return cvtpk_rne(lo, hi); }
constexpr int SG_PB = 272;
__device__ __forceinline__ void sg_unit(int b, int n, int g, int l, const bf16* PROJ, bf16* MIX, const float* sgg, const float* sgw, const float* sgb, LAS unsigned char* Vt, int tid, int lane, int wave) {
    const int row0 = b * TB + n * 128, c4 = lane >> 4, l15 = lane & 15;
    v4u wf[4];
    {   const float* W = sgw + ((size_t)(l * 4 + g) * 128 + 16 * wave + l15) * 128 + 8 * c4;
#pragma unroll
        for (int ks = 0; ks < 4; ++ks) { const v4f a0 = *(const v4f*)(W + 32 * ks), a1 = *(const v4f*)(W + 32 * ks + 4);
            wf[ks].x = cvtpk_hw(a0.x, a0.y); wf[ks].y = cvtpk_hw(a0.z, a0.w); wf[ks].z = cvtpk_hw(a1.x, a1.y); wf[ks].w = cvtpk_hw(a1.z, a1.w); } }
    const size_t orow = (size_t)(row0 + 16 * wave + l15);
    v2u uraw[8];
#pragma unroll
    for (int dt = 0; dt < 8; ++dt) uraw[dt] = *(const v2u*)(PROJ + orow * INC + C_SU + g * 128 + 16 * dt + 4 * c4);
    const float bsv = sgb[(l * 4 + g) * 128 + 16 * wave + l15];
    {
        const int s = tid >> 2, q = tid & 3;
        const v4u* src = (const v4u*)(PROJ + (size_t)(row0 + s) * INC + C_SV + g * 128 + 32 * q);
        float ge[32]; float ss = 0.f;
#pragma unroll
        for (int i = 0; i < 4; ++i) { const v4u w = src[i];
#pragma unroll
            for (int e = 0; e < 4; ++e) { const float a0 = gelu_tanh(bf2f(w[e] & 0xffffu)), a1 = gelu_tanh(bf2f(w[e] >> 16)); ge[8 * i + 2 * e] = a0; ge[8 * i + 2 * e + 1] = a1; ss += a0 * a0 + a1 * a1; } }
        ss += __shfl_xor(ss, 1); ss += __shfl_xor(ss, 2);
        const float rstd = 1.0f / sqrtf(ss * (1.f / 128.f) + EPS);
        const float* gp = sgg + g * 128 + 32 * q;
#pragma unroll
        for (int i = 0; i < 32; ++i) *(LAS bf16*)(Vt + (32 * q + i) * SG_PB + 2 * s) = (bf16)(cvtpk_hw(ge[i] * rstd * gp[i], 0.f) & 0xffffu);
    }
    LDS_BAR();
#pragma unroll
    for (int dt = 0; dt < 8; ++dt) {
        v4f acc = (v4f){0.f, 0.f, 0.f, 0.f};
#pragma unroll
        for (int ks = 0; ks < 4; ++ks) acc = mfma_bf(*(const LAS v4u*)(Vt + (16 * dt + l15) * SG_PB + (32 * ks + 8 * c4) * 2), wf[ks], acc);
        const float u0 = gelu_tanh(bf2f(uraw[dt].x & 0xffffu)), u1 = gelu_tanh(bf2f(uraw[dt].x >> 16)), u2 = gelu_tanh(bf2f(uraw[dt].y & 0xffffu)), u3 = gelu_tanh(bf2f(uraw[dt].y >> 16));
        v2u o; o.x = cvtpk_hw(u0 * (acc[0] + bsv), u1 * (acc[1] + bsv)); o.y = cvtpk_hw(u2 * (acc[2] + bsv), u3 * (acc[3] + bsv));
        *(v2u*)(MIX + orow * DM + 1536 + g * 128 + 16 * dt + 4 * c4) = o;
    }
    LDS_BAR();
}

__device__ __forceinline__ int hg_row(int b, int dir, int P) {
    if (P < CTXL) return b * TB + SEQ + (dir ? CTXL - 1 - P : P);
    const int t = P - CTXL; return b * TB + (dir ? SEQ - 1 - t : t);
}
constexpr int NCH = 136, SCH = 17, NSC = NCH / SCH;
constexpr size_t WS_QF = 966 * MiB, WS_KF = 1000 * MiB, WS_VF = 1034 * MiB, WS_PF = 1068 * MiB, WS_DF = 1077 * MiB;
static_assert(WS_DF + (size_t)32 * NCH * 512 <= WS_GS, "fragment buffers inside the mixer-half scratch");
constexpr int PL_DD = 53248  , PL_T = 0, PL_QF = 4096, PL_KF = PL_QF + 8192, PL_VF = PL_KF + 8192, PL_PF = PL_VF + 8192, PL_QP = PL_PF + 2048, PL_KP1 = PL_QP + 8704, PL_KP0 = PL_KP1 + 8704;

__device__ __forceinline__ unsigned bf1(float x) { return cvtpk_hw(x, 0.f) & 0xffffu; }
__device__ __forceinline__ void hgrn_pre(int l, const bf16* PROJ, const float* LBS, unsigned char* QF, unsigned char* KF, unsigned char* VF, unsigned char* PF, float* DF, float* HS, float* HD,
                                         LAS unsigned char* L, int bx, int G, int tid, int lane, int wave) {
    const int kp = lane, jj = wave, c4 = lane >> 4, l15 = lane & 15;
    constexpr float LOG2E = 1.4426950408889634f, CLAMP2 = 115.f;
    LAS v2f* T = (LAS v2f*)(L + PL_T);
    unsigned zr[4], qr[4], vr[4];
#define PRE_LOAD(it_) do { const int ch_ = (it_) / NCH, ci_ = (it_) - ch_ * NCH, dir_ = ch_ & 1, bh_ = ch_ >> 1, h_ = bh_ & 3; \
        const bf16* pr_ = PROJ + (size_t)hg_row(bh_ >> 2, dir_, 32 * ci_ + 4 * jj) * INC + h_ * 128 + 2 * kp; const long st_ = dir_ ? -(long)INC : (long)INC; const int cf_ = dir_ ? C_HFB : C_HFF; \
        _Pragma("unroll") for (int i = 0; i < 4; ++i) { zr[i] = *(const unsigned*)(pr_ + cf_); qr[i] = *(const unsigned*)(pr_ + C_HQ); vr[i] = *(const unsigned*)(pr_ + C_HI); pr_ += st_; } } while (0)
#pragma unroll 1
    for (int s = bx; s < 32 * NSC; s += G) {
    v4f acc[8], dprod[8];
#pragma unroll
    for (int kt = 0; kt < 8; ++kt) { acc[kt] = (v4f){0.f, 0.f, 0.f, 0.f}; dprod[kt] = (v4f){1.f, 1.f, 1.f, 1.f}; }
    const int it0 = (s >> 3) * NCH + (s & 7) * SCH;
    PRE_LOAD(it0);
#pragma unroll 1
    for (int it = it0; it < it0 + SCH; ++it) {
        const int chain = it / NCH;
        const int dir = chain & 1, h = (chain >> 1) & 3;
        const v2f lb2 = *(const v2f*)(LBS + (dir * DEPTH + l) * 512 + h * 128 + 2 * kp);
        float cs[2][4], kk[2][4], qq[2][4];
#pragma unroll
        for (int i = 0; i < 4; ++i)
#pragma unroll
            for (int e = 0; e < 2; ++e) {
                float z = bf2f(e ? zr[i] >> 16 : zr[i] & 0xffffu); z = fminf(fmaxf(z, -40.f), 40.f);
                const float q = bf2f(e ? qr[i] >> 16 : qr[i] & 0xffffu);
                qq[e][i] = q * __builtin_amdgcn_rcpf(1.f + __builtin_amdgcn_exp2f(-q * LOG2E));
                const float lb = e ? lb2.y : lb2.x, oml = 1.f - lb;
                const float ez = __builtin_amdgcn_exp2f(-z * LOG2E), sg = __builtin_amdgcn_rcpf(1.f + ez);
                cs[e][i] = __builtin_amdgcn_logf(fmaxf(lb + oml * sg, 1e-30f)); kk[e][i] = oml * ez * sg;
            }
        v2u vfa, vfb;
        vfa.x = (vr[0] & 0xffffu) | (vr[1] << 16); vfa.y = (vr[2] & 0xffffu) | (vr[3] << 16);
        vfb.x = (vr[0] >> 16) | (vr[1] & 0xffff0000u); vfb.y = (vr[2] >> 16) | (vr[3] & 0xffff0000u);
        if (it + 1 < it0 + SCH) PRE_LOAD(it + 1);
#pragma unroll
        for (int e = 0; e < 2; ++e)
#pragma unroll
            for (int i = 1; i < 4; ++i) cs[e][i] += cs[e][i - 1];
        T[jj * 64 + kp] = (v2f){cs[0][3], cs[1][3]};
        LDS_BAR();
        v2f pre = (v2f){0.f, 0.f}, bend = pre, b15 = pre;
#pragma unroll
        for (int w = 0; w < 8; ++w) { const v2f t = T[w * 64 + kp]; bend += t; if (w < 4) b15 += t; if (w < jj) pre += t; }
        LAS unsigned char* qfp = L + PL_QF + (((jj >> 2) * 4 + (kp >> 4)) * 64 + ((kp >> 1) & 3) * 16 + 4 * (jj & 3)) * 16 + (4 * ((kp >> 3) & 1) + 2 * (kp & 1)) * 2;
        LAS unsigned char* qpp = L + PL_QP + (4 * jj) * 272 + 4 * kp;
        float kh[2][4];
#pragma unroll
        for (int i = 0; i < 4; ++i) {
            float qt[2], qp[2], kp1[2], kp0[2];
#pragma unroll
            for (int e = 0; e < 2; ++e) {
                const float bi = (e ? pre.y : pre.x) + cs[e][i], be = e ? bend.y : bend.x, bm = e ? b15.y : b15.x;
                qt[e] = qq[e][i] * __builtin_amdgcn_exp2f(bi);
                kh[e][i] = kk[e][i] * __builtin_amdgcn_exp2f(be - bi);
                qp[e] = (jj < 4) ? qt[e] : qq[e][i] * __builtin_amdgcn_exp2f(bi - bm);
                kp1[e] = kk[e][i] * __builtin_amdgcn_exp2f(fminf(bm - bi, CLAMP2));
                kp0[e] = (jj < 4) ? kk[e][i] * __builtin_amdgcn_exp2f(fminf(-bi, CLAMP2)) : 0.f;
            }
            *(LAS unsigned*)(qfp + i * 16) = cvtpk_hw(qt[0], qt[1]);
            *(LAS unsigned*)(qpp + i * 272) = cvtpk_hw(qp[0], qp[1]);
            *(LAS unsigned*)(qpp + (PL_KP1 - PL_QP) + i * 272) = cvtpk_hw(kp1[0], kp1[1]);
            if (jj < 4) *(LAS unsigned*)(qpp + (PL_KP0 - PL_QP) + i * 272) = cvtpk_hw(kp0[0], kp0[1]);
        }
        {
            const int ka = 2 * kp, fo = ((ka >> 4) * 64 + (jj >> 1) * 16 + (ka & 15)) * 16 + 8 * (jj & 1);
            v2u w0, w1; w0.x = cvtpk_hw(kh[0][0], kh[0][1]); w0.y = cvtpk_hw(kh[0][2], kh[0][3]); w1.x = cvtpk_hw(kh[1][0], kh[1][1]); w1.y = cvtpk_hw(kh[1][2], kh[1][3]);
            *(LAS v2u*)(L + PL_KF + fo) = w0; *(LAS v2u*)(L + PL_KF + fo + 16) = w1;
            *(LAS v2u*)(L + PL_VF + fo) = vfa; *(LAS v2u*)(L + PL_VF + fo + 16) = vfb; }
        if (jj == 0) { const v2f dd = (v2f){__builtin_amdgcn_exp2f(bend.x), __builtin_amdgcn_exp2f(bend.y)}; *(v2f*)(DF + (size_t)it * 128 + 2 * kp) = dd; *(LAS v2f*)(L + PL_DD + 8 * kp) = dd; }
        LDS_BAR();
        if (wave < 3) {
            const LAS unsigned char* qa = L + PL_QP + ((wave == 0 ? 0 : 16) + l15) * 272 + c4 * 16;
            const LAS unsigned char* kb = (wave == 0 ? L + PL_KP0 + l15 * 272 : L + PL_KP1 + ((wave == 2 ? 16 : 0) + l15) * 272) + c4 * 16;
            v4f p = (v4f){0.f, 0.f, 0.f, 0.f};
#pragma unroll
            for (int s = 0; s < 4; ++s) p = mfma_bf(*(const LAS v4u*)(qa + s * 64), *(const LAS v4u*)(kb + s * 64), p);
            const int mt = wave == 0 ? 0 : 1, sidx = (wave == 2 ? 16 : 0) + l15;
#pragma unroll
            for (int r = 0; r < 4; ++r) { const int tl = 4 * c4 + r; const float v = (wave == 1 || l15 <= tl) ? p[r] : 0.f;
                *(LAS bf16*)(L + PL_PF + (mt * 64 + (sidx >> 3) * 16 + tl) * 16 + (sidx & 7) * 2) = (bf16)bf1(v); }
        } else if (wave == 3) {
            if (lane < 32) { unsigned zz; asm volatile("v_mov_b32 %0, 0" : "=v"(zz)); *(LAS v4u*)(L + PL_PF + (32 + lane) * 16) = (v4u){zz, zz, zz, zz}; }
        }
        LDS_BAR();
        if ((s & 7) < NSC - 1) {
            const v4u vfr = *(const LAS v4u*)(L + PL_VF + (wave * 64 + lane) * 16);
#pragma unroll
            for (int kt = 0; kt < 8; ++kt) { const v4f d = *(const LAS v4f*)(L + PL_DD + (16 * kt + 4 * c4) * 4);
                acc[kt] = acc[kt] * d; acc[kt] = mfma_bf(*(const LAS v4u*)(L + PL_KF + (kt * 64 + lane) * 16), vfr, acc[kt]); dprod[kt] = dprod[kt] * d; }
        }
        *(v4u*)(QF + (size_t)it * 8192 + tid * 16) = *(const LAS v4u*)(L + PL_QF + tid * 16);
        *(v4u*)(KF + (size_t)it * 8192 + tid * 16) = *(const LAS v4u*)(L + PL_KF + tid * 16);
        *(v4u*)(VF + (size_t)it * 8192 + tid * 16) = *(const LAS v4u*)(L + PL_VF + tid * 16);
        if (tid < 128) *(v4u*)(PF + (size_t)it * 2048 + tid * 16) = *(const LAS v4u*)(L + PL_PF + tid * 16);
    }
    if ((s & 7) < NSC - 1) {
        float* slot = HS + (size_t)s * 16384;
#pragma unroll
        for (int kt = 0; kt < 8; ++kt)
#pragma unroll
            for (int r = 0; r < 4; ++r) slot[(16 * kt + 4 * c4 + r) * 128 + 16 * wave + l15] = acc[kt][r];
        if (wave == 0 && l15 == 0) {
#pragma unroll
            for (int kt = 0; kt < 8; ++kt) *(v4f*)(HD + (size_t)s * 128 + 16 * kt + 4 * c4) = dprod[kt];
        }
    }
    LDS_BAR();
    }
#undef PRE_LOAD
}
constexpr int HU_Q = 0, HU_K = 8192, HU_P = 16384, HU_D = 18432, HU_SLOT = 18944, HU_OT = 2 * HU_SLOT + 1024  ;
template <bool WITH_OUT>
__device__ __forceinline__ void hgrn_unit2(int chain, int sc, const unsigned char* QF, const unsigned char* KF, const unsigned char* VF, const unsigned char* PF, const float* DF,
                                           float* HS, float* HD, bf16* HO, LAS unsigned char* L, int tid, int lane, int wave) {
    static_assert(WITH_OUT, "the local-state recurrence lives in hgrn_pre now");
    const int dir = chain & 1, bh = chain >> 1, b = bh >> 2, h = bh & 3, c4 = lane >> 4, l15 = lane & 15;
    v4f acc[8];
    const size_t item0 = (size_t)chain * NCH + sc * SCH;
    v4u rqA, rkA, rpA, rdA, vfA, rqB, rkB, rpB, rdB, vfB, vf;
#define HU_LOAD(S_, it_) do { rq##S_ = *(const v4u*)(QF + (it_) * 8192 + tid * 16); rk##S_ = *(const v4u*)(KF + (it_) * 8192 + tid * 16); \
        if (tid < 128) rp##S_ = *(const v4u*)(PF + (it_) * 2048 + tid * 16); if (tid < 32) rd##S_ = *(const v4u*)((const unsigned char*)DF + (it_) * 512 + tid * 16); \
        vf##S_ = ((const v4u*)(VF + (it_) * 8192))[wave * 64 + lane]; } while (0)
#define HU_WRITE(S_, s_) do { LAS unsigned char* sl_ = L + (s_) * HU_SLOT; *(LAS v4u*)(sl_ + HU_Q + tid * 16) = rq##S_; *(LAS v4u*)(sl_ + HU_K + tid * 16) = rk##S_; \
        if (tid < 128) *(LAS v4u*)(sl_ + HU_P + tid * 16) = rp##S_; if (tid < 32) *(LAS v4u*)(sl_ + HU_D + tid * 16) = rd##S_; } while (0)
#define HU_FLUSH(step_) do { const int t_ = tid >> 4; const int row_ = hg_row(b, dir, 32 * (sc * SCH + (step_)) + t_); \
        *(v4u*)(HO + ((size_t)dir * R + row_) * 512 + h * 128 + 8 * (tid & 15)) = *(const LAS v4u*)(L + HU_OT + ((step_) & 1) * 8192 + tid * 16); } while (0)
#define HU_COMPUTE(step_) do { const LAS unsigned char* sl = L + ((step_) & 1) * HU_SLOT; \
        v4u sb[4]; \
        _Pragma("unroll") for (int ks = 0; ks < 4; ++ks) { sb[ks].x = cvtpk_hw(acc[2 * ks][0], acc[2 * ks][1]); sb[ks].y = cvtpk_hw(acc[2 * ks][2], acc[2 * ks][3]); \
            sb[ks].z = cvtpk_hw(acc[2 * ks + 1][0], acc[2 * ks + 1][1]); sb[ks].w = cvtpk_hw(acc[2 * ks + 1][2], acc[2 * ks + 1][3]); } \
        _Pragma("unroll") for (int mt = 0; mt < 2; ++mt) { \
            v4f o = (v4f){0.f, 0.f, 0.f, 0.f}; \
            _Pragma("unroll") for (int ks = 0; ks < 4; ++ks) o = mfma_bf(*(const LAS v4u*)(sl + HU_Q + ((mt * 4 + ks) * 64 + lane) * 16), sb[ks], o); \
            o = mfma_bf(*(const LAS v4u*)(sl + HU_P + (mt * 64 + lane) * 16), vf, o); \
            _Pragma("unroll") for (int r = 0; r < 4; ++r) *(LAS bf16*)(L + HU_OT + ((step_) & 1) * 8192 + ((16 * mt + 4 * c4 + r) * 128 + 16 * wave + l15) * 2) = (bf16)bf1(o[r]); } \
        _Pragma("unroll") for (int kt = 0; kt < 8; ++kt) { const v4f d = *(const LAS v4f*)(sl + HU_D + (16 * kt + 4 * c4) * 4); \
            acc[kt] = acc[kt] * d; acc[kt] = mfma_bf(*(const LAS v4u*)(sl + HU_K + (kt * 64 + lane) * 16), vf, acc[kt]); } } while (0)
    HU_LOAD(A, item0);
    HU_LOAD(B, item0 + 1);
    if (sc > 0) {
        const float* slot = HS + (size_t)(chain * NSC + sc - 1) * 16384;
#pragma unroll
        for (int kt = 0; kt < 8; ++kt)
#pragma unroll
            for (int r = 0; r < 4; ++r) acc[kt][r] = slot[(16 * kt + 4 * c4 + r) * 128 + 16 * wave + l15];
    } else {
#pragma unroll
        for (int kt = 0; kt < 8; ++kt) acc[kt] = (v4f){0.f, 0.f, 0.f, 0.f};
    }
    HU_WRITE(A, 0); vf = vfA;
    LDS_BAR();
#pragma unroll 1
    for (int step = 0; step < SCH; step += 2) {
        if (step + 2 < SCH) HU_LOAD(A, item0 + step + 2);
        if (step > 0) HU_FLUSH(step - 1);
        HU_COMPUTE(step);
        if (step + 1 < SCH) { HU_WRITE(B, 1); vf = vfB; }
        LDS_BAR();
        if (step + 1 < SCH) {
            if (step + 3 < SCH) HU_LOAD(B, item0 + step + 3);
            HU_FLUSH(step);
            HU_COMPUTE(step + 1);
            if (step + 2 < SCH) { HU_WRITE(A, 0); vf = vfA; }
            LDS_BAR();
        }
    }
    HU_FLUSH(SCH - 1);
    LDS_BAR();
#undef HU_LOAD
#undef HU_WRITE
#undef HU_COMPUTE
#undef HU_FLUSH
    (void)HD;
}
__device__ __forceinline__ void hgrn_scan(float* HS, const float* HD, int gtid, int NT) {
    for (int e = gtid; e < 32 * 4096; e += NT) {
        const int chain = e >> 12, q4 = e & 4095, k = q4 >> 5;
        v4f* p = (v4f*)(HS + (size_t)chain * NSC * 16384) + q4; const float* dp = HD + chain * NSC * 128 + k;
        v4f tmp[NSC - 1]; float dd[NSC - 1];
#pragma unroll
        for (int s = 0; s < NSC - 1; ++s) { tmp[s] = p[(size_t)s * 4096]; dd[s] = dp[s * 128]; }
        v4f st = (v4f){0.f, 0.f, 0.f, 0.f};
#pragma unroll
        for (int s = 0; s < NSC - 1; ++s) { st = st * dd[s] + tmp[s]; p[(size_t)s * 4096] = st; }
    }
}
__device__ __forceinline__ void hg_combine(const bf16* HO, const bf16* PROJ, bf16* MIX, const float* hgg, bool skip_ctx, int gw, int NGW, int lane) {
    const float g0 = hgg[2 * lane], g1 = hgg[2 * lane + 1];
#pragma unroll 1
    for (int m0 = 4 * gw; m0 < R; m0 += 4 * NGW) {
        const int b = m0 / TB, t = m0 - b * TB; if (t >= SEQ && skip_ctx) continue;
        unsigned a[4][4], c[4][4], w2[4][4];
#pragma unroll
        for (int rr = 0; rr < 4; ++rr)
#pragma unroll
            for (int h = 0; h < 4; ++h) { const bf16* p0 = HO + (size_t)(m0 + rr) * 512 + h * 128 + 2 * lane;
                a[rr][h] = *(const unsigned*)p0; c[rr][h] = *(const unsigned*)(p0 + (size_t)R * 512);
                w2[rr][h] = *(const unsigned*)(PROJ + (size_t)(m0 + rr) * INC + C_HGT + h * 128 + 2 * lane); }
#pragma unroll
        for (int rr = 0; rr < 4; ++rr)
#pragma unroll
            for (int h = 0; h < 4; ++h) {
                const float o0 = bf2f(a[rr][h] & 0xffffu) + bf2f(c[rr][h] & 0xffffu), o1 = bf2f(a[rr][h] >> 16) + bf2f(c[rr][h] >> 16);
                const float rstd = __builtin_amdgcn_rsqf(wave_sum(o0 * o0 + o1 * o1) * (1.f / 128.f) + EPS);
                const float y0 = o0 * rstd * g0 * silu_f(bf2f(w2[rr][h] & 0xffffu)), y1 = o1 * rstd * g1 * silu_f(bf2f(w2[rr][h] >> 16));
                *(unsigned*)(MIX + (size_t)(m0 + rr) * DM + 1024 + h * 128 + 2 * lane) = cvtpk_rne(y0, y1);
            }
    }
}
__device__ __forceinline__ void conv_act_phase(const bf16* UP, bf16* ACT, const float* cw, const float* cb, bool skip_ctx, int gtid, int NT) {
    constexpr int NOCT = DFF / 8, NSTRIP = R / 32;
    for (int it = gtid; it < NSTRIP * NOCT; it += NT) {
        const int strip = it / NOCT, oc = it - strip * NOCT, wi = strip % (TB / 32), c0 = oc * 8;
        if (skip_ctx && wi >= SEQ / 32) continue;
        const bool seg_start = (wi == 0 || wi == SEQ / 32), seg_end = (wi == SEQ / 32 - 1 || wi == TB / 32 - 1);
        float w[2][3][8], bb[2][8];
#pragma unroll
        for (int hlf = 0; hlf < 2; ++hlf) {
#pragma unroll
            for (int jj = 0; jj < 3; ++jj) { const v4f a0 = *(const v4f*)(cw + (size_t)jj * UPC + hlf * DFF + c0), a1 = *(const v4f*)(cw + (size_t)jj * UPC + hlf * DFF + c0 + 4);
                w[hlf][jj][0] = a0.x; w[hlf][jj][1] = a0.y; w[hlf][jj][2] = a0.z; w[hlf][jj][3] = a0.w; w[hlf][jj][4] = a1.x; w[hlf][jj][5] = a1.y; w[hlf][jj][6] = a1.z; w[hlf][jj][7] = a1.w; }
            const v4f b0 = *(const v4f*)(cb + hlf * DFF + c0), b1 = *(const v4f*)(cb + hlf * DFF + c0 + 4);
            bb[hlf][0] = b0.x; bb[hlf][1] = b0.y; bb[hlf][2] = b0.z; bb[hlf][3] = b0.w; bb[hlf][4] = b1.x; bb[hlf][5] = b1.y; bb[hlf][6] = b1.z; bb[hlf][7] = b1.w;
        }
        const size_t r0 = (size_t)strip * 32;
        v4u pg = (v4u){0u, 0u, 0u, 0u}, pv = pg, cg, cvv, ng, nv;
        if (!seg_start) { pg = *(const v4u*)(UP + (r0 - 1) * UPC + c0); pv = *(const v4u*)(UP + (r0 - 1) * UPC + DFF + c0); }
        cg = *(const v4u*)(UP + r0 * UPC + c0); cvv = *(const v4u*)(UP + r0 * UPC + DFF + c0);
#pragma unroll 2
        for (int i = 0; i < 32; ++i) {
            if (i < 31 || !seg_end) { ng = *(const v4u*)(UP + (r0 + i + 1) * UPC + c0); nv = *(const v4u*)(UP + (r0 + i + 1) * UPC + DFF + c0); }
            else { ng = (v4u){0u, 0u, 0u, 0u}; nv = ng; }
            v4u o;
#pragma unroll
            for (int q = 0; q < 4; ++q) {
                float res[2];
#pragma unroll
                for (int e = 0; e < 2; ++e) {
                    const int ci = 2 * q + e;
                    const float gp = e ? bf2f(pg[q] >> 16) : bf2f(pg[q] & 0xffffu), gc = e ? bf2f(cg[q] >> 16) : bf2f(cg[q] & 0xffffu), gn = e ? bf2f(ng[q] >> 16) : bf2f(ng[q] & 0xffffu);
                    const float vp = e ? bf2f(pv[q] >> 16) : bf2f(pv[q] & 0xffffu), vc = e ? bf2f(cvv[q] >> 16) : bf2f(cvv[q] & 0xffffu), vn = e ? bf2f(nv[q] >> 16) : bf2f(nv[q] & 0xffffu);
                    const float yg = bb[0][ci] + w[0][0][ci] * gp + w[0][1][ci] * gc + w[0][2][ci] * gn;
                    const float yv = bb[1][ci] + w[1][0][ci] * vp + w[1][1][ci] * vc + w[1][2][ci] * vn;
                    res[e] = silu_f(yg) * yv;
                }
                o[q] = pk2(res[0], res[1]);
            }
            *(v4u*)(ACT + (r0 + i) * DFF + c0) = o;
            pg = cg; pv = cvv; cg = ng; cvv = nv;
        }
    }
}

__device__ __forceinline__ kptr_t kargs_fresh() { kptr_t p = (kptr_t)__builtin_amdgcn_kernarg_segment_ptr(); asm volatile("" : "+s"(p)); return p; }
#define KIN(i)  (*(const float* const AS4*)(kp + 8 * (i)))
#define KOUT()  (*(float* const AS4*)(kp + 176))
#define KWS()   (*(unsigned char* const AS4*)(kp + 184))
#define PH_BEGIN \
    int tid = threadIdx.x; asm volatile("" : "+v"(tid)); \
    const int lane = tid & 63, wave = __builtin_amdgcn_readfirstlane(tid >> 6); \
    int bx = blockIdx.x; asm volatile("" : "+s"(bx)); int G = gridDim.x; asm volatile("" : "+s"(G)); \
    const int gw = bx * NWAVES + wave, NGW = G * NWAVES, gtid = bx * NTHR + tid, NT = G * NTHR; \
    const kptr_t kp = kargs_fresh(); unsigned char* const ws = KWS(); \
    (void)lane; (void)gw; (void)NGW; (void)gtid; (void)NT; (void)ws;

template <int SEL>
__device__ __forceinline__ void convert_item(int l, int r, kptr_t kp, unsigned char* ws, LAS float* scr, int lane) {
    unsigned char* wb = ws + WS_W + (size_t)l * W_LAYER; const float* MOD = (const float*)(ws + WS_MOD) + (size_t)l * 5 * NMODC;
    if (SEL & 1) { if (r < CI_IN) { p0_transpose_item<true>(KIN(I_WIN) + (size_t)l * DM * INC, DM, INC, (bf16*)(wb + W_IN), scr, r, lane, (float*)(ws + WS_SWIN) + (size_t)l * 5 * INC, MOD + 0 * DM); return; } r -= CI_IN; }
    if (SEL & 2) { if (r < CI_OUT) { p0_transpose_item<false>(KIN(I_WOUT) + (size_t)l * DM * DM, DM, DM, (bf16*)(wb + W_OUT), scr, r, lane, nullptr, nullptr); return; } r -= CI_OUT; }
    if (SEL & 4) { if (r < CI_UP) { p0_transpose_item<true>(KIN(I_WUP) + (size_t)l * DM * UPC, DM, UPC, (bf16*)(wb + W_UP), scr, r, lane, (float*)(ws + WS_SWUP) + (size_t)l * 5 * UPC, MOD + 3 * DM); return; } r -= CI_UP; }
    if (SEL & 8) { p0_transpose_item<false>(KIN(I_WDN) + (size_t)l * DFF * DM, DFF, DM, (bf16*)(wb + W_DN), scr, r, lane, nullptr, nullptr); }
}

__global__ void __launch_bounds__(NTHR, 2) mk_fwd(Args a_unused) {
    extern __shared__ __attribute__((aligned(16))) unsigned char lds[];
    LAS unsigned char* ldsp = (LAS unsigned char*)lds;
    int lo, hi;
    { const kptr_t kp = kargs_fresh(); lo = *(const int AS4*)(kp + 192); hi = *(const int AS4*)(kp + 196); }
    for (int u = threadIdx.x; u < (LDS_BYTES - LDSCTL_OFF) / 4; u += NTHR) ((LAS unsigned*)(ldsp + LDSCTL_OFF))[u] = 0u;
    __syncthreads();
#if MK_ONE_LAUNCH
    XcdBarrier bar;
    { const kptr_t kp = kargs_fresh(); bar = xcd_barrier_post((unsigned*)(KWS() + WS_CTL) + CW_BAR, (volatile LAS unsigned*)(ldsp + MISC_OFF) + 8); }
#define GRID_BAR() xcd_barrier(bar)
#else
#define GRID_BAR() do { } while (0)
#endif
#define IN(k) (lo <= (k) && (k) < hi)

    if (IN(0)) {
        PH_BEGIN
        float* MOD = (float*)(ws + WS_MOD);
        p0_mod(KIN(I_C), KIN(I_CCTX), KIN(I_WADA), KIN(I_BADA), ldsp, MOD, tid, lane, wave, bx, G);
        if (bx == G - 1) {
            float* LBS = (float*)(ws + WS_MISC); float* RCOS = (float*)(ws + WS_MISC + 16384); float* RSIN = (float*)(ws + WS_MISC + 24576);
            const float* lbp = KIN(I_LBP);
            for (int i = tid; i < 1024; i += NTHR) { const int dir = i >> 9, ci = i & 511; float v[DEPTH], mx = -3.0e38f;
#pragma unroll
                for (int l = 0; l < DEPTH; ++l) { v[l] = lbp[(dir * DEPTH + l) * 512 + ci]; mx = fmaxf(mx, v[l]); }
                float s = 0.f;
#pragma unroll
                for (int l = 0; l < DEPTH; ++l) { v[l] = expf(v[l] - mx); s += v[l]; }
                float cum = 0.f;
#pragma unroll
                for (int l = 0; l < DEPTH; ++l) { if (l > 0) cum += v[l] / s; LBS[(dir * DEPTH + l) * 512 + ci] = cum; } }
            for (int i = tid; i < 2048; i += NTHR) { const int pos = i >> 5, fi = i & 31; const float inv = powf(10000.f, -(float)fi / 32.f); const float ang = (float)pos * inv; RCOS[i] = cosf(ang); RSIN[i] = sinf(ang); }
        }
        __syncthreads();
        {
            LAS float* scr = (LAS float*)(ldsp + wave * 16384);
            for (int it = gw; it < convert_count<2 | 8>(); it += NGW) convert_item<2 | 8>(0, it, kp, ws, scr, lane);
        }
        GRID_BAR();
    }

    if (IN(1)) { PH_BEGIN
        const float* MOD = (const float*)(ws + WS_MOD);
        {
            const float* xin = KIN(I_X); const float* cin = KIN(I_CTX); bf16* H = (bf16*)(ws + WS_H); float* RS0 = (float*)(ws + WS_RS); const float* g = KIN(I_N1G);
            for (int m = gw; m < R; m += NGW) {
                const int b = m / TB, t = m - b * TB; const float* mrow = MOD + (size_t)(t >= SEQ ? 4 : b) * NMODC;
                const v4f* xr = (const v4f*)(t < SEQ ? xin + ((size_t)b * SEQ + t) * DM : cin + ((size_t)b * CTXL + (t - SEQ)) * DM) + lane; float ss = 0.f;
#pragma unroll
                for (int j = 0; j < 8; ++j) { const v4f v = xr[64 * j]; ss += (v.x * v.x + v.y * v.y) + (v.z * v.z + v.w * v.w); const int c = 4 * lane + 256 * j;
                    const v4f y = v * *(const v4f*)(g + c) * (1.f + *(const v4f*)(mrow + 1 * DM + c));
                    v2u w; w.x = pk2(y.x, y.y); w.y = pk2(y.z, y.w); *(v2u*)(H + (size_t)m * DM + c) = w; }
                ss = wave_sum(ss); if (lane == 0) RS0[m] = ss;
            } }
        {
            float* GS = (float*)(ws + WS_GS); const float* g1 = KIN(I_N1G); const float* g2 = KIN(I_N2G);
            for (int i = gtid; i < DEPTH * 2 * 5 * DM; i += NT) { const int c = i & (DM - 1), r = (i >> 11) % 5, wl = i / (5 * DM), which = wl & 1, l = wl >> 1;
                GS[i] = (which ? g2 : g1)[l * DM + c] * (1.f + MOD[(size_t)(l * 5 + r) * NMODC + (which ? 4 : 1) * DM + c]); } }
        {
            LAS float* scr = (LAS float*)(ldsp + wave * 16384);
            for (int it = gw; it < convert_count<1 | 4>(); it += NGW) convert_item<1 | 4>(0, it, kp, ws, scr, lane);
        }
        GRID_BAR();
    }

#pragma unroll 1
    for (int l = 0; l < DEPTH; ++l) {
        const int pb = 2 + 9 * l; const bool last = (l == DEPTH - 1);
#define MODL ((const float*)(ws + WS_MOD) + (size_t)l * 5 * NMODC)
#define WB   (ws + WS_W + (size_t)l * W_LAYER)
#define RSL(s_) ((float*)(ws + WS_RS) + (size_t)(s_) * R)
#define GSL(l_, which_) ((const float*)(ws + WS_GS) + (size_t)((l_) * 2 + (which_)) * 5 * DM)
        if (IN(pb + 0)) { PH_BEGIN
            pg8::Gemm g{(const bf16*)(ws + WS_H), (const bf16*)(WB + W_IN), R, INC, DM}; TileOrder S; S.init2(INC, G, bx, false);
            EpiBf16N E{(bf16*)(ws + WS_PROJ), INC, RSL(2 * l), (const float*)(ws + WS_SWIN) + (size_t)l * 5 * INC};
            pg8::gemm_phase<EpiBf16N, TileOrder, true, true>(ldsp, g, S, E);
            GRID_BAR();
        }
        if (IN(pb + 1)) { PH_BEGIN
            const bf16* PROJ = (const bf16*)(ws + WS_PROJ);
            qknorm_phase(PROJ, (bf16*)(ws + WS_QN), (bf16*)(ws + WS_KN), KIN(I_QG) + l * 128, KIN(I_KG) + l * 128, (const float*)(ws + WS_MISC + 16384), (const float*)(ws + WS_MISC + 24576), gw, NGW, lane);
            {   const int nch = last ? 32 : 34, nU = NB * nch * 4;
                for (int u = bx; u < nU; u += G) { const int g = u & 3, bn = u >> 2, b = bn / nch, n = bn - b * nch;
                    sg_unit(b, n, g, l, PROJ, (bf16*)(ws + WS_MIX), KIN(I_SGG) + l * 512, KIN(I_SGW), KIN(I_SGB), ldsp, tid, lane, wave); } }
            hgrn_pre(l, PROJ, (const float*)(ws + WS_MISC), ws + WS_QF, ws + WS_KF, ws + WS_VF, ws + WS_PF, (float*)(ws + WS_DF), (float*)(ws + WS_HS), (float*)(ws + WS_HD), ldsp, bx, G, tid, lane, wave);
            GRID_BAR();
        }
        if (IN(pb + 2)) { PH_BEGIN
            hgrn_scan((float*)(ws + WS_HS), (const float*)(ws + WS_HD), gtid, NT);
            const int nU = last ? 512 : 544;
            for (int u = bx; u < nU; u += G) {
                int b, hq, row_q, row_k, seq;
                if (u < 512) { const int xcd = u & 7, idx = u >> 3; b = xcd >> 1; hq = (xcd & 1) * 4 + (idx >> 4); row_k = b * TB; row_q = row_k + (idx & 15) * 256; seq = TB; }
                else { const int uc = u - 512; b = uc >> 3; hq = uc & 7; row_k = b * TB + SEQ; row_q = row_k; seq = CTXL; }
                const int kvh = hq >> 2;
                att::attn_dense_body((const bf16*)(ws + WS_QN) + (size_t)row_q * 1024 + hq * 128, (const bf16*)(ws + WS_KN) + (size_t)row_k * 256 + kvh * 128,
                                     (const bf16*)(ws + WS_PROJ) + (size_t)row_k * INC + C_AV + kvh * 128, (bf16*)(ws + WS_MIX) + (size_t)row_q * DM + hq * 128, seq, (char*)lds);
            }
            GRID_BAR();
        }
        if (IN(pb + 3)) { PH_BEGIN
            for (int u = bx; u < 32 * NSC; u += G) hgrn_unit2<true>(u & 31, u >> 5, ws + WS_QF, ws + WS_KF, ws + WS_VF, ws + WS_PF, (const float*)(ws + WS_DF), (float*)(ws + WS_HS), (float*)(ws + WS_HD), (bf16*)(ws + WS_HO), ldsp, tid, lane, wave);
            GRID_BAR();
        }
        if (IN(pb + 4)) { PH_BEGIN hg_combine((const bf16*)(ws + WS_HO), (const bf16*)(ws + WS_PROJ), (bf16*)(ws + WS_MIX), KIN(I_HGG) + l * 128, last, gw, NGW, lane); GRID_BAR(); }
        if (IN(pb + 5)) { PH_BEGIN
            pg8::Gemm g{(const bf16*)(ws + WS_MIX), (const bf16*)(WB + W_OUT), R, DM, DM}; TileOrder S; S.init2(DM, G, bx, last);
            EpiResGate<true> E{(float*)(ws + WS_X), MODL, 2, (bf16*)(ws + WS_H), GSL(l, 1), RSL(2 * l + 1), l == 0 ? KIN(I_X) : nullptr, l == 0 ? KIN(I_CTX) : nullptr};
            pg8::gemm_phase<EpiResGate<true>, TileOrder, true, true>(ldsp, g, S, E);
            if (!last) {
                const int nfull = (G == 256) ? 32 : 0; LAS float* scr = (LAS float*)(ldsp + wave * 16384);
                if (bx >= nfull) for (int it = (bx - nfull) * NWAVES + wave; it < convert_count<1 | 2>(); it += (G - nfull) * NWAVES) convert_item<1 | 2>(l + 1, it, kp, ws, scr, lane);
            }
            GRID_BAR();
        }
        if (IN(pb + 6)) { PH_BEGIN
            pg8::Gemm g{(const bf16*)(ws + WS_H), (const bf16*)(WB + W_UP), R, UPC, DM}; TileOrder S; S.init2(UPC, G, bx, last);
            EpiBf16N E{(bf16*)(ws + WS_UP), UPC, RSL(2 * l + 1), (const float*)(ws + WS_SWUP) + (size_t)l * 5 * UPC};
            pg8::gemm_phase<EpiBf16N, TileOrder, true, true>(ldsp, g, S, E);
            GRID_BAR();
        }
        if (IN(pb + 7)) { PH_BEGIN conv_act_phase((const bf16*)(ws + WS_UP), (bf16*)(ws + WS_ACT), KIN(I_CW) + (size_t)l * 3 * UPC, KIN(I_CB) + (size_t)l * UPC, last, gtid, NT); GRID_BAR(); }
        if (IN(pb + 8)) { PH_BEGIN
            pg8::Gemm g{(const bf16*)(ws + WS_ACT), (const bf16*)(WB + W_DN), R, DM, DFF}; TileOrder S; S.init2(DM, G, bx, last);
            if (!last) { EpiResGate<true> E{(float*)(ws + WS_X), MODL, 5, (bf16*)(ws + WS_H), GSL(l + 1, 0), RSL(2 * l + 2), nullptr, nullptr};
                pg8::gemm_phase<EpiResGate<true>, TileOrder, true, true>(ldsp, g, S, E);
                const int nfull = (G == 256) ? 32 : 0; LAS float* scr = (LAS float*)(ldsp + wave * 16384);
                if (bx >= nfull) for (int it = (bx - nfull) * NWAVES + wave; it < convert_count<4 | 8>(); it += (G - nfull) * NWAVES) convert_item<4 | 8>(l + 1, it, kp, ws, scr, lane); }
            else { EpiResGate<false> E{(float*)(ws + WS_X), MODL, 5, nullptr, nullptr, nullptr, nullptr, nullptr};
                pg8::gemm_phase<EpiResGate<false>, TileOrder, true, true>(ldsp, g, S, E); }
            GRID_BAR();
        }
    }
    if (IN(NPHASE - 1)) { PH_BEGIN
        const float* g = KIN(I_FNG); const float* X = (const float*)(ws + WS_X); float* out = KOUT();
        for (int m = gw; m < NB * SEQ; m += NGW) {
            const int b = m >> 12, t = m & 4095;
            const v4f* xr = (const v4f*)(X + (size_t)(b * TB + t) * DM) + lane;
            v4f v[8]; float ss = 0.f;
#pragma unroll
            for (int j = 0; j < 8; ++j) { v[j] = xr[64 * j]; ss += (v[j].x * v[j].x + v[j].y * v[j].y) + (v[j].z * v[j].z + v[j].w * v[j].w); }
            const float rstd = 1.0f / sqrtf(wave_sum(ss) * (1.f / DM) + EPS);
            v4f* orow = (v4f*)(out + (size_t)m * DM) + lane;
#pragma unroll
            for (int j = 0; j < 8; ++j) orow[64 * j] = v[j] * rstd * *(const v4f*)(g + 4 * lane + 256 * j);
        }
    }
#undef IN
}

extern "C" void kernel_launch(void* const* d_in, const int* in_sizes, int n_in, void* d_out, int out_size, void* d_ws, size_t ws_size, hipStream_t stream) {
    static int grid = 0;
    if (grid == 0) {
        if (n_in != 22 || in_sizes[0] != NB * SEQ * DM || out_size != NB * SEQ * DM || ws_size < WS_END) {
            fprintf(stderr, "kernel_launch: unexpected shapes (n_in %d in0 %d out %d ws %zu, need ws >= %zu); nothing launched\n", n_in, n_in > 0 ? in_sizes[0] : -1, out_size, ws_size, (size_t)WS_END); grid = -1; return; }
        int dev = 0, cus = 0, per_cu = 0;
        if (hipGetDevice(&dev) != hipSuccess || hipDeviceGetAttribute(&cus, hipDeviceAttributeMultiprocessorCount, dev) != hipSuccess) { grid = -1; return; }
        if (hipFuncSetAttribute((const void*)mk_fwd, hipFuncAttributeMaxDynamicSharedMemorySize, LDS_BYTES) != hipSuccess) { fprintf(stderr, "kernel_launch: hipFuncSetAttribute failed\n"); grid = -1; return; }
        if (hipOccupancyMaxActiveBlocksPerMultiprocessor(&per_cu, (const void*)mk_fwd, NTHR, LDS_BYTES) != hipSuccess || per_cu < 1)
            fprintf(stderr, "kernel_launch: note: occupancy query reports %d workgroups per CU\n", per_cu);
        (void)hipGetLastError();
        grid = cus;
    }
    if (grid < 0) return;
    if (hipMemsetAsync((char*)d_ws + WS_CTL, 0, CTL_ZERO_BYTES, stream) != hipSuccess) return;
    Args a{};
    for (int i = 0; i < 22; ++i) a.in[i] = (const float*)d_in[i];
    a.out = (float*)d_out; a.ws = (unsigned char*)d_ws;
#if MK_ONE_LAUNCH
    a.ph_lo = 0; a.ph_hi = NPHASE;
    hipLaunchKernelGGL(mk_fwd, dim3(grid), dim3(NTHR), LDS_BYTES, stream, a);
#else
    for (int p = 0; p < NPHASE; ++p) { a.ph_lo = p; a.ph_hi = p + 1; hipLaunchKernelGGL(mk_fwd, dim3(grid), dim3(NTHR), LDS_BYTES, stream, a); }
#endif
    const hipError_t le = hipPeekAtLastError();
    if (le != hipSuccess) fprintf(stderr, "kernel_launch: launch failed: %s\n", hipGetErrorName(le));
}
```

```cpp
#include <hip/hip_runtime.h>
#include <cstdio>
#include <cstdint>
#ifndef MK_ONE_LAUNCH
#define MK_ONE_LAUNCH 1
#endif
namespace pg8 {
#define PG8_LAS __attribute__((address_space(3)))
typedef unsigned short bf16_t;
typedef short bf16x8 __attribute__((ext_vector_type(8)));
typedef float f32x4 __attribute__((ext_vector_type(4)));
typedef unsigned u32x4 __attribute__((ext_vector_type(4)));
constexpr int BM = 256, BK = 64, HALF = 128, HTB = HALF * BK * 2  , STAGE_BYTES = 8 * HTB, NXCD = 8, WGM = 8;

__host__ __device__ __forceinline__ int lds_byte(int r, int c) { const int st = (r >> 4) * 2 + (c >> 5), rr = r & 15, cc = c & 31, ob = rr * 64 + cc * 2; return st * 1024 + (ob ^ (((ob >> 9) & 1) << 5)); }
__host__ __device__ __forceinline__ void stage_rc(int b, int& R, int& C) { const int st = b / 1024, sb = b % 1024, swz = sb ^ (((sb >> 9) & 1) << 5); R = (st >> 1) * 16 + swz / 64; C = (st & 1) * 32 + (swz % 64) / 2; }
__host__ __device__ __forceinline__ int perm32(int rho) { const int n = rho >> 4, i = rho & 15; return 8 * (i >> 2) + 4 * n + (i & 3); }

struct Unit { int pm, pn; };
struct Gemm { const bf16_t* A; const bf16_t* Bt; int M, N, K; };

struct StaticOrder {
    int nM, nN, nwg, G, c;
    __host__ __device__ void init(int M, int N, int G_, int c_) { nM = M / BM; nN = N / BM; nwg = nM * nN; G = G_; c = c_; }
    __host__ __device__ bool next(int i, Unit& u) const {
        const long L = (long)i * G + c; if (L >= nwg) return false;
        int wgid = (int)L; { const int q = nwg / NXCD, r = nwg % NXCD, xcd = wgid % NXCD, off = wgid / NXCD; wgid = (xcd < r ? xcd * (q + 1) : r * (q + 1) + (xcd - r) * q) + off; }
        const int nig = WGM * nN, gid = wgid / nig, fm = gid * WGM, gsz = (nM - fm) < WGM ? (nM - fm) : WGM;
        u.pm = fm + ((wgid % nig) % gsz); u.pn = (wgid % nig) / gsz; return true;
    }
    __device__ __forceinline__ void a_ready(const Unit&) const {}
    __device__ __forceinline__ void done(const Unit&) const {}
};

__device__ __forceinline__ unsigned cvt_pk_bf16(float lo, float hi) { unsigned r; asm volatile("v_cvt_pk_bf16_f32 %0, %1, %2" : "=v"(r) : "v"(lo), "v"(hi)); return r; }
typedef float f32x2 __attribute__((ext_vector_type(2)));
__device__ __forceinline__ f32x2 gelu_pk(f32x2 v) {
    const f32x2 av = __builtin_elementwise_abs(v), d = av * 0.2316418882f + 1.0f;
    f32x2 t; t.x = __builtin_amdgcn_rcpf(d.x); t.y = __builtin_amdgcn_rcpf(d.y);
    f32x2 q = t * 0.5307027145f + (-0.7265760135f); q = q * t + 0.7107068705f; q = q * t + (-0.142248368f); q = q * t + 0.127414796f; q = q * t;
    const f32x2 s = (v * v) * (-0.72134752044f);
    f32x2 e; e.x = __builtin_amdgcn_exp2f(s.x); e.y = __builtin_amdgcn_exp2f(s.y);
    const f32x2 m = v * (q * e), r = v - m;
    f32x2 o; o.x = v.x < 0.f ? m.x : r.x; o.y = v.y < 0.f ? m.y : r.y; return o;
}

template <int ACT  > struct EpiBf16 {
    static constexpr bool PERM = true, AFTER_DRAIN = false; static_assert(ACT == 0 || ACT == 1, "EpiBf16: ACT is 0 (none) or 1 (gelu_pk)");
    bf16_t* O; int ldc; const float* bias; int split_cols; size_t split_stride; float scale0;
    __device__ __forceinline__ void operator()(const f32x4 (&acc)[2][2][4][2], const Unit& u, int wr, int wc, int fr, int fq) const {
        const int row0 = u.pm * BM + wr * 64 + fr; int colt = u.pn * BM; bf16_t* base = O;
        float sc = 1.f; if (split_cols) { const int t = colt / split_cols; base += (size_t)t * split_stride; colt -= t * split_cols; if (t == 0) sc = scale0; }
        const int col0 = colt + wc * 32 + 8 * fq, bcol0 = u.pn * BM + wc * 32 + 8 * fq;
        f32x4 bv[2][2];
#pragma unroll
        for (int bj = 0; bj < 2; ++bj)
#pragma unroll
            for (int n = 0; n < 2; ++n) bv[bj][n] = bias ? *(const f32x4*)(bias + bcol0 + bj * HALF + 4 * n) : (f32x4){0.f, 0.f, 0.f, 0.f};
#pragma unroll
        for (int ai = 0; ai < 2; ++ai)
#pragma unroll
            for (int m = 0; m < 4; ++m) { bf16_t* rowp = base + (size_t)(row0 + ai * HALF + m * 16) * ldc + col0;
#pragma unroll
                for (int bj = 0; bj < 2; ++bj) { f32x4 v0 = acc[ai][bj][m][0] + bv[bj][0], v1 = acc[ai][bj][m][1] + bv[bj][1];
                    if (ACT == 1) { f32x2 a = gelu_pk((f32x2){v0[0], v0[1]}), b = gelu_pk((f32x2){v0[2], v0[3]}), c = gelu_pk((f32x2){v1[0], v1[1]}), d = gelu_pk((f32x2){v1[2], v1[3]});
                        v0 = (f32x4){a.x, a.y, b.x, b.y}; v1 = (f32x4){c.x, c.y, d.x, d.y}; }
                    v0 = v0 * sc; v1 = v1 * sc; u32x4 w; w.x = cvt_pk_bf16(v0[0], v0[1]); w.y = cvt_pk_bf16(v0[2], v0[3]); w.z = cvt_pk_bf16(v1[0], v1[1]); w.w = cvt_pk_bf16(v1[2], v1[3]);
                    *(u32x4*)(rowp + bj * HALF) = w; } }
    }
};
template <class Epi, class Sched, bool ALIGN_EPI = false, bool SP2 = false>
__device__ __forceinline__ void gemm_phase(PG8_LAS unsigned char* lds, const Gemm g, const Sched& S, const Epi& E) {
    int tid_l = threadIdx.x; asm volatile("" : "+v"(tid_l)); const int tid = tid_l, wid = __builtin_amdgcn_readfirstlane(tid >> 6), lane = tid & 63, wr = wid >> 2, wc = wid & 3, fr = lane & 15, fq = lane >> 4;
    const int K = g.K, nt = K / BK;
    unsigned voffA[2], voffB[2];
#pragma unroll
    for (int i = 0; i < 2; ++i) { int R, C; stage_rc(tid * 16 + i * 8192, R, C); const int Rb = Epi::PERM ? ((R & ~31) + perm32(R & 31)) : R;
        voffA[i] = (unsigned)(R * K + C) * 2u; voffB[i] = (unsigned)(Rb * K + C) * 2u; }
    const size_t kstep = (size_t)(BK * 2);
    const size_t hstep = (size_t)HALF * K * 2;
    const size_t tstep = 2 * hstep;
    const unsigned ldsw = (unsigned)wid * 1024u;
    const int aoff = lds_byte(wr * 64 + fr, fq * 8), boff = lds_byte(wc * 32 + fr, fq * 8);
#define PG8_SA(b, h) (((b) * 2 + (h)) * HTB)
#define PG8_SB(b, h) ((4 + (b) * 2 + (h)) * HTB)
#define PG8_STAGE(bufoff, gbase, voff) do { _Pragma("unroll") for (int _i = 0; _i < 2; ++_i) \
        __builtin_amdgcn_global_load_lds((const unsigned*)((const char*)(gbase) + (voff)[_i]), (PG8_LAS unsigned*)(lds + (bufoff) + ldsw + _i * 8192), 16, 0, 0); } while (0)
#define PG8_LDA(dst, b, h) do { _Pragma("unroll") for (int m = 0; m < 4; ++m) _Pragma("unroll") for (int k = 0; k < 2; ++k) dst[m][k] = *(const PG8_LAS bf16x8*)(lds + PG8_SA(b, h) + aoff + m * 2048 + k * 1024); } while (0)
#define PG8_LDB(dst, b, h) do { _Pragma("unroll") for (int n = 0; n < 2; ++n) _Pragma("unroll") for (int k = 0; k < 2; ++k) dst[n][k] = *(const PG8_LAS bf16x8*)(lds + PG8_SB(b, h) + boff + n * 2048 + k * 1024); } while (0)
#define PG8_MMA(ai, bj, At, Bt) do { __builtin_amdgcn_s_setprio(1); _Pragma("unroll") for (int m = 0; m < 4; ++m) _Pragma("unroll") for (int n = 0; n < 2; ++n) _Pragma("unroll") for (int k = 0; k < 2; ++k) \
        acc[ai][bj][m][n] = __builtin_amdgcn_mfma_f32_16x16x32_bf16(Bt[n][k], At[m][k], acc[ai][bj][m][n], 0, 0, 0); __builtin_amdgcn_s_setprio(0); } while (0)
#define PG8_WAIT_V(n) asm volatile("s_waitcnt vmcnt(" #n ")" ::: "memory")
#define PG8_WAIT_L(n) asm volatile("s_waitcnt lgkmcnt(" #n ")" ::: "memory")
#define PG8_BAR __builtin_amdgcn_s_barrier()
#define PG8_SCHED __builtin_amdgcn_sched_barrier(0)
    Unit cur, nxt; int ui = 0;
    if (!S.next(0, cur)) return;
    f32x4 acc[2][2][4][2];
#pragma unroll
    for (int a = 0; a < 2; ++a)
#pragma unroll
        for (int b = 0; b < 2; ++b)
#pragma unroll
            for (int m = 0; m < 4; ++m)
#pragma unroll
                for (int n = 0; n < 2; ++n) acc[a][b][m][n] = (f32x4){0.f, 0.f, 0.f, 0.f};
    bf16x8 At[4][2], B0[2][2], B1[2][2];
    const char* cA = (const char*)g.A + (size_t)cur.pm * tstep; const char* cB = (const char*)g.Bt + (size_t)cur.pn * tstep;
    S.a_ready(cur);
    if constexpr (SP2) {
        PG8_STAGE(PG8_SB(0, 0), cB, voffB); PG8_STAGE(PG8_SB(0, 1), cB + hstep, voffB); PG8_STAGE(PG8_SA(0, 0), cA, voffA); PG8_STAGE(PG8_SA(0, 1), cA + hstep, voffA);
        if (wr == 1) PG8_BAR;
        PG8_WAIT_V(2); PG8_BAR;
        PG8_STAGE(PG8_SB(1, 0), cB + kstep, voffB); PG8_STAGE(PG8_SA(1, 0), cA + kstep, voffA); PG8_STAGE(PG8_SB(1, 1), cB + hstep + kstep, voffB);
        PG8_WAIT_V(6); PG8_BAR;
    } else {
        PG8_STAGE(PG8_SB(0, 0), cB, voffB); PG8_STAGE(PG8_SA(0, 0), cA, voffA); PG8_STAGE(PG8_SB(0, 1), cB + hstep, voffB); PG8_STAGE(PG8_SA(0, 1), cA + hstep, voffA);
        if (wr == 1) PG8_BAR;
        PG8_WAIT_V(4); PG8_BAR;
        PG8_STAGE(PG8_SB(1, 0), cB + kstep, voffB); PG8_STAGE(PG8_SA(1, 0), cA + kstep, voffA); PG8_STAGE(PG8_SB(1, 1), cB + hstep + kstep, voffB);
        PG8_WAIT_V(6); PG8_BAR;
    }
    for (;;) {
        const bool has_next = S.next(ui + 1, nxt);
        const char* nA = has_next ? (const char*)g.A + (size_t)nxt.pm * tstep : cA; const char* nB = has_next ? (const char*)g.Bt + (size_t)nxt.pn * tstep : cB;
        for (int t = 0; t < nt; t += 2) {
            const bool last = (t == nt - 2);
            const char* a1 = cA + (size_t)(t + 1) * kstep;
            const char* a2 = last ? nA : cA + (size_t)(t + 2) * kstep; const char* b2 = last ? nB : cB + (size_t)(t + 2) * kstep;
            const char* a3 = a2 + kstep; const char* b3 = b2 + kstep;
            if (last && has_next) S.a_ready(nxt);
            if constexpr (SP2) {
            PG8_LDB(B0, 0, 0); PG8_LDB(B1, 0, 1); PG8_SCHED; PG8_LDA(At, 0, 0); PG8_STAGE(PG8_SA(1, 1), a1 + hstep, voffA);
            PG8_WAIT_V(8); PG8_WAIT_L(0); PG8_BAR; PG8_MMA(0, 0, At, B0); PG8_MMA(0, 1, At, B1); PG8_BAR; PG8_SCHED;
            PG8_LDA(At, 0, 1); PG8_STAGE(PG8_SB(0, 0), b2, voffB); PG8_STAGE(PG8_SB(0, 1), b2 + hstep, voffB); PG8_STAGE(PG8_SA(0, 0), a2, voffA);
            PG8_WAIT_V(8); PG8_WAIT_L(0); PG8_BAR; PG8_MMA(1, 0, At, B0); PG8_MMA(1, 1, At, B1); PG8_BAR; PG8_SCHED;
            PG8_LDB(B0, 1, 0); PG8_LDB(B1, 1, 1); PG8_SCHED; PG8_LDA(At, 1, 0); PG8_STAGE(PG8_SA(0, 1), a2 + hstep, voffA);
            PG8_WAIT_V(8); PG8_WAIT_L(0); PG8_BAR; PG8_MMA(0, 0, At, B0); PG8_MMA(0, 1, At, B1); PG8_BAR; PG8_SCHED;
            PG8_LDA(At, 1, 1); PG8_STAGE(PG8_SB(1, 0), b3, voffB); PG8_STAGE(PG8_SB(1, 1), b3 + hstep, voffB); PG8_STAGE(PG8_SA(1, 0), a3, voffA);
            PG8_WAIT_V(8); PG8_WAIT_L(0); PG8_BAR; PG8_MMA(1, 0, At, B0); PG8_MMA(1, 1, At, B1); PG8_BAR; PG8_SCHED;
            } else {
            PG8_LDB(B0, 0, 0); PG8_SCHED; PG8_LDA(At, 0, 0); PG8_STAGE(PG8_SA(1, 1), a1 + hstep, voffA);
            PG8_WAIT_L(8); PG8_BAR; PG8_WAIT_L(0); PG8_MMA(0, 0, At, B0); PG8_BAR; PG8_SCHED;
            PG8_LDB(B1, 0, 1); PG8_STAGE(PG8_SB(0, 0), b2, voffB);
            PG8_BAR; PG8_WAIT_L(0); PG8_MMA(0, 1, At, B1); PG8_BAR;
            PG8_LDA(At, 0, 1); PG8_STAGE(PG8_SA(0, 0), a2, voffA);
            PG8_BAR; PG8_WAIT_L(0); PG8_MMA(1, 0, At, B0); PG8_BAR; PG8_SCHED;
            PG8_STAGE(PG8_SB(0, 1), b2 + hstep, voffB);
            PG8_WAIT_V(6); PG8_BAR; PG8_MMA(1, 1, At, B1); PG8_BAR;
            PG8_LDB(B0, 1, 0); PG8_SCHED; PG8_LDA(At, 1, 0); PG8_STAGE(PG8_SA(0, 1), a2 + hstep, voffA);
            PG8_WAIT_L(8); PG8_BAR; PG8_WAIT_L(0); PG8_MMA(0, 0, At, B0); PG8_BAR; PG8_SCHED;
            PG8_LDB(B1, 1, 1); PG8_STAGE(PG8_SB(1, 0), b3, voffB);
            PG8_BAR; PG8_WAIT_L(0); PG8_MMA(0, 1, At, B1); PG8_BAR;
            PG8_LDA(At, 1, 1); PG8_STAGE(PG8_SA(1, 0), a3, voffA);
            PG8_BAR; PG8_WAIT_L(0); PG8_MMA(1, 0, At, B0); PG8_BAR; PG8_SCHED;
            PG8_STAGE(PG8_SB(1, 1), b3 + hstep, voffB);
            PG8_WAIT_V(6); PG8_BAR; PG8_MMA(1, 1, At, B1); PG8_BAR;
            }
        }
        if constexpr (ALIGN_EPI) { if (wr == 0) PG8_BAR; }
        if constexpr (!Epi::AFTER_DRAIN) { E(acc, cur, wr, wc, fr, fq); S.done(cur); }
        if (!has_next) break;
#pragma unroll
        for (int a = 0; a < 2; ++a)
#pragma unroll
            for (int b = 0; b < 2; ++b)
#pragma unroll
                for (int m = 0; m < 4; ++m)
#pragma unroll
                    for (int n = 0; n < 2; ++n) acc[a][b][m][n] = (f32x4){0.f, 0.f, 0.f, 0.f};
        cur = nxt; cA = nA; cB = nB; ++ui;
        if constexpr (ALIGN_EPI) { if (wr == 1) PG8_BAR; }
    }
    PG8_WAIT_V(0);
    if constexpr (!ALIGN_EPI) { if (wr == 0) PG8_BAR; }
    PG8_BAR;
    if constexpr (Epi::AFTER_DRAIN) { E.fused(acc, cur, wr, wc, fr, fq, lds, wid, lane); S.done(cur); }
#undef PG8_SA
#undef PG8_SB
#undef PG8_STAGE
#undef PG8_LDA
#undef PG8_LDB
#undef PG8_MMA
#undef PG8_WAIT_V
#undef PG8_WAIT_L
#undef PG8_BAR
#undef PG8_SCHED
}
}
constexpr int DM = 2048, NB = 4, SEQ = 4096, CTXL = 256, DEPTH = 4;
constexpr int TB = SEQ + CTXL;
constexpr int R = NB * TB;
constexpr int INC = 5120, DFF = 5632, UPC = 2 * DFF, NMODC = 6 * DM;
constexpr int C_AQ = 0, C_AK = 1024, C_AV = 1280, C_HQ = 1536, C_HFF = 2048, C_HFB = 2560, C_HI = 3072, C_HGT = 3584, C_SU = 4096, C_SV = 4608;
constexpr float EPS = 1e-6f;
constexpr int NWAVES = 8, NTHR = 512;
constexpr int NPHASE = 3 + 9 * DEPTH;

constexpr size_t MiB = 1u << 20;
constexpr size_t WS_CTL = 0, CTL_ZERO_BYTES = 4 * MiB;
constexpr size_t WS_MOD = 3 * MiB;
constexpr size_t WS_MISC = 1146 * MiB;
constexpr size_t WS_W = 4 * MiB, W_LAYER = 94 * MiB, W_IN = 0, W_OUT = 20 * MiB, W_UP = 28 * MiB, W_DN = 72 * MiB;
constexpr size_t WS_X = 380 * MiB;
constexpr size_t WS_H = 516 * MiB;
constexpr size_t WS_PROJ = 584 * MiB;
constexpr size_t WS_QN = 754 * MiB;
constexpr size_t WS_KN = 788 * MiB;
constexpr size_t WS_MIX = 797 * MiB;
constexpr size_t WS_HS = 865 * MiB;
constexpr size_t WS_HD = 897 * MiB;
constexpr size_t WS_HO = 898 * MiB;
constexpr size_t WS_UP = 584 * MiB;
constexpr size_t WS_ACT = 958 * MiB;
constexpr size_t WS_SWIN = 1 * MiB;
constexpr size_t WS_SWUP = WS_SWIN + 512 * 1024;
constexpr size_t WS_GS = 1145 * MiB;
constexpr size_t WS_END = 1147 * MiB;
constexpr size_t WS_RS = 65536;
static_assert(WS_RS + (size_t)2 * DEPTH * R * 4 <= WS_SWIN && WS_SWIN + (size_t)DEPTH * 5 * INC * 4 <= WS_SWUP && WS_SWUP + (size_t)DEPTH * 5 * UPC * 4 <= WS_MOD && WS_MOD + (size_t)DEPTH * 5 * NMODC * 4 <= CTL_ZERO_BYTES && WS_GS + (size_t)DEPTH * 2 * 5 * DM * 4 <= WS_MISC && WS_MISC + 65536 <= WS_END && WS_MOD + (size_t)DEPTH * 5 * NMODC * 4 <= WS_W, "ws map 4");
static_assert(WS_HO + (size_t)2 * R * 512 * 4 <= 966 * MiB && WS_UP + (size_t)R * UPC * 2 <= WS_ACT && WS_ACT + (size_t)R * DFF * 2 <= WS_GS, "ws map");
static_assert(WS_PROJ + (size_t)R * INC * 2 <= WS_QN && WS_QN + (size_t)R * 1024 * 2 <= WS_KN && WS_KN + (size_t)R * 256 * 2 <= WS_MIX && WS_MIX + (size_t)R * DM * 2 <= WS_HS, "ws map 2");
static_assert(WS_X + (size_t)R * DM * 4 <= WS_H && WS_H + (size_t)R * DM * 2 <= WS_PROJ && WS_W + DEPTH * W_LAYER <= WS_X, "ws map 3");
constexpr int CW_BAR = 4096;
constexpr int CW_Q0 = 64;

constexpr int RING_BYTES = 131072, LDSCTL_OFF = RING_BYTES, MISC_OFF = LDSCTL_OFF + 320, LDS_BYTES = 147456;

#define GAS __attribute__((address_space(1)))
#define LAS __attribute__((address_space(3)))
typedef unsigned short bf16;
typedef float v4f __attribute__((ext_vector_type(4)));
typedef unsigned v4u __attribute__((ext_vector_type(4)));
typedef unsigned v2u __attribute__((ext_vector_type(2)));
typedef float v2f __attribute__((ext_vector_type(2)));
typedef GAS unsigned gu32;
#define AS4 __attribute__((address_space(4)))
typedef const AS4 unsigned char* kptr_t;
#define LDS_WAIT() asm volatile("s_waitcnt lgkmcnt(0)" ::: "memory")
#define LDS_BAR() do { asm volatile("s_waitcnt lgkmcnt(0)" ::: "memory"); __builtin_amdgcn_s_barrier(); asm volatile("" ::: "memory"); } while (0)
__device__ __forceinline__ float bf2f(unsigned u) { return __uint_as_float(u << 16); }
__device__ __forceinline__ unsigned f2bf(float f) { unsigned u = __float_as_uint(f); return (u + 0x7fffu + ((u >> 16) & 1u)) >> 16; }
__device__ __forceinline__ unsigned pk2(float lo, float hi) { return f2bf(lo) | (f2bf(hi) << 16); }
typedef float cvt_f32x2 __attribute__((ext_vector_type(2))); typedef __bf16 cvt_bf16x2 __attribute__((ext_vector_type(2)));
__device__ __forceinline__ unsigned cvtpk_rne(float lo, float hi) { const cvt_f32x2 v = {lo, hi}; return __builtin_bit_cast(unsigned, __builtin_convertvector(v, cvt_bf16x2)); }
__device__ __forceinline__ float dpp_f(float v, const int ctrl_unused) { return v; }
#define DPP_ADD(v, ctrl) ((v) + __builtin_bit_cast(float, __builtin_amdgcn_update_dpp(0, __builtin_bit_cast(int, (v)), (ctrl), 0xf, 0xf, false)))
__device__ __forceinline__ float wave_sum(float v) {
    v = DPP_ADD(v, 0xB1);
    v = DPP_ADD(v, 0x4E);
    v = DPP_ADD(v, 0x141);
    v = DPP_ADD(v, 0x140);
    { auto rr = __builtin_amdgcn_permlane16_swap(__float_as_uint(v), __float_as_uint(v), false, false); v = __uint_as_float(rr[0]) + __uint_as_float(rr[1]); }
    { auto rr = __builtin_amdgcn_permlane32_swap(__float_as_uint(v), __float_as_uint(v), false, false); v = __uint_as_float(rr[0]) + __uint_as_float(rr[1]); }
    return v;
}
__device__ __forceinline__ float sigm(float z) { return __builtin_amdgcn_rcpf(1.f + __expf(-z)); }
__device__ __forceinline__ float silu_f(float z) { return z * sigm(z); }
__device__ __forceinline__ float gelu_tanh(float x) {
    const float u = 0.7978845608028654f * (x + 0.044715f * x * x * x);
    const float th = 1.f - 2.f * __builtin_amdgcn_rcpf(1.f + __expf(2.f * u));
    return 0.5f * x * (1.f + th);
}
__device__ __forceinline__ v4f mfma4(float a, float b, v4f c) { return __builtin_amdgcn_mfma_f32_16x16x4f32(a, b, c, 0, 0, 0); }

#define XB_TMO      128
#define XB_XCNT(j)  (256  + 64 * (j))
#define XB_XSUB(j)  (1280 + 64 * (j))
#define XB_XGEN(j)  (2304 + 64 * (j))
#define XB_TOP      3328
#define XB_TOPGEN   3392
#define XCD_BAR_WORDS 3456
#define XB_SPIN_CAP (1u << 18)
__device__ __forceinline__ unsigned xb_ld(unsigned* p)              { return __hip_atomic_load(p, __ATOMIC_RELAXED, __HIP_MEMORY_SCOPE_AGENT); }
__device__ __forceinline__ unsigned xb_add(unsigned* p, unsigned v) { return __hip_atomic_fetch_add(p, v, __ATOMIC_RELAXED, __HIP_MEMORY_SCOPE_AGENT); }
__device__ __forceinline__ unsigned xb_xcc_id() { return (unsigned)__builtin_amdgcn_s_getreg((3 << 11) | 20) & 0xFu; }
#define XB_SPIN(cond, bar) do { unsigned _sp = 0; while (cond) { __builtin_amdgcn_s_sleep(1); \
    if ((++_sp & 255u) == 0u) { if (xb_ld(&(bar)[XB_TMO])) break; if (_sp > XB_SPIN_CAP) { atomicAdd(&(bar)[XB_TMO], 1u); break; } } } } while (0)
struct XcdBarrier { unsigned* bar; unsigned x; volatile LAS unsigned* st; };
__device__ __forceinline__ XcdBarrier xcd_barrier_post(unsigned* bar, volatile LAS unsigned* st) {
    XcdBarrier b; b.bar = bar; b.x = xb_xcc_id(); b.st = st;
    if (threadIdx.x == 0) (void)xb_add(&bar[XB_XCNT(b.x)], 1u);
    return b;
}
__device__ __forceinline__ void xcd_barrier_complete(unsigned* bar, unsigned x, unsigned& nloc, unsigned& nx) {
    const unsigned G = gridDim.x * gridDim.y * gridDim.z;
    unsigned sum, cnt, mine, sp = 0u;
    for (;;) {
        sum = 0u; cnt = 0u; mine = 0u;
#pragma unroll
        for (unsigned j = 0; j < 16; ++j) { const unsigned c = xb_ld(&bar[XB_XCNT(j)]); sum += c; cnt += (c > 0u) ? 1u : 0u; mine = (j == x) ? c : mine; }
        if (sum == G) break;
        __builtin_amdgcn_s_sleep(1);
        if ((++sp & 255u) == 0u) { if (xb_ld(&bar[XB_TMO])) break; if (sp > XB_SPIN_CAP) { atomicAdd(&bar[XB_TMO], 1u); break; } }
    }
    nloc = mine > 0u ? mine : 1u; nx = cnt > 0u ? cnt : 1u;
}
__device__ __forceinline__ void xcd_barrier(const XcdBarrier& b) {
    asm volatile("s_waitcnt vmcnt(0)" ::: "memory");
    __syncthreads();
    if (threadIdx.x == 0) {
        unsigned* bar = b.bar;
        __builtin_amdgcn_s_waitcnt(0);
        unsigned nloc = b.st[0], nx = b.st[1];
        if (nloc == 0u) { xcd_barrier_complete(bar, b.x, nloc, nx); b.st[0] = nloc; b.st[1] = nx; }
        const unsigned old = xb_add(&bar[XB_XSUB(b.x)], 1u);
        const unsigned gen = old / nloc;
        if (old + 1u == (gen + 1u) * nloc) {
            __builtin_amdgcn_fence(__ATOMIC_RELEASE, "agent");
            asm volatile("s_waitcnt vmcnt(0)" ::: "memory");
            const unsigned og = xb_add(&bar[XB_TOP], 1u);
            const unsigned tg = og / nx;
            if (og + 1u == (tg + 1u) * nx) xb_add(&bar[XB_TOPGEN], 1u);
            else XB_SPIN(xb_ld(&bar[XB_TOPGEN]) == tg, bar);
            __builtin_amdgcn_fence(__ATOMIC_ACQUIRE, "agent");
            xb_add(&bar[XB_XGEN(b.x)], 1u);
            asm volatile("s_waitcnt vmcnt(0)" ::: "memory");
        } else {
            XB_SPIN(xb_ld(&bar[XB_XGEN(b.x)]) == gen, bar);
            __builtin_amdgcn_fence(__ATOMIC_ACQUIRE, "agent");
            asm volatile("s_waitcnt vmcnt(0)" ::: "memory");
        }
    }
    __syncthreads();
}

struct TileOrder : pg8::StaticOrder {
    bool skip;
    __device__ void init2(int N, int G_, int c_, bool skip_) { skip = skip_; init(skip_ ? NB * SEQ : R, N, G_, c_); }
    __device__ bool next(int i, pg8::Unit& u) const { if (!pg8::StaticOrder::next(i, u)) return false; if (skip) u.pm += u.pm >> 4; return true; }
};
__device__ __forceinline__ unsigned cvt_pk2(float lo, float hi) { return cvtpk_rne(lo, hi); }
template <bool MAKE_H>
struct EpiResGate {
    static constexpr bool PERM = true, AFTER_DRAIN = false;
    float* X; const float* mod_l; int jg; bf16* H; const float* gs; float* rs;
    const float* xin; const float* cin;
    __device__ __forceinline__ void operator()(const pg8::f32x4 (&acc)[2][2][4][2], const pg8::Unit& u, int wr, int wc, int fr, int fq) const {
        const int b = u.pm / 17, jt = u.pm - b * 17, mrow = (jt == 16 ? 4 : b);
        const float* gp = mod_l + (size_t)mrow * NMODC + (size_t)jg * DM;
        const float* gsp = gs + (size_t)mrow * DM;
        const int col0 = u.pn * 256 + wc * 32 + 8 * fq;
        pg8::f32x4 gv[2][2];
#pragma unroll
        for (int bj = 0; bj < 2; ++bj)
#pragma unroll
            for (int n = 0; n < 2; ++n) gv[bj][n] = *(const pg8::f32x4*)(gp + col0 + bj * 128 + 4 * n);
#pragma unroll
        for (int ai = 0; ai < 2; ++ai)
#pragma unroll
            for (int m = 0; m < 4; ++m) { const int row = u.pm * 256 + ai * 128 + wr * 64 + m * 16 + fr; const size_t off = (size_t)row * DM + col0; float ss = 0.f;
                const float* src = xin ? (jt == 16 ? cin + ((size_t)b * CTXL + (row - u.pm * 256)) * DM : xin + ((size_t)b * SEQ + jt * 256 + (row - u.pm * 256)) * DM) + col0 : X + off;
#pragma unroll
                for (int bj = 0; bj < 2; ++bj) { pg8::f32x4 xn[2];
#pragma unroll
                    for (int n = 0; n < 2; ++n) { xn[n] = *(const pg8::f32x4*)(src + bj * 128 + 4 * n) + gv[bj][n] * acc[ai][bj][m][n]; *(pg8::f32x4*)(X + off + bj * 128 + 4 * n) = xn[n]; }
                    if (MAKE_H) {
#pragma unroll
                        for (int n = 0; n < 2; ++n) ss += (xn[n][0] * xn[n][0] + xn[n][1] * xn[n][1]) + (xn[n][2] * xn[n][2] + xn[n][3] * xn[n][3]);
                        const pg8::f32x4 h0 = xn[0] * *(const pg8::f32x4*)(gsp + col0 + bj * 128), h1 = xn[1] * *(const pg8::f32x4*)(gsp + col0 + bj * 128 + 4);
                        v4u w; w.x = cvt_pk2(h0[0], h0[1]); w.y = cvt_pk2(h0[2], h0[3]); w.z = cvt_pk2(h1[0], h1[1]); w.w = cvt_pk2(h1[2], h1[3]);
                        *(v4u*)(H + off + bj * 128) = w; } }
                if (MAKE_H) { ss += __shfl_xor(ss, 16); ss += __shfl_xor(ss, 32); if (fq == 0) unsafeAtomicAdd(rs + row, ss); }
                if (m & 1) asm volatile("" ::: "memory"); }
    }
};
struct EpiBf16N {
    static constexpr bool PERM = true, AFTER_DRAIN = false;
    bf16* O; int ldc; const float* rs; const float* sw;
    __device__ __forceinline__ void operator()(const pg8::f32x4 (&acc)[2][2][4][2], const pg8::Unit& u, int wr, int wc, int fr, int fq) const {
        const int b = u.pm / 17, jt = u.pm - b * 17, mrow = (jt == 16 ? 4 : b);
        const int row0 = u.pm * 256 + wr * 64 + fr, col0 = u.pn * 256 + wc * 32 + 8 * fq;
        const float* swp = sw + (size_t)mrow * ldc + col0;
        pg8::f32x4 bv[2][2];
#pragma unroll
        for (int bj = 0; bj < 2; ++bj)
#pragma unroll
            for (int n = 0; n < 2; ++n) bv[bj][n] = *(const pg8::f32x4*)(swp + bj * 128 + 4 * n);
#pragma unroll
        for (int ai = 0; ai < 2; ++ai)
#pragma unroll
            for (int m = 0; m < 4; ++m) { const int row = row0 + ai * 128 + m * 16; const float rstd = 1.0f / sqrtf(rs[row] * (1.f / DM) + EPS);
                bf16* rowp = O + (size_t)row * ldc + col0;
#pragma unroll
                for (int bj = 0; bj < 2; ++bj) { const pg8::f32x4 v0 = acc[ai][bj][m][0] * rstd + bv[bj][0], v1 = acc[ai][bj][m][1] * rstd + bv[bj][1];
                    pg8::u32x4 w; w.x = cvt_pk2(v0[0], v0[1]); w.y = cvt_pk2(v0[2], v0[3]); w.z = cvt_pk2(v1[0], v1[1]); w.w = cvt_pk2(v1[2], v1[3]);
                    *(pg8::u32x4*)(rowp + bj * 128) = w; } }
    }
};

namespace att {
using bf16x8 = __attribute__((ext_vector_type(8))) short;
using s16x4  = __attribute__((ext_vector_type(4))) short;
using f32x16 = __attribute__((ext_vector_type(16))) float;
using u32x4  = __attribute__((ext_vector_type(4))) unsigned;
constexpr int   D = 128, NW = 8, QBLK = 32, KVBLK = 64;
constexpr float SCALE = 0.088388347648318440f;
constexpr float THR = 8.f;
constexpr int LDQ = 1024, LDK = 256, LDV = INC, LDO = DM;
constexpr size_t SHM_V = KVBLK * D * 2, SHM_K = KVBLK * D * 2, SHM_ATTN = 2 * SHM_V + 2 * SHM_K + NW * 64 * 4;
#define KSWZ(row, colB) ((row) * 256 + ((colB) ^ (((row) & 7) << 4)))
#define SBAR() __builtin_amdgcn_sched_barrier(0)
__device__ __forceinline__ int crow(int r, int hi) { return (r & 3) + 8 * (r >> 2) + 4 * hi; }
__device__ __forceinline__ unsigned cvtpk(float lo, float hi) { unsigned r; asm volatile("v_cvt_pk_bf16_f32 %0, %1, %2" : "=v"(r) : "v"(lo), "v"(hi)); return r; }
__device__ __forceinline__ void partialSM(f32x16& p0, f32x16& p1, float& m_reg, float& mn, float& alpha) {
  constexpr float C = SCALE * 1.4426950408889634f;
  float pmax = p0[0]; for (int r = 1; r < 16; ++r) pmax = fmaxf(pmax, p0[r]); for (int r = 0; r < 16; ++r) pmax = fmaxf(pmax, p1[r]);
  { auto rr = __builtin_amdgcn_permlane32_swap(__float_as_uint(pmax), __float_as_uint(pmax), false, false);
    pmax = fmaxf(__uint_as_float(rr[0]), __uint_as_float(rr[1])); }
  if (__builtin_expect(__all(pmax - m_reg <= THR / SCALE), 1)) { mn = m_reg; alpha = 1.f; }
  else { mn = fmaxf(m_reg, pmax); alpha = __builtin_amdgcn_exp2f((m_reg - mn) * C); m_reg = mn; }
  float mnC = -mn * C;
  for (int r = 0; r < 16; ++r) p0[r] = fmaf(p0[r], C, mnC); for (int r = 0; r < 16; ++r) p1[r] = fmaf(p1[r], C, mnC);
  for (int r = 0; r < 16; ++r) p0[r] = __builtin_amdgcn_exp2f(p0[r]);
}
__device__ __forceinline__ void finishSM(f32x16& p0, f32x16& p1, float alpha, float& l_reg, bf16x8& pa0, bf16x8& pa1, bf16x8& pa2, bf16x8& pa3) {
  for (int r = 0; r < 16; ++r) p1[r] = __builtin_amdgcn_exp2f(p1[r]);
  float ps = 0; for (int r = 0; r < 16; ++r) ps += p0[r]; for (int r = 0; r < 16; ++r) ps += p1[r];
  { auto rr = __builtin_amdgcn_permlane32_swap(__float_as_uint(ps), __float_as_uint(ps), false, false);
    ps = __uint_as_float(rr[0]) + __uint_as_float(rr[1]); }
  l_reg = l_reg * alpha + ps;
#define PK4(P, BASE, OUT) do { unsigned a0 = cvtpk(P[BASE + 0], P[BASE + 1]), a1 = cvtpk(P[BASE + 2], P[BASE + 3]);   \
    unsigned b0 = cvtpk(P[BASE + 4], P[BASE + 5]), b1 = cvtpk(P[BASE + 6], P[BASE + 7]);                              \
    auto r0 = __builtin_amdgcn_permlane32_swap(a0, b0, false, false); auto r1 = __builtin_amdgcn_permlane32_swap(a1, b1, false, false); \
    u32x4 w = {r0[0], r1[0], r0[1], r1[1]}; OUT = *reinterpret_cast<bf16x8*>(&w); } while (0)
  PK4(p0, 0, pa0); PK4(p0, 8, pa1); PK4(p1, 0, pa2); PK4(p1, 8, pa3);
#undef PK4
}
__device__ __forceinline__ void qkt(f32x16& p0, f32x16& p1, const bf16* Ks, const bf16x8* qr, int r32, int hi) {
  p0 = f32x16{}; p1 = f32x16{};
  for (int d0 = 0; d0 < 8; ++d0) { int cb = (d0 * 16 + hi * 8) * 2;
    bf16x8 b0 = *reinterpret_cast<const bf16x8*>((const char*)Ks + KSWZ(r32, cb));
    bf16x8 b1 = *reinterpret_cast<const bf16x8*>((const char*)Ks + KSWZ(32 + r32, cb));
    p0 = __builtin_amdgcn_mfma_f32_32x32x16_bf16(b0, qr[d0], p0, 0, 0, 0);
    p1 = __builtin_amdgcn_mfma_f32_32x32x16_bf16(b1, qr[d0], p1, 0, 0, 0); }
}
__device__ __forceinline__ int v_st(int k, int c) { const int kk = (k & ~0xC) | ((k & 4) << 1) | ((k & 8) >> 1); return ((kk >> 3) * 4 + (c >> 5)) * 512 + ((kk & 7) * 32 + (c & 31)) * 2; }
__device__ __forceinline__ int v_rd_base(int lane) { return ((lane & 3) << 3) | (((lane >> 2) & 3) << 6) | (((lane >> 4) & 1) << 5) | (((lane >> 5) & 1) << 8); }
constexpr int v_rd_off(int d0, int ks, int half) { return d0 * 512 + ks * 4096 + half * 2048; }
template <int OFF> __device__ __forceinline__ s16x4 tr_read(int vb) {
  s16x4 r; asm volatile("ds_read_b64_tr_b16 %0, %1 offset:%2" : "=&v"(r) : "v"(vb), "i"(OFF) : "memory"); return r;
}
template <int D0> __device__ __forceinline__ void pv_one(f32x16& od, int vb, bf16x8 pa0, bf16x8 pa1, bf16x8 pa2, bf16x8 pa3) {
  const s16x4 l0 = tr_read<v_rd_off(D0, 0, 0)>(vb), h0 = tr_read<v_rd_off(D0, 0, 1)>(vb), l1 = tr_read<v_rd_off(D0, 1, 0)>(vb), h1 = tr_read<v_rd_off(D0, 1, 1)>(vb);
  const s16x4 l2 = tr_read<v_rd_off(D0, 2, 0)>(vb), h2 = tr_read<v_rd_off(D0, 2, 1)>(vb), l3 = tr_read<v_rd_off(D0, 3, 0)>(vb), h3 = tr_read<v_rd_off(D0, 3, 1)>(vb);
  asm volatile("s_waitcnt lgkmcnt(0)" ::: "memory"); SBAR();
#define PK(L, H) (bf16x8){L[0], L[1], L[2], L[3], H[0], H[1], H[2], H[3]}
  od = __builtin_amdgcn_mfma_f32_32x32x16_bf16(pa0, PK(l0, h0), od, 0, 0, 0);
  od = __builtin_amdgcn_mfma_f32_32x32x16_bf16(pa1, PK(l1, h1), od, 0, 0, 0);
  od = __builtin_amdgcn_mfma_f32_32x32x16_bf16(pa2, PK(l2, h2), od, 0, 0, 0);
  od = __builtin_amdgcn_mfma_f32_32x32x16_bf16(pa3, PK(l3, h3), od, 0, 0, 0);
#undef PK
}
__device__ __forceinline__ void pv_d0(f32x16* o, int vb, bf16x8 pa0, bf16x8 pa1, bf16x8 pa2, bf16x8 pa3) {
  pv_one<0>(o[0], vb, pa0, pa1, pa2, pa3); pv_one<1>(o[1], vb, pa0, pa1, pa2, pa3); pv_one<2>(o[2], vb, pa0, pa1, pa2, pa3); pv_one<3>(o[3], vb, pa0, pa1, pa2, pa3);
}
__device__ __forceinline__ void attn_dense_body(const bf16* __restrict__ Qb, const bf16* __restrict__ Kh, const bf16* __restrict__ Vh,
                                                bf16* __restrict__ Ob, int seq, char* lds) {
  int tid_l = threadIdx.x; asm volatile("" : "+v"(tid_l)); const int tid = tid_l, wid = tid >> 6, lane = tid & 63, r32 = lane & 31, hi = lane >> 5;
  bf16* V_lds = (bf16*)lds; bf16* K_lds = (bf16*)(lds + 2 * SHM_V);
  float* ws = (float*)(lds + 2 * SHM_V + 2 * SHM_K) + wid * 64; float* li_l = ws; float* al_l = ws + 32;
  float m_reg = -1e30f, l_reg = 0; f32x16 o[4] = {}; bf16x8 qr[8];
  const bf16* Qw = Qb + (long)(wid * QBLK + r32) * LDQ + hi * 8;
#pragma unroll
  for (int d0 = 0; d0 < 8; ++d0) qr[d0] = *reinterpret_cast<const bf16x8*>(Qw + d0 * 16);
  const int sr = tid >> 4, sc = (tid & 15) * 8, vst0 = v_st(sr, sc), vst1 = v_st(32 + sr, sc);
  const int vb0 = (int)(uintptr_t)V_lds + v_rd_base(lane);
  struct { bf16x8 vs0, vs1, ks0, ks1; } sr_[2];
#define SLOAD(i, k0) do { sr_[i].vs0 = *reinterpret_cast<const bf16x8*>(&Vh[(long)((k0) + sr) * LDV + sc]); sr_[i].vs1 = *reinterpret_cast<const bf16x8*>(&Vh[(long)((k0) + 32 + sr) * LDV + sc]); \
    sr_[i].ks0 = *reinterpret_cast<const bf16x8*>(&Kh[(long)((k0) + sr) * LDK + sc]); sr_[i].ks1 = *reinterpret_cast<const bf16x8*>(&Kh[(long)((k0) + 32 + sr) * LDK + sc]); } while (0)
#define SWRITE(b, i) do { *(bf16x8*)((char*)V_lds + (b) * SHM_V + vst0) = sr_[i].vs0;          \
    *(bf16x8*)((char*)V_lds + (b) * SHM_V + vst1) = sr_[i].vs1; int kc = sc * 2;               \
    *(bf16x8*)((char*)K_lds + (b) * SHM_K + KSWZ(sr, kc)) = sr_[i].ks0;                       \
    *(bf16x8*)((char*)K_lds + (b) * SHM_K + KSWZ(32 + sr, kc)) = sr_[i].ks1; } while (0)
#define SWAIT() asm volatile("s_waitcnt vmcnt(4)" ::: "memory")
#define RESC(a) do { if (__any((a) < 1.f)) { if (hi == 0) al_l[r32] = (a); asm volatile("s_waitcnt lgkmcnt(0)" ::: "memory"); \
    for (int d = 0; d < 4; ++d) for (int r = 0; r < 16; ++r) o[d][r] *= al_l[crow(r, hi)]; } } while (0)
  f32x16 pA0, pA1, pB0, pB1; float mnA, mnB, alA, alB; bf16x8 pa0, pa1, pa2, pa3; const int NT = seq / KVBLK;
  constexpr int SE = 0, SO = 1;
  SLOAD(SE, 0); asm volatile("s_waitcnt vmcnt(0)" ::: "memory"); SWRITE(0, SE); __syncthreads();
  qkt(pA0, pA1, K_lds, qr, r32, hi); partialSM(pA0, pA1, m_reg, mnA, alA);
  SLOAD(SO, KVBLK); if (2 < NT) SLOAD(SE, 2 * KVBLK);
  SWAIT(); SWRITE(1, SO); __syncthreads();
  for (int j = 1; j + 1 < NT; j += 2) {
    SBAR(); qkt(pB0, pB1, (bf16*)((char*)K_lds + SHM_K), qr, r32, hi);
    finishSM(pA0, pA1, alA, l_reg, pa0, pa1, pa2, pa3); SBAR();
    SLOAD(SO, (j + 2) * KVBLK); SBAR();
    pv_d0(o, vb0, pa0, pa1, pa2, pa3); partialSM(pB0, pB1, m_reg, mnB, alB);
    __syncthreads(); SWAIT(); SWRITE(0, SE);
    RESC(alB); __syncthreads();
    SBAR(); qkt(pA0, pA1, K_lds, qr, r32, hi);
    finishSM(pB0, pB1, alB, l_reg, pa0, pa1, pa2, pa3); SBAR();
    if (j + 3 < NT) SLOAD(SE, (j + 3) * KVBLK); SBAR();
    pv_d0(o, vb0 + (int)SHM_V, pa0, pa1, pa2, pa3); partialSM(pA0, pA1, m_reg, mnA, alA);
    __syncthreads(); SWAIT(); SWRITE(1, SO);
    RESC(alA); __syncthreads();
  }
  SBAR(); qkt(pB0, pB1, (bf16*)((char*)K_lds + SHM_K), qr, r32, hi);
  finishSM(pA0, pA1, alA, l_reg, pa0, pa1, pa2, pa3); SBAR();
  pv_d0(o, vb0, pa0, pa1, pa2, pa3); partialSM(pB0, pB1, m_reg, mnB, alB);
  __syncthreads(); RESC(alB);
  finishSM(pB0, pB1, alB, l_reg, pa0, pa1, pa2, pa3); SBAR();
  pv_d0(o, vb0 + (int)SHM_V, pa0, pa1, pa2, pa3);
  if (hi == 0) li_l[r32] = l_reg; asm volatile("s_waitcnt lgkmcnt(0)" ::: "memory");
  float rli[16];
#pragma unroll
  for (int r = 0; r < 16; ++r) rli[r] = __builtin_amdgcn_rcpf(li_l[crow(r, hi)]);
  bf16* Ow = Ob + (long)(wid * QBLK) * LDO;
#pragma unroll
  for (int r = 0; r < 16; ++r) { int orow = crow(r, hi);
    for (int d0 = 0; d0 < 4; ++d0) Ow[(long)orow * LDO + d0 * 32 + r32] = (bf16)f2bf(o[d0][r] * rli[r]); }
  __syncthreads();
#undef SLOAD
#undef SWRITE
#undef SWAIT
#undef RESC
}
}

struct Args { const float* in[22]; float* out; unsigned char* ws; int ph_lo, ph_hi; };
enum { I_X = 0, I_C, I_CTX, I_CCTX, I_WADA, I_BADA, I_N1G, I_WIN, I_QG, I_KG, I_LBP, I_HGG, I_SGG, I_SGW, I_SGB, I_WOUT, I_N2G, I_WUP, I_CW, I_CB, I_WDN, I_FNG };

__device__ __forceinline__ void p0_mod(const float* cin, const float* ccin, const float* wada, const float* bada, LAS unsigned char* lds, float* MOD, int tid, int lane, int wave, int bx, int G) {
    LAS float* sc = (LAS float*)lds;
    LAS float* red0 = (LAS float*)(lds + 40960);
    for (int i = tid; i < 5 * DM; i += NTHR) { const int r = i >> 11, k = i & 2047; const float v = r < 4 ? cin[r * DM + k] : ccin[k]; sc[i] = silu_f(v); }
    LDS_BAR();
    int par = 0;
    for (int it = bx; it < 768; it += G, par ^= 1) {
        const int cb = it >> 2, kq = it & 3, l = cb / 48, n0 = (cb % 48) * 256, kbase = 512 * kq + 64 * wave;
        const float* wp = wada + ((size_t)l * DM + kbase) * NMODC + n0 + 4 * lane;
        LAS float* red = red0 + par * (8 * 5 * 256);
        v4f acc[5];
#pragma unroll
        for (int r = 0; r < 5; ++r) acc[r] = (v4f){0.f, 0.f, 0.f, 0.f};
#pragma unroll 16
        for (int k = 0; k < 64; ++k) {
            const v4f w = *(const v4f*)(wp + (size_t)k * NMODC);
#pragma unroll
            for (int r = 0; r < 5; ++r) { const float s = sc[r * DM + kbase + k]; acc[r] += w * s; }
        }
#pragma unroll
        for (int r = 0; r < 5; ++r) *(LAS v4f*)(red + (wave * 5 + r) * 256 + 4 * lane) = acc[r];
        LDS_BAR();
        for (int o = tid; o < 1280; o += NTHR) { const int r = o >> 8, ci = o & 255; float s = (kq == 0) ? bada[l * NMODC + n0 + ci] : 0.f;
#pragma unroll
            for (int w = 0; w < 8; ++w) s += red[(w * 5 + r) * 256 + ci];
            unsafeAtomicAdd(MOD + (size_t)(l * 5 + r) * NMODC + n0 + ci, s); }
    }
    LDS_BAR();
}
template <bool SWACC>
__device__ __forceinline__ void p0_transpose_item(const float* W, int K, int N, bf16* WT, LAS float* scr, int item, int lane, float* sw, const float* sh) {
    const int nblk = N / 32, kb = item / nblk, nb = item % nblk, k0 = 64 * kb, n0 = 32 * nb;
    {   v4f t[8];
#pragma unroll
        for (int i = 0; i < 8; ++i) t[i] = *(const v4f*)(W + (size_t)(k0 + 8 * i + (lane >> 3)) * N + n0 + 4 * (lane & 7));
#pragma unroll
        for (int i = 0; i < 8; ++i) { LAS float* d = scr + (8 * i + (lane >> 3)) * 33 + 4 * (lane & 7); d[0] = t[i].x; d[1] = t[i].y; d[2] = t[i].z; d[3] = t[i].w; } }
    LDS_WAIT(); asm volatile("" ::: "memory");
    const int c = lane & 7;
#pragma unroll
    for (int j = 0; j < 4; ++j) { const int n = (lane >> 3) + 8 * j; const LAS float* s = scr + (8 * c) * 33 + n;
        v4u o; o.x = pk2(s[0 * 33], s[1 * 33]); o.y = pk2(s[2 * 33], s[3 * 33]); o.z = pk2(s[4 * 33], s[5 * 33]); o.w = pk2(s[6 * 33], s[7 * 33]);
        *(GAS v4u*)(WT + (size_t)(n0 + n) * K + k0 + 8 * c) = o; }
    if (SWACC) {
        const int n = lane & 31, kh = lane >> 5; float s5[5] = {0.f, 0.f, 0.f, 0.f, 0.f};
        const float* shp = sh + k0 + 32 * kh; const LAS float* tp = scr + (32 * kh) * 33 + n;
#pragma unroll
        for (int q = 0; q < 8; ++q) { const float w0 = tp[(4 * q) * 33], w1 = tp[(4 * q + 1) * 33], w2 = tp[(4 * q + 2) * 33], w3 = tp[(4 * q + 3) * 33];
#pragma unroll
            for (int r = 0; r < 5; ++r) { const v4f s = *(const v4f*)(shp + (size_t)r * NMODC + 4 * q); s5[r] += (s.x * w0 + s.y * w1) + (s.z * w2 + s.w * w3); } }
#pragma unroll
        for (int r = 0; r < 5; ++r) { s5[r] += __shfl_xor(s5[r], 32); if (lane < 32) unsafeAtomicAdd(sw + (size_t)r * N + n0 + n, s5[r]); }
    }
    LDS_WAIT(); asm volatile("" ::: "memory");
}
constexpr int CI_IN = (DM / 64) * (INC / 32), CI_OUT = (DM / 64) * (DM / 32), CI_UP = (DM / 64) * (UPC / 32), CI_DN = (DFF / 64) * (DM / 32);
template <int SEL>
__device__ __forceinline__ void convert_item(int l, int r, kptr_t kp, unsigned char* ws, LAS float* scr, int lane);
template <int SEL> constexpr int convert_count() { return ((SEL & 1) ? CI_IN : 0) + ((SEL & 2) ? CI_OUT : 0) + ((SEL & 4) ? CI_UP : 0) + ((SEL & 8) ? CI_DN : 0); }
__device__ __forceinline__ void norm_phase(const float* X, bf16* H, const float* g, const float* mod_l, int jshift, int jscale, bool skip_ctx, int gw, int NGW, int lane) {
    for (int m = gw; m < R; m += NGW) {
        const int b = m / TB, t = m - b * TB; const bool isc = t >= SEQ; if (isc && skip_ctx) continue;
        const float* mrow = mod_l + (size_t)(isc ? 4 : b) * NMODC;
        const v4f* xr = (const v4f*)(X + (size_t)m * DM) + lane;
        v4f v[8]; float ss = 0.f;
#pragma unroll
        for (int j = 0; j < 8; ++j) { v[j] = xr[64 * j]; ss += (v[j].x * v[j].x + v[j].y * v[j].y) + (v[j].z * v[j].z + v[j].w * v[j].w); }
        const float rstd = 1.0f / sqrtf(wave_sum(ss) * (1.f / DM) + EPS);
#pragma unroll
        for (int j = 0; j < 8; ++j) { const int c = 4 * lane + 256 * j;
            const v4f gg = *(const v4f*)(g + c), sh = *(const v4f*)(mrow + jshift * DM + c), sc = *(const v4f*)(mrow + jscale * DM + c);
            const v4f y = v[j] * rstd * gg * (1.f + sc) + sh;
            v2u w; w.x = pk2(y.x, y.y); w.y = pk2(y.z, y.w);
            *(v2u*)(H + (size_t)m * DM + c) = w; }
    }
}
__device__ __forceinline__ void qknorm_phase(const bf16* PROJ, bf16* QN, bf16* KN, const float* qg, const float* kg, const float* rcos, const float* rsin, int gw, int NGW, int lane) {
    const float qg0 = qg[2 * lane], qg1 = qg[2 * lane + 1], kg0 = kg[2 * lane], kg1 = kg[2 * lane + 1];
#pragma unroll 1
    for (int m0 = 4 * gw; m0 < R; m0 += 4 * NGW) {
        unsigned w2[4][10];
#pragma unroll
        for (int rr = 0; rr < 4; ++rr)
#pragma unroll
            for (int hh = 0; hh < 10; ++hh) w2[rr][hh] = *(const unsigned*)(PROJ + (size_t)(m0 + rr) * INC + hh * 128 + 2 * lane);
#pragma unroll
        for (int rr = 0; rr < 4; ++rr) {
            const int m = m0 + rr, b = m / TB, t = m - b * TB; const bool lat = t < SEQ;
            float cs = 1.f, sn = 0.f;
            if (lat) { const int pos = (lane < 32) ? (t >> 6) : (t & 63); cs = rcos[pos * 32 + (lane & 31)]; sn = rsin[pos * 32 + (lane & 31)]; }
#pragma unroll
            for (int hh = 0; hh < 10; ++hh) {
                const float x1 = bf2f(w2[rr][hh] & 0xffffu), x2 = bf2f(w2[rr][hh] >> 16);
                const float rstd = __builtin_amdgcn_rsqf(wave_sum(x1 * x1 + x2 * x2) * (1.f / 128.f) + EPS);
                const float y1 = x1 * rstd * (hh < 8 ? qg0 : kg0), y2 = x2 * rstd * (hh < 8 ? qg1 : kg1);
                const float o1 = y1 * cs - y2 * sn, o2 = y1 * sn + y2 * cs;
                bf16* dst = hh < 8 ? QN + (size_t)m * 1024 + hh * 128 + 2 * lane : KN + (size_t)m * 256 + (hh - 8) * 128 + 2 * lane;
                *(unsigned*)dst = cvtpk_rne(o1, o2);
            }
        }
    }
}
typedef short hbf16x8 __attribute__((ext_vector_type(8)));
__device__ __forceinline__ v4f mfma_bf(v4u a, v4u b, v4f c) { return __builtin_amdgcn_mfma_f32_16x16x32_bf16(__builtin_bit_cast(hbf16x8, a), __builtin_bit_cast(hbf16x8, b), c, 0, 0, 0); }
__device__ __forceinline__ unsigned cvtpk_hw(float lo, float hi) { return cvtpk_rne(lo, hi); }
constexpr int SG_PB = 272;
__device__ __forceinline__ void sg_unit(int b, int n, int g, int l, const bf16* PROJ, bf16* MIX, const float* sgg, const float* sgw, const float* sgb, LAS unsigned char* Vt, int tid, int lane, int wave) {
    const int row0 = b * TB + n * 128, c4 = lane >> 4, l15 = lane & 15;
    v4u wf[4];
    {   const float* W = sgw + ((size_t)(l * 4 + g) * 128 + 16 * wave + l15) * 128 + 8 * c4;
#pragma unroll
        for (int ks = 0; ks < 4; ++ks) { const v4f a0 = *(const v4f*)(W + 32 * ks), a1 = *(const v4f*)(W + 32 * ks + 4);
            wf[ks].x = cvtpk_hw(a0.x, a0.y); wf[ks].y = cvtpk_hw(a0.z, a0.w); wf[ks].z = cvtpk_hw(a1.x, a1.y); wf[ks].w = cvtpk_hw(a1.z, a1.w); } }
    const size_t orow = (size_t)(row0 + 16 * wave + l15);
    v2u uraw[8];
#pragma unroll
    for (int dt = 0; dt < 8; ++dt) uraw[dt] = *(const v2u*)(PROJ + orow * INC + C_SU + g * 128 + 16 * dt + 4 * c4);
    const float bsv = sgb[(l * 4 + g) * 128 + 16 * wave + l15];
    {
        const int s = tid >> 2, q = tid & 3;
        const v4u* src = (const v4u*)(PROJ + (size_t)(row0 + s) * INC + C_SV + g * 128 + 32 * q);
        float ge[32]; float ss = 0.f;
#pragma unroll
        for (int i = 0; i < 4; ++i) { const v4u w = src[i];
#pragma unroll
            for (int e = 0; e < 4; ++e) { const float a0 = gelu_tanh(bf2f(w[e] & 0xffffu)), a1 = gelu_tanh(bf2f(w[e] >> 16)); ge[8 * i + 2 * e] = a0; ge[8 * i + 2 * e + 1] = a1; ss += a0 * a0 + a1 * a1; } }
        ss += __shfl_xor(ss, 1); ss += __shfl_xor(ss, 2);
        const float rstd = 1.0f / sqrtf(ss * (1.f / 128.f) + EPS);
        const float* gp = sgg + g * 128 + 32 * q;
#pragma unroll
        for (int i = 0; i < 32; ++i) *(LAS bf16*)(Vt + (32 * q + i) * SG_PB + 2 * s) = (bf16)(cvtpk_hw(ge[i] * rstd * gp[i], 0.f) & 0xffffu);
    }
    LDS_BAR();
#pragma unroll
    for (int dt = 0; dt < 8; ++dt) {
        v4f acc = (v4f){0.f, 0.f, 0.f, 0.f};
#pragma unroll
        for (int ks = 0; ks < 4; ++ks) acc = mfma_bf(*(const LAS v4u*)(Vt + (16 * dt + l15) * SG_PB + (32 * ks + 8 * c4) * 2), wf[ks], acc);
        const float u0 = gelu_tanh(bf2f(uraw[dt].x & 0xffffu)), u1 = gelu_tanh(bf2f(uraw[dt].x >> 16)), u2 = gelu_tanh(bf2f(uraw[dt].y & 0xffffu)), u3 = gelu_tanh(bf2f(uraw[dt].y >> 16));
        v2u o; o.x = cvtpk_hw(u0 * (acc[0] + bsv), u1 * (acc[1] + bsv)); o.y = cvtpk_hw(u2 * (acc[2] + bsv), u3 * (acc[3] + bsv));
        *(v2u*)(MIX + orow * DM + 1536 + g * 128 + 16 * dt + 4 * c4) = o;
    }
    LDS_BAR();
}

__device__ __forceinline__ int hg_row(int b, int dir, int P) {
    if (P < CTXL) return b * TB + SEQ + (dir ? CTXL - 1 - P : P);
    const int t = P - CTXL; return b * TB + (dir ? SEQ - 1 - t : t);
}
constexpr int NCH = 136, SCH = 17, NSC = NCH / SCH;
constexpr size_t WS_QF = 966 * MiB, WS_KF = 1000 * MiB, WS_VF = 1034 * MiB, WS_PF = 1068 * MiB, WS_DF = 1077 * MiB;
static_assert(WS_DF + (size_t)32 * NCH * 512 <= WS_GS, "fragment buffers inside the mixer-half scratch");
constexpr int PL_DD = 53248  , PL_T = 0, PL_QF = 4096, PL_KF = PL_QF + 8192, PL_VF = PL_KF + 8192, PL_PF = PL_VF + 8192, PL_QP = PL_PF + 2048, PL_KP1 = PL_QP + 8704, PL_KP0 = PL_KP1 + 8704;

__device__ __forceinline__ unsigned bf1(float x) { return cvtpk_hw(x, 0.f) & 0xffffu; }
__device__ __forceinline__ void hgrn_pre(int l, const bf16* PROJ, const float* LBS, unsigned char* QF, unsigned char* KF, unsigned char* VF, unsigned char* PF, float* DF, float* HS, float* HD,
                                         LAS unsigned char* L, int bx, int G, int tid, int lane, int wave) {
    const int kp = lane, jj = wave, c4 = lane >> 4, l15 = lane & 15;
    constexpr float LOG2E = 1.4426950408889634f, CLAMP2 = 115.f;
    LAS v2f* T = (LAS v2f*)(L + PL_T);
    unsigned zr[4], qr[4], vr[4];
#define PRE_LOAD(it_) do { const int ch_ = (it_) / NCH, ci_ = (it_) - ch_ * NCH, dir_ = ch_ & 1, bh_ = ch_ >> 1, h_ = bh_ & 3; \
        const bf16* pr_ = PROJ + (size_t)hg_row(bh_ >> 2, dir_, 32 * ci_ + 4 * jj) * INC + h_ * 128 + 2 * kp; const long st_ = dir_ ? -(long)INC : (long)INC; const int cf_ = dir_ ? C_HFB : C_HFF; \
        _Pragma("unroll") for (int i = 0; i < 4; ++i) { zr[i] = *(const unsigned*)(pr_ + cf_); qr[i] = *(const unsigned*)(pr_ + C_HQ); vr[i] = *(const unsigned*)(pr_ + C_HI); pr_ += st_; } } while (0)
#pragma unroll 1
    for (int s = bx; s < 32 * NSC; s += G) {
    v4f acc[8], dprod[8];
#pragma unroll
    for (int kt = 0; kt < 8; ++kt) { acc[kt] = (v4f){0.f, 0.f, 0.f, 0.f}; dprod[kt] = (v4f){1.f, 1.f, 1.f, 1.f}; }
    const int it0 = (s >> 3) * NCH + (s & 7) * SCH;
    PRE_LOAD(it0);
#pragma unroll 1
    for (int it = it0; it < it0 + SCH; ++it) {
        const int chain = it / NCH;
        const int dir = chain & 1, h = (chain >> 1) & 3;
        const v2f lb2 = *(const v2f*)(LBS + (dir * DEPTH + l) * 512 + h * 128 + 2 * kp);
        float cs[2][4], kk[2][4], qq[2][4];
#pragma unroll
        for (int i = 0; i < 4; ++i)
#pragma unroll
            for (int e = 0; e < 2; ++e) {
                float z = bf2f(e ? zr[i] >> 16 : zr[i] & 0xffffu); z = fminf(fmaxf(z, -40.f), 40.f);
                const float q = bf2f(e ? qr[i] >> 16 : qr[i] & 0xffffu);
                qq[e][i] = q * __builtin_amdgcn_rcpf(1.f + __builtin_amdgcn_exp2f(-q * LOG2E));
                const float lb = e ? lb2.y : lb2.x, oml = 1.f - lb;
                const float ez = __builtin_amdgcn_exp2f(-z * LOG2E), sg = __builtin_amdgcn_rcpf(1.f + ez);
                cs[e][i] = __builtin_amdgcn_logf(fmaxf(lb + oml * sg, 1e-30f)); kk[e][i] = oml * ez * sg;
            }
        v2u vfa, vfb;
        vfa.x = (vr[0] & 0xffffu) | (vr[1] << 16); vfa.y = (vr[2] & 0xffffu) | (vr[3] << 16);
        vfb.x = (vr[0] >> 16) | (vr[1] & 0xffff0000u); vfb.y = (vr[2] >> 16) | (vr[3] & 0xffff0000u);
        if (it + 1 < it0 + SCH) PRE_LOAD(it + 1);
#pragma unroll
        for (int e = 0; e < 2; ++e)
#pragma unroll
            for (int i = 1; i < 4; ++i) cs[e][i] += cs[e][i - 1];
        T[jj * 64 + kp] = (v2f){cs[0][3], cs[1][3]};
        LDS_BAR();
        v2f pre = (v2f){0.f, 0.f}, bend = pre, b15 = pre;
#pragma unroll
        for (int w = 0; w < 8; ++w) { const v2f t = T[w * 64 + kp]; bend += t; if (w < 4) b15 += t; if (w < jj) pre += t; }
        LAS unsigned char* qfp = L + PL_QF + (((jj >> 2) * 4 + (kp >> 4)) * 64 + ((kp >> 1) & 3) * 16 + 4 * (jj & 3)) * 16 + (4 * ((kp >> 3) & 1) + 2 * (kp & 1)) * 2;
        LAS unsigned char* qpp = L + PL_QP + (4 * jj) * 272 + 4 * kp;
        float kh[2][4];
#pragma unroll
        for (int i = 0; i < 4; ++i) {
            float qt[2], qp[2], kp1[2], kp0[2];
#pragma unroll
            for (int e = 0; e < 2; ++e) {
                const float bi = (e ? pre.y : pre.x) + cs[e][i], be = e ? bend.y : bend.x, bm = e ? b15.y : b15.x;
                qt[e] = qq[e][i] * __builtin_amdgcn_exp2f(bi);
                kh[e][i] = kk[e][i] * __builtin_amdgcn_exp2f(be - bi);
                qp[e] = (jj < 4) ? qt[e] : qq[e][i] * __builtin_amdgcn_exp2f(bi - bm);
                kp1[e] = kk[e][i] * __builtin_amdgcn_exp2f(fminf(bm - bi, CLAMP2));
                kp0[e] = (jj < 4) ? kk[e][i] * __builtin_amdgcn_exp2f(fminf(-bi, CLAMP2)) : 0.f;
            }
            *(LAS unsigned*)(qfp + i * 16) = cvtpk_hw(qt[0], qt[1]);
            *(LAS unsigned*)(qpp + i * 272) = cvtpk_hw(qp[0], qp[1]);
            *(LAS unsigned*)(qpp + (PL_KP1 - PL_QP) + i * 272) = cvtpk_hw(kp1[0], kp1[1]);
            if (jj < 4) *(LAS unsigned*)(qpp + (PL_KP0 - PL_QP) + i * 272) = cvtpk_hw(kp0[0], kp0[1]);
        }
        {
            const int ka = 2 * kp, fo = ((ka >> 4) * 64 + (jj >> 1) * 16 + (ka & 15)) * 16 + 8 * (jj & 1);
            v2u w0, w1; w0.x = cvtpk_hw(kh[0][0], kh[0][1]); w0.y = cvtpk_hw(kh[0][2], kh[0][3]); w1.x = cvtpk_hw(kh[1][0], kh[1][1]); w1.y = cvtpk_hw(kh[1][2], kh[1][3]);
            *(LAS v2u*)(L + PL_KF + fo) = w0; *(LAS v2u*)(L + PL_KF + fo + 16) = w1;
            *(LAS v2u*)(L + PL_VF + fo) = vfa; *(LAS v2u*)(L + PL_VF + fo + 16) = vfb; }
        if (jj == 0) { const v2f dd = (v2f){__builtin_amdgcn_exp2f(bend.x), __builtin_amdgcn_exp2f(bend.y)}; *(v2f*)(DF + (size_t)it * 128 + 2 * kp) = dd; *(LAS v2f*)(L + PL_DD + 8 * kp) = dd; }
        LDS_BAR();
        if (wave < 3) {
            const LAS unsigned char* qa = L + PL_QP + ((wave == 0 ? 0 : 16) + l15) * 272 + c4 * 16;
            const LAS unsigned char* kb = (wave == 0 ? L + PL_KP0 + l15 * 272 : L + PL_KP1 + ((wave == 2 ? 16 : 0) + l15) * 272) + c4 * 16;
            v4f p = (v4f){0.f, 0.f, 0.f, 0.f};
#pragma unroll
            for (int s = 0; s < 4; ++s) p = mfma_bf(*(const LAS v4u*)(qa + s * 64), *(const LAS v4u*)(kb + s * 64), p);
            const int mt = wave == 0 ? 0 : 1, sidx = (wave == 2 ? 16 : 0) + l15;
#pragma unroll
            for (int r = 0; r < 4; ++r) { const int tl = 4 * c4 + r; const float v = (wave == 1 || l15 <= tl) ? p[r] : 0.f;
                *(LAS bf16*)(L + PL_PF + (mt * 64 + (sidx >> 3) * 16 + tl) * 16 + (sidx & 7) * 2) = (bf16)bf1(v); }
        } else if (wave == 3) {
            if (lane < 32) { unsigned zz; asm volatile("v_mov_b32 %0, 0" : "=v"(zz)); *(LAS v4u*)(L + PL_PF + (32 + lane) * 16) = (v4u){zz, zz, zz, zz}; }
        }
        LDS_BAR();
        if ((s & 7) < NSC - 1) {
            const v4u vfr = *(const LAS v4u*)(L + PL_VF + (wave * 64 + lane) * 16);
#pragma unroll
            for (int kt = 0; kt < 8; ++kt) { const v4f d = *(const LAS v4f*)(L + PL_DD + (16 * kt + 4 * c4) * 4);
                acc[kt] = acc[kt] * d; acc[kt] = mfma_bf(*(const LAS v4u*)(L + PL_KF + (kt * 64 + lane) * 16), vfr, acc[kt]); dprod[kt] = dprod[kt] * d; }
        }
        *(v4u*)(QF + (size_t)it * 8192 + tid * 16) = *(const LAS v4u*)(L + PL_QF + tid * 16);
        *(v4u*)(KF + (size_t)it * 8192 + tid * 16) = *(const LAS v4u*)(L + PL_KF + tid * 16);
        *(v4u*)(VF + (size_t)it * 8192 + tid * 16) = *(const LAS v4u*)(L + PL_VF + tid * 16);
        if (tid < 128) *(v4u*)(PF + (size_t)it * 2048 + tid * 16) = *(const LAS v4u*)(L + PL_PF + tid * 16);
    }
    if ((s & 7) < NSC - 1) {
        float* slot = HS + (size_t)s * 16384;
#pragma unroll
        for (int kt = 0; kt < 8; ++kt)
#pragma unroll
            for (int r = 0; r < 4; ++r) slot[(16 * kt + 4 * c4 + r) * 128 + 16 * wave + l15] = acc[kt][r];
        if (wave == 0 && l15 == 0) {
#pragma unroll
            for (int kt = 0; kt < 8; ++kt) *(v4f*)(HD + (size_t)s * 128 + 16 * kt + 4 * c4) = dprod[kt];
        }
    }
    LDS_BAR();
    }
#undef PRE_LOAD
}
constexpr int HU_Q = 0, HU_K = 8192, HU_P = 16384, HU_D = 18432, HU_SLOT = 18944, HU_OT = 2 * HU_SLOT + 1024  ;
template <bool WITH_OUT>
__device__ __forceinline__ void hgrn_unit2(int chain, int sc, const unsigned char* QF, const unsigned char* KF, const unsigned char* VF, const unsigned char* PF, const float* DF,
                                           float* HS, float* HD, bf16* HO, LAS unsigned char* L, int tid, int lane, int wave) {
    static_assert(WITH_OUT, "the local-state recurrence lives in hgrn_pre now");
    const int dir = chain & 1, bh = chain >> 1, b = bh >> 2, h = bh & 3, c4 = lane >> 4, l15 = lane & 15;
    v4f acc[8];
    const size_t item0 = (size_t)chain * NCH + sc * SCH;
    v4u rq0, rk0, rp0, rd0, vf0, rq1, rk1, rp1, rd1, vf1, rq2, rk2, rp2, rd2, vf2, rq3, rk3, rp3, rd3, vf3, vf;
#define HU_LOAD(S_, it_) do { rq##S_ = *(const v4u*)(QF + (it_) * 8192 + tid * 16); rk##S_ = *(const v4u*)(KF + (it_) * 8192 + tid * 16); \
        if (tid < 128) rp##S_ = *(const v4u*)(PF + (it_) * 2048 + tid * 16); if (tid < 32) rd##S_ = *(const v4u*)((const unsigned char*)DF + (it_) * 512 + tid * 16); \
        vf##S_ = ((const v4u*)(VF + (it_) * 8192))[wave * 64 + lane]; } while (0)
#define HU_WRITE(S_, s_) do { LAS unsigned char* sl_ = L + (s_) * HU_SLOT; *(LAS v4u*)(sl_ + HU_Q + tid * 16) = rq##S_; *(LAS v4u*)(sl_ + HU_K + tid * 16) = rk##S_; \
        if (tid < 128) *(LAS v4u*)(sl_ + HU_P + tid * 16) = rp##S_; if (tid < 32) *(LAS v4u*)(sl_ + HU_D + tid * 16) = rd##S_; } while (0)
#define HU_FLUSH(step_) do { const int t_ = tid >> 4; const int row_ = hg_row(b, dir, 32 * (sc * SCH + (step_)) + t_); \
        *(v4u*)(HO + ((size_t)dir * R + row_) * 512 + h * 128 + 8 * (tid & 15)) = *(const LAS v4u*)(L + HU_OT + ((step_) & 1) * 8192 + tid * 16); } while (0)
#define HU_COMPUTE(step_) do { const LAS unsigned char* sl = L + ((step_) & 1) * HU_SLOT; \
        v4u sb[4]; \
        _Pragma("unroll") for (int ks = 0; ks < 4; ++ks) { sb[ks].x = cvtpk_hw(acc[2 * ks][0], acc[2 * ks][1]); sb[ks].y = cvtpk_hw(acc[2 * ks][2], acc[2 * ks][3]); \
            sb[ks].z = cvtpk_hw(acc[2 * ks + 1][0], acc[2 * ks + 1][1]); sb[ks].w = cvtpk_hw(acc[2 * ks + 1][2], acc[2 * ks + 1][3]); } \
        _Pragma("unroll") for (int mt = 0; mt < 2; ++mt) { \
            v4f o = (v4f){0.f, 0.f, 0.f, 0.f}; \
            _Pragma("unroll") for (int ks = 0; ks < 4; ++ks) o = mfma_bf(*(const LAS v4u*)(sl + HU_Q + ((mt * 4 + ks) * 64 + lane) * 16), sb[ks], o); \
            o = mfma_bf(*(const LAS v4u*)(sl + HU_P + (mt * 64 + lane) * 16), vf, o); \
            _Pragma("unroll") for (int r = 0; r < 4; ++r) *(LAS bf16*)(L + HU_OT + ((step_) & 1) * 8192 + ((16 * mt + 4 * c4 + r) * 128 + 16 * wave + l15) * 2) = (bf16)bf1(o[r]); } \
        _Pragma("unroll") for (int kt = 0; kt < 8; ++kt) { const v4f d = *(const LAS v4f*)(sl + HU_D + (16 * kt + 4 * c4) * 4); \
            acc[kt] = acc[kt] * d; acc[kt] = mfma_bf(*(const LAS v4u*)(sl + HU_K + (kt * 64 + lane) * 16), vf, acc[kt]); } } while (0)
    HU_LOAD(0, item0);
    HU_LOAD(1, item0 + 1);
    HU_LOAD(2, item0 + 2);
    if (sc > 0) {
        const float* slot = HS + (size_t)(chain * NSC + sc - 1) * 16384;
#pragma unroll
        for (int kt = 0; kt < 8; ++kt)
#pragma unroll
            for (int r = 0; r < 4; ++r) acc[kt][r] = slot[(16 * kt + 4 * c4 + r) * 128 + 16 * wave + l15];
    } else {
#pragma unroll
        for (int kt = 0; kt < 8; ++kt) acc[kt] = (v4f){0.f, 0.f, 0.f, 0.f};
    }
    HU_WRITE(0, 0); vf = vf0;
    LDS_BAR();
#define HU_STEP(s_, SL_, SW_) do { if ((s_) < SCH) { if ((s_) + 3 < SCH) HU_LOAD(SL_, item0 + (s_) + 3); if ((s_) > 0) HU_FLUSH((s_) - 1); HU_COMPUTE(s_); \
        if ((s_) + 1 < SCH) { HU_WRITE(SW_, ((s_) + 1) & 1); vf = vf##SW_; } LDS_BAR(); } } while (0)
#pragma unroll 1
    for (int step = 0; step < SCH; step += 4) { HU_STEP(step, 3, 1); HU_STEP(step + 1, 0, 2); HU_STEP(step + 2, 1, 3); HU_STEP(step + 3, 2, 0); }
    HU_FLUSH(SCH - 1);
    LDS_BAR();
#undef HU_STEP
#undef HU_LOAD
#undef HU_WRITE
#undef HU_COMPUTE
#undef HU_FLUSH
    (void)HD;
}
__device__ __forceinline__ void hgrn_scan(float* HS, const float* HD, int gtid, int NT) {
    for (int e = gtid; e < 32 * 4096; e += NT) {
        const int chain = e >> 12, q4 = e & 4095, k = q4 >> 5;
        v4f* p = (v4f*)(HS + (size_t)chain * NSC * 16384) + q4; const float* dp = HD + chain * NSC * 128 + k;
        v4f tmp[NSC - 1]; float dd[NSC - 1];
#pragma unroll
        for (int s = 0; s < NSC - 1; ++s) { tmp[s] = p[(size_t)s * 4096]; dd[s] = dp[s * 128]; }
        v4f st = (v4f){0.f, 0.f, 0.f, 0.f};
#pragma unroll
        for (int s = 0; s < NSC - 1; ++s) { st = st * dd[s] + tmp[s]; p[(size_t)s * 4096] = st; }
    }
}
__device__ __forceinline__ void hg_combine(const bf16* HO, const bf16* PROJ, bf16* MIX, const float* hgg, bool skip_ctx, int gw, int NGW, int lane) {
    const float g0 = hgg[2 * lane], g1 = hgg[2 * lane + 1];
#pragma unroll 1
    for (int m0 = 4 * gw; m0 < R; m0 += 4 * NGW) {
        const int b = m0 / TB, t = m0 - b * TB; if (t >= SEQ && skip_ctx) continue;
        unsigned a[4][4], c[4][4], w2[4][4];
#pragma unroll
        for (int rr = 0; rr < 4; ++rr)
#pragma unroll
            for (int h = 0; h < 4; ++h) { const bf16* p0 = HO + (size_t)(m0 + rr) * 512 + h * 128 + 2 * lane;
                a[rr][h] = *(const unsigned*)p0; c[rr][h] = *(const unsigned*)(p0 + (size_t)R * 512);
                w2[rr][h] = *(const unsigned*)(PROJ + (size_t)(m0 + rr) * INC + C_HGT + h * 128 + 2 * lane); }
#pragma unroll
        for (int rr = 0; rr < 4; ++rr)
#pragma unroll
            for (int h = 0; h < 4; ++h) {
                const float o0 = bf2f(a[rr][h] & 0xffffu) + bf2f(c[rr][h] & 0xffffu), o1 = bf2f(a[rr][h] >> 16) + bf2f(c[rr][h] >> 16);
                const float rstd = __builtin_amdgcn_rsqf(wave_sum(o0 * o0 + o1 * o1) * (1.f / 128.f) + EPS);
                const float y0 = o0 * rstd * g0 * silu_f(bf2f(w2[rr][h] & 0xffffu)), y1 = o1 * rstd * g1 * silu_f(bf2f(w2[rr][h] >> 16));
                *(unsigned*)(MIX + (size_t)(m0 + rr) * DM + 1024 + h * 128 + 2 * lane) = cvtpk_rne(y0, y1);
            }
    }
}
__device__ __forceinline__ void conv_act_phase(const bf16* UP, bf16* ACT, const float* cw, const float* cb, bool skip_ctx, int gtid, int NT) {
    constexpr int NOCT = DFF / 8, NSTRIP = R / 32;
    for (int it = gtid; it < NSTRIP * NOCT; it += NT) {
        const int strip = it / NOCT, oc = it - strip * NOCT, wi = strip % (TB / 32), c0 = oc * 8;
        if (skip_ctx && wi >= SEQ / 32) continue;
        const bool seg_start = (wi == 0 || wi == SEQ / 32), seg_end = (wi == SEQ / 32 - 1 || wi == TB / 32 - 1);
        float w[2][3][8], bb[2][8];
#pragma unroll
        for (int hlf = 0; hlf < 2; ++hlf) {
#pragma unroll
            for (int jj = 0; jj < 3; ++jj) { const v4f a0 = *(const v4f*)(cw + (size_t)jj * UPC + hlf * DFF + c0), a1 = *(const v4f*)(cw + (size_t)jj * UPC + hlf * DFF + c0 + 4);
                w[hlf][jj][0] = a0.x; w[hlf][jj][1] = a0.y; w[hlf][jj][2] = a0.z; w[hlf][jj][3] = a0.w; w[hlf][jj][4] = a1.x; w[hlf][jj][5] = a1.y; w[hlf][jj][6] = a1.z; w[hlf][jj][7] = a1.w; }
            const v4f b0 = *(const v4f*)(cb + hlf * DFF + c0), b1 = *(const v4f*)(cb + hlf * DFF + c0 + 4);
            bb[hlf][0] = b0.x; bb[hlf][1] = b0.y; bb[hlf][2] = b0.z; bb[hlf][3] = b0.w; bb[hlf][4] = b1.x; bb[hlf][5] = b1.y; bb[hlf][6] = b1.z; bb[hlf][7] = b1.w;
        }
        const size_t r0 = (size_t)strip * 32;
#pragma unroll 1
        for (int sb = 0; sb < 4; ++sb) {
            v4u gr[10], vr[10];
#pragma unroll
            for (int j = 0; j < 10; ++j) {
                const bool zero = (j == 0 && sb == 0 && seg_start) || (j == 9 && sb == 3 && seg_end);
                if (!zero) { const size_t rr = r0 + 8 * sb + j - 1; gr[j] = *(const v4u*)(UP + rr * UPC + c0); vr[j] = *(const v4u*)(UP + rr * UPC + DFF + c0); }
                else { gr[j] = (v4u){0u, 0u, 0u, 0u}; vr[j] = gr[j]; }
            }
#pragma unroll
            for (int i = 0; i < 8; ++i) {
                v4u o;
#pragma unroll
                for (int q = 0; q < 4; ++q) {
                    float res[2];
#pragma unroll
                    for (int e = 0; e < 2; ++e) {
                        const int ci = 2 * q + e;
                        const float gp = e ? bf2f(gr[i][q] >> 16) : bf2f(gr[i][q] & 0xffffu), gc = e ? bf2f(gr[i + 1][q] >> 16) : bf2f(gr[i + 1][q] & 0xffffu), gn = e ? bf2f(gr[i + 2][q] >> 16) : bf2f(gr[i + 2][q] & 0xffffu);
                        const float vp = e ? bf2f(vr[i][q] >> 16) : bf2f(vr[i][q] & 0xffffu), vc = e ? bf2f(vr[i + 1][q] >> 16) : bf2f(vr[i + 1][q] & 0xffffu), vn = e ? bf2f(vr[i + 2][q] >> 16) : bf2f(vr[i + 2][q] & 0xffffu);
                        const float yg = bb[0][ci] + w[0][0][ci] * gp + w[0][1][ci] * gc + w[0][2][ci] * gn;
                        const float yv = bb[1][ci] + w[1][0][ci] * vp + w[1][1][ci] * vc + w[1][2][ci] * vn;
                        res[e] = silu_f(yg) * yv;
                    }
                    o[q] = cvtpk_rne(res[0], res[1]);
                }
                *(v4u*)(ACT + (r0 + 8 * sb + i) * DFF + c0) = o;
            }
        }
    }
}

__device__ __forceinline__ kptr_t kargs_fresh() { kptr_t p = (kptr_t)__builtin_amdgcn_kernarg_segment_ptr(); asm volatile("" : "+s"(p)); return p; }
#define KIN(i)  (*(const float* const AS4*)(kp + 8 * (i)))
#define KOUT()  (*(float* const AS4*)(kp + 176))
#define KWS()   (*(unsigned char* const AS4*)(kp + 184))
#define PH_BEGIN \
    int tid = threadIdx.x; asm volatile("" : "+v"(tid)); \
    const int lane = tid & 63, wave = __builtin_amdgcn_readfirstlane(tid >> 6); \
    int bx = blockIdx.x; asm volatile("" : "+s"(bx)); int G = gridDim.x; asm volatile("" : "+s"(G)); \
    const int gw = bx * NWAVES + wave, NGW = G * NWAVES, gtid = bx * NTHR + tid, NT = G * NTHR; \
    const kptr_t kp = kargs_fresh(); unsigned char* const ws = KWS(); \
    (void)lane; (void)gw; (void)NGW; (void)gtid; (void)NT; (void)ws;

template <int SEL>
__device__ __forceinline__ void convert_item(int l, int r, kptr_t kp, unsigned char* ws, LAS float* scr, int lane) {
    unsigned char* wb = ws + WS_W + (size_t)l * W_LAYER; const float* MOD = (const float*)(ws + WS_MOD) + (size_t)l * 5 * NMODC;
    if (SEL & 1) { if (r < CI_IN) { p0_transpose_item<true>(KIN(I_WIN) + (size_t)l * DM * INC, DM, INC, (bf16*)(wb + W_IN), scr, r, lane, (float*)(ws + WS_SWIN) + (size_t)l * 5 * INC, MOD + 0 * DM); return; } r -= CI_IN; }
    if (SEL & 2) { if (r < CI_OUT) { p0_transpose_item<false>(KIN(I_WOUT) + (size_t)l * DM * DM, DM, DM, (bf16*)(wb + W_OUT), scr, r, lane, nullptr, nullptr); return; } r -= CI_OUT; }
    if (SEL & 4) { if (r < CI_UP) { p0_transpose_item<true>(KIN(I_WUP) + (size_t)l * DM * UPC, DM, UPC, (bf16*)(wb + W_UP), scr, r, lane, (float*)(ws + WS_SWUP) + (size_t)l * 5 * UPC, MOD + 3 * DM); return; } r -= CI_UP; }
    if (SEL & 8) { p0_transpose_item<false>(KIN(I_WDN) + (size_t)l * DFF * DM, DFF, DM, (bf16*)(wb + W_DN), scr, r, lane, nullptr, nullptr); }
}

__global__ void __launch_bounds__(NTHR, 2) mk_fwd(Args a_unused) {
    extern __shared__ __attribute__((aligned(16))) unsigned char lds[];
    LAS unsigned char* ldsp = (LAS unsigned char*)lds;
    int lo, hi;
    { const kptr_t kp = kargs_fresh(); lo = *(const int AS4*)(kp + 192); hi = *(const int AS4*)(kp + 196); }
    for (int u = threadIdx.x; u < (LDS_BYTES - LDSCTL_OFF) / 4; u += NTHR) ((LAS unsigned*)(ldsp + LDSCTL_OFF))[u] = 0u;
    __syncthreads();
#if MK_ONE_LAUNCH
    XcdBarrier bar;
    { const kptr_t kp = kargs_fresh(); bar = xcd_barrier_post((unsigned*)(KWS() + WS_CTL) + CW_BAR, (volatile LAS unsigned*)(ldsp + MISC_OFF) + 8); }
#define GRID_BAR() xcd_barrier(bar)
#else
#define GRID_BAR() do { } while (0)
#endif
#define IN(k) (lo <= (k) && (k) < hi)

    if (IN(0)) {
        PH_BEGIN
        float* MOD = (float*)(ws + WS_MOD);
        p0_mod(KIN(I_C), KIN(I_CCTX), KIN(I_WADA), KIN(I_BADA), ldsp, MOD, tid, lane, wave, bx, G);
        if (bx == G - 1) {
            float* LBS = (float*)(ws + WS_MISC); float* RCOS = (float*)(ws + WS_MISC + 16384); float* RSIN = (float*)(ws + WS_MISC + 24576);
            const float* lbp = KIN(I_LBP);
            for (int i = tid; i < 1024; i += NTHR) { const int dir = i >> 9, ci = i & 511; float v[DEPTH], mx = -3.0e38f;
#pragma unroll
                for (int l = 0; l < DEPTH; ++l) { v[l] = lbp[(dir * DEPTH + l) * 512 + ci]; mx = fmaxf(mx, v[l]); }
                float s = 0.f;
#pragma unroll
                for (int l = 0; l < DEPTH; ++l) { v[l] = expf(v[l] - mx); s += v[l]; }
                float cum = 0.f;
#pragma unroll
                for (int l = 0; l < DEPTH; ++l) { if (l > 0) cum += v[l] / s; LBS[(dir * DEPTH + l) * 512 + ci] = cum; } }
            for (int i = tid; i < 2048; i += NTHR) { const int pos = i >> 5, fi = i & 31; const float inv = powf(10000.f, -(float)fi / 32.f); const float ang = (float)pos * inv; RCOS[i] = cosf(ang); RSIN[i] = sinf(ang); }
        }
        __syncthreads();
        {
            LAS float* scr = (LAS float*)(ldsp + wave * 16384);
            for (int it = gw; it < convert_count<2 | 8>(); it += NGW) convert_item<2 | 8>(0, it, kp, ws, scr, lane);
        }
        GRID_BAR();
    }

    if (IN(1)) { PH_BEGIN
        const float* MOD = (const float*)(ws + WS_MOD);
        {
            const float* xin = KIN(I_X); const float* cin = KIN(I_CTX); bf16* H = (bf16*)(ws + WS_H); float* RS0 = (float*)(ws + WS_RS); const float* g = KIN(I_N1G);
            for (int m0 = 2 * gw; m0 < R; m0 += 2 * NGW) {
                v4f v[2][8];
#pragma unroll
                for (int rr = 0; rr < 2; ++rr) { const int m = m0 + rr, b = m / TB, t = m - b * TB;
                    const v4f* xr = (const v4f*)(t < SEQ ? xin + ((size_t)b * SEQ + t) * DM : cin + ((size_t)b * CTXL + (t - SEQ)) * DM) + lane;
#pragma unroll
                    for (int j = 0; j < 8; ++j) v[rr][j] = xr[64 * j]; }
#pragma unroll
                for (int rr = 0; rr < 2; ++rr) { const int m = m0 + rr, b = m / TB, t = m - b * TB; const float* mrow = MOD + (size_t)(t >= SEQ ? 4 : b) * NMODC; float ss = 0.f;
#pragma unroll
                    for (int j = 0; j < 8; ++j) { const v4f x = v[rr][j]; ss += (x.x * x.x + x.y * x.y) + (x.z * x.z + x.w * x.w); const int c = 4 * lane + 256 * j;
                        const v4f y = x * *(const v4f*)(g + c) * (1.f + *(const v4f*)(mrow + 1 * DM + c));
                        v2u w; w.x = cvtpk_rne(y.x, y.y); w.y = cvtpk_rne(y.z, y.w); *(v2u*)(H + (size_t)m * DM + c) = w; }
                    ss = wave_sum(ss); if (lane == 0) RS0[m] = ss; }
            } }
        {
            float* GS = (float*)(ws + WS_GS); const float* g1 = KIN(I_N1G); const float* g2 = KIN(I_N2G);
            for (int i = gtid; i < DEPTH * 2 * 5 * DM; i += NT) { const int c = i & (DM - 1), r = (i >> 11) % 5, wl = i / (5 * DM), which = wl & 1, l = wl >> 1;
                GS[i] = (which ? g2 : g1)[l * DM + c] * (1.f + MOD[(size_t)(l * 5 + r) * NMODC + (which ? 4 : 1) * DM + c]); } }
        {
            LAS float* scr = (LAS float*)(ldsp + wave * 16384);
            for (int it = gw; it < convert_count<1 | 4>(); it += NGW) convert_item<1 | 4>(0, it, kp, ws, scr, lane);
        }
        GRID_BAR();
    }

#pragma unroll 1
    for (int l = 0; l < DEPTH; ++l) {
        const int pb = 2 + 9 * l; const bool last = (l == DEPTH - 1);
#define MODL ((const float*)(ws + WS_MOD) + (size_t)l * 5 * NMODC)
#define WB   (ws + WS_W + (size_t)l * W_LAYER)
#define RSL(s_) ((float*)(ws + WS_RS) + (size_t)(s_) * R)
#define GSL(l_, which_) ((const float*)(ws + WS_GS) + (size_t)((l_) * 2 + (which_)) * 5 * DM)
        if (IN(pb + 0)) { PH_BEGIN
            pg8::Gemm g{(const bf16*)(ws + WS_H), (const bf16*)(WB + W_IN), R, INC, DM}; TileOrder S; S.init2(INC, G, bx, false);
            EpiBf16N E{(bf16*)(ws + WS_PROJ), INC, RSL(2 * l), (const float*)(ws + WS_SWIN) + (size_t)l * 5 * INC};
            pg8::gemm_phase<EpiBf16N, TileOrder, true, true>(ldsp, g, S, E);
            GRID_BAR();
        }
        if (IN(pb + 1)) { PH_BEGIN
            const bf16* PROJ = (const bf16*)(ws + WS_PROJ);
            qknorm_phase(PROJ, (bf16*)(ws + WS_QN), (bf16*)(ws + WS_KN), KIN(I_QG) + l * 128, KIN(I_KG) + l * 128, (const float*)(ws + WS_MISC + 16384), (const float*)(ws + WS_MISC + 24576), gw, NGW, lane);
            {   const int nch = last ? 32 : 34, nU = NB * nch * 4;
                for (int u = bx; u < nU; u += G) { const int g = u & 3, bn = u >> 2, b = bn / nch, n = bn - b * nch;
                    sg_unit(b, n, g, l, PROJ, (bf16*)(ws + WS_MIX), KIN(I_SGG) + l * 512, KIN(I_SGW), KIN(I_SGB), ldsp, tid, lane, wave); } }
            hgrn_pre(l, PROJ, (const float*)(ws + WS_MISC), ws + WS_QF, ws + WS_KF, ws + WS_VF, ws + WS_PF, (float*)(ws + WS_DF), (float*)(ws + WS_HS), (float*)(ws + WS_HD), ldsp, bx, G, tid, lane, wave);
            GRID_BAR();
        }
        if (IN(pb + 2)) { PH_BEGIN
            hgrn_scan((float*)(ws + WS_HS), (const float*)(ws + WS_HD), gtid, NT);
            const int nU = last ? 512 : 544;
            for (int u = bx; u < nU; u += G) {
                int b, hq, row_q, row_k, seq;
                if (u < 512) { const int xcd = u & 7, idx = u >> 3; b = xcd >> 1; hq = (xcd & 1) * 4 + (idx >> 4); row_k = b * TB; row_q = row_k + (idx & 15) * 256; seq = TB; }
                else { const int uc = u - 512; b = uc >> 3; hq = uc & 7; row_k = b * TB + SEQ; row_q = row_k; seq = CTXL; }
                const int kvh = hq >> 2;
                att::attn_dense_body((const bf16*)(ws + WS_QN) + (size_t)row_q * 1024 + hq * 128, (const bf16*)(ws + WS_KN) + (size_t)row_k * 256 + kvh * 128,
                                     (const bf16*)(ws + WS_PROJ) + (size_t)row_k * INC + C_AV + kvh * 128, (bf16*)(ws + WS_MIX) + (size_t)row_q * DM + hq * 128, seq, (char*)lds);
            }
            GRID_BAR();
        }
        if (IN(pb + 3)) { PH_BEGIN
            for (int u = bx; u < 32 * NSC; u += G) hgrn_unit2<true>(u & 31, u >> 5, ws + WS_QF, ws + WS_KF, ws + WS_VF, ws + WS_PF, (const float*)(ws + WS_DF), (float*)(ws + WS_HS), (float*)(ws + WS_HD), (bf16*)(ws + WS_HO), ldsp, tid, lane, wave);
            GRID_BAR();
        }
        if (IN(pb + 4)) { PH_BEGIN hg_combine((const bf16*)(ws + WS_HO), (const bf16*)(ws + WS_PROJ), (bf16*)(ws + WS_MIX), KIN(I_HGG) + l * 128, last, gw, NGW, lane); GRID_BAR(); }
        if (IN(pb + 5)) { PH_BEGIN
            pg8::Gemm g{(const bf16*)(ws + WS_MIX), (const bf16*)(WB + W_OUT), R, DM, DM}; TileOrder S; S.init2(DM, G, bx, last);
            EpiResGate<true> E{(float*)(ws + WS_X), MODL, 2, (bf16*)(ws + WS_H), GSL(l, 1), RSL(2 * l + 1), l == 0 ? KIN(I_X) : nullptr, l == 0 ? KIN(I_CTX) : nullptr};
            pg8::gemm_phase<EpiResGate<true>, TileOrder, true, true>(ldsp, g, S, E);
            if (!last) {
                const int nfull = (G == 256) ? 32 : 0; LAS float* scr = (LAS float*)(ldsp + wave * 16384);
                if (bx >= nfull) for (int it = (bx - nfull) * NWAVES + wave; it < convert_count<1 | 2>(); it += (G - nfull) * NWAVES) convert_item<1 | 2>(l + 1, it, kp, ws, scr, lane);
            }
            GRID_BAR();
        }
        if (IN(pb + 6)) { PH_BEGIN
            pg8::Gemm g{(const bf16*)(ws + WS_H), (const bf16*)(WB + W_UP), R, UPC, DM}; TileOrder S; S.init2(UPC, G, bx, last);
            EpiBf16N E{(bf16*)(ws + WS_UP), UPC, RSL(2 * l + 1), (const float*)(ws + WS_SWUP) + (size_t)l * 5 * UPC};
            pg8::gemm_phase<EpiBf16N, TileOrder, true, true>(ldsp, g, S, E);
            GRID_BAR();
        }
        if (IN(pb + 7)) { PH_BEGIN conv_act_phase((const bf16*)(ws + WS_UP), (bf16*)(ws + WS_ACT), KIN(I_CW) + (size_t)l * 3 * UPC, KIN(I_CB) + (size_t)l * UPC, last, gtid, NT); GRID_BAR(); }
        if (IN(pb + 8)) { PH_BEGIN
            pg8::Gemm g{(const bf16*)(ws + WS_ACT), (const bf16*)(WB + W_DN), R, DM, DFF}; TileOrder S; S.init2(DM, G, bx, last);
            if (!last) { EpiResGate<true> E{(float*)(ws + WS_X), MODL, 5, (bf16*)(ws + WS_H), GSL(l + 1, 0), RSL(2 * l + 2), nullptr, nullptr};
                pg8::gemm_phase<EpiResGate<true>, TileOrder, true, true>(ldsp, g, S, E);
                const int nfull = (G == 256) ? 32 : 0; LAS float* scr = (LAS float*)(ldsp + wave * 16384);
                if (bx >= nfull) for (int it = (bx - nfull) * NWAVES + wave; it < convert_count<4 | 8>(); it += (G - nfull) * NWAVES) convert_item<4 | 8>(l + 1, it, kp, ws, scr, lane); }
            else { EpiResGate<false> E{(float*)(ws + WS_X), MODL, 5, nullptr, nullptr, nullptr, nullptr, nullptr};
                pg8::gemm_phase<EpiResGate<false>, TileOrder, true, true>(ldsp, g, S, E); }
            GRID_BAR();
        }
    }
    if (IN(NPHASE - 1)) { PH_BEGIN
        const float* g = KIN(I_FNG); const float* X = (const float*)(ws + WS_X); float* out = KOUT();
        for (int m0 = 2 * gw; m0 < NB * SEQ; m0 += 2 * NGW) {
            v4f v[2][8];
#pragma unroll
            for (int rr = 0; rr < 2; ++rr) { const int m = m0 + rr, b = m >> 12, t = m & 4095; const v4f* xr = (const v4f*)(X + (size_t)(b * TB + t) * DM) + lane;
#pragma unroll
                for (int j = 0; j < 8; ++j) v[rr][j] = xr[64 * j]; }
#pragma unroll
            for (int rr = 0; rr < 2; ++rr) { float ss = 0.f;
#pragma unroll
                for (int j = 0; j < 8; ++j) ss += (v[rr][j].x * v[rr][j].x + v[rr][j].y * v[rr][j].y) + (v[rr][j].z * v[rr][j].z + v[rr][j].w * v[rr][j].w);
                const float rstd = __builtin_amdgcn_rsqf(wave_sum(ss) * (1.f / DM) + EPS);
                v4f* orow = (v4f*)(out + (size_t)(m0 + rr) * DM) + lane;
#pragma unroll
                for (int j = 0; j < 8; ++j) orow[64 * j] = v[rr][j] * rstd * *(const v4f*)(g + 4 * lane + 256 * j); }
        }
    }
#undef IN
}

extern "C" void kernel_launch(void* const* d_in, const int* in_sizes, int n_in, void* d_out, int out_size, void* d_ws, size_t ws_size, hipStream_t stream) {
    static int grid = 0;
    if (grid == 0) {
        if (n_in != 22 || in_sizes[0] != NB * SEQ * DM || out_size != NB * SEQ * DM || ws_size < WS_END) {
            fprintf(stderr, "kernel_launch: unexpected shapes (n_in %d in0 %d out %d ws %zu, need ws >= %zu); nothing launched\n", n_in, n_in > 0 ? in_sizes[0] : -1, out_size, ws_size, (size_t)WS_END); grid = -1; return; }
        int dev = 0, cus = 0, per_cu = 0;
        if (hipGetDevice(&dev) != hipSuccess || hipDeviceGetAttribute(&cus, hipDeviceAttributeMultiprocessorCount, dev) != hipSuccess) { grid = -1; return; }
        if (hipFuncSetAttribute((const void*)mk_fwd, hipFuncAttributeMaxDynamicSharedMemorySize, LDS_BYTES) != hipSuccess) { fprintf(stderr, "kernel_launch: hipFuncSetAttribute failed\n"); grid = -1; return; }
        if (hipOccupancyMaxActiveBlocksPerMultiprocessor(&per_cu, (const void*)mk_fwd, NTHR, LDS_BYTES) != hipSuccess || per_cu < 1)
            fprintf(stderr, "kernel_launch: note: occupancy query reports %d workgroups per CU\n", per_cu);
        (void)hipGetLastError();
        grid = cus;
    }
    if (grid < 0) return;
    if (hipMemsetAsync((char*)d_ws + WS_CTL, 0, CTL_ZERO_BYTES, stream) != hipSuccess) return;
    Args a{};
    for (int i = 0; i < 22; ++i) a.in[i] = (const float*)d_in[i];
    a.out = (float*)d_out; a.ws = (unsigned char*)d_ws;
#if MK_ONE_LAUNCH
    a.ph_lo = 0; a.ph_hi = NPHASE;
    hipLaunchKernelGGL(mk_fwd, dim3(grid), dim3(NTHR), LDS_BYTES, stream, a);
#else
    for (int p = 0; p < NPHASE; ++p) { a.ph_lo = p; a.ph_hi = p + 1; hipLaunchKernelGGL(mk_fwd, dim3(grid), dim3(NTHR), LDS_BYTES, stream, a); }
#endif
    const hipError_t le = hipPeekAtLastError();
    if (le != hipSuccess) fprintf(stderr, "kernel_launch: launch failed: %s\n", hipGetErrorName(le));
}
```

```cpp
#include <hip/hip_runtime.h>
#include <cstdio>
#include <cstdint>
#ifndef MK_ONE_LAUNCH
#define MK_ONE_LAUNCH 1
#endif
namespace pg8 {
#define PG8_LAS __attribute__((address_space(3)))
typedef unsigned short bf16_t;
typedef short bf16x8 __attribute__((ext_vector_type(8)));
typedef float f32x4 __attribute__((ext_vector_type(4)));
typedef unsigned u32x4 __attribute__((ext_vector_type(4)));
constexpr int BM = 256, BK = 64, HALF = 128, HTB = HALF * BK * 2  , STAGE_BYTES = 8 * HTB, NXCD = 8, WGM = 8;

__host__ __device__ __forceinline__ int lds_byte(int r, int c) { const int st = (r >> 4) * 2 + (c >> 5), rr = r & 15, cc = c & 31, ob = rr * 64 + cc * 2; return st * 1024 + (ob ^ (((ob >> 9) & 1) << 5)); }
__host__ __device__ __forceinline__ void stage_rc(int b, int& R, int& C) { const int st = b / 1024, sb = b % 1024, swz = sb ^ (((sb >> 9) & 1) << 5); R = (st >> 1) * 16 + swz / 64; C = (st & 1) * 32 + (swz % 64) / 2; }
__host__ __device__ __forceinline__ int perm32(int rho) { const int n = rho >> 4, i = rho & 15; return 8 * (i >> 2) + 4 * n + (i & 3); }

struct Unit { int pm, pn, hn; };
struct Gemm { const bf16_t* A; const bf16_t* Bt; int M, N, K; };

struct StaticOrder {
    int nM, nN, nwg, G, c;
    __host__ __device__ void init(int M, int N, int G_, int c_) { nM = M / BM; nN = N / BM; nwg = nM * nN; G = G_; c = c_; }
    __host__ __device__ bool next(int i, Unit& u) const {
        const long L = (long)i * G + c; if (L >= nwg) return false;
        int wgid = (int)L; { const int q = nwg / NXCD, r = nwg % NXCD, xcd = wgid % NXCD, off = wgid / NXCD; wgid = (xcd < r ? xcd * (q + 1) : r * (q + 1) + (xcd - r) * q) + off; }
        const int nig = WGM * nN, gid = wgid / nig, fm = gid * WGM, gsz = (nM - fm) < WGM ? (nM - fm) : WGM;
        u.pm = fm + ((wgid % nig) % gsz); u.pn = (wgid % nig) / gsz; u.hn = 0; return true;
    }
    __device__ __forceinline__ void a_ready(const Unit&) const {}
    __device__ __forceinline__ void done(const Unit&) const {}
};

__device__ __forceinline__ unsigned cvt_pk_bf16(float lo, float hi) { unsigned r; asm volatile("v_cvt_pk_bf16_f32 %0, %1, %2" : "=v"(r) : "v"(lo), "v"(hi)); return r; }
typedef float f32x2 __attribute__((ext_vector_type(2)));
__device__ __forceinline__ f32x2 gelu_pk(f32x2 v) {
    const f32x2 av = __builtin_elementwise_abs(v), d = av * 0.2316418882f + 1.0f;
    f32x2 t; t.x = __builtin_amdgcn_rcpf(d.x); t.y = __builtin_amdgcn_rcpf(d.y);
    f32x2 q = t * 0.5307027145f + (-0.7265760135f); q = q * t + 0.7107068705f; q = q * t + (-0.142248368f); q = q * t + 0.127414796f; q = q * t;
    const f32x2 s = (v * v) * (-0.72134752044f);
    f32x2 e; e.x = __builtin_amdgcn_exp2f(s.x); e.y = __builtin_amdgcn_exp2f(s.y);
    const f32x2 m = v * (q * e), r = v - m;
    f32x2 o; o.x = v.x < 0.f ? m.x : r.x; o.y = v.y < 0.f ? m.y : r.y; return o;
}

template <int ACT  > struct EpiBf16 {
    static constexpr bool PERM = true, AFTER_DRAIN = false, HALF_N = false; static_assert(ACT == 0 || ACT == 1, "EpiBf16: ACT is 0 (none) or 1 (gelu_pk)");
    bf16_t* O; int ldc; const float* bias; int split_cols; size_t split_stride; float scale0;
    __device__ __forceinline__ void operator()(const f32x4 (&acc)[2][2][4][2], const Unit& u, int wr, int wc, int fr, int fq) const {
        const int row0 = u.pm * BM + wr * 64 + fr; int colt = u.pn * BM; bf16_t* base = O;
        float sc = 1.f; if (split_cols) { const int t = colt / split_cols; base += (size_t)t * split_stride; colt -= t * split_cols; if (t == 0) sc = scale0; }
        const int col0 = colt + wc * 32 + 8 * fq, bcol0 = u.pn * BM + wc * 32 + 8 * fq;
        f32x4 bv[2][2];
#pragma unroll
        for (int bj = 0; bj < 2; ++bj)
#pragma unroll
            for (int n = 0; n < 2; ++n) bv[bj][n] = bias ? *(const f32x4*)(bias + bcol0 + bj * HALF + 4 * n) : (f32x4){0.f, 0.f, 0.f, 0.f};
#pragma unroll
        for (int ai = 0; ai < 2; ++ai)
#pragma unroll
            for (int m = 0; m < 4; ++m) { bf16_t* rowp = base + (size_t)(row0 + ai * HALF + m * 16) * ldc + col0;
#pragma unroll
                for (int bj = 0; bj < 2; ++bj) { f32x4 v0 = acc[ai][bj][m][0] + bv[bj][0], v1 = acc[ai][bj][m][1] + bv[bj][1];
                    if (ACT == 1) { f32x2 a = gelu_pk((f32x2){v0[0], v0[1]}), b = gelu_pk((f32x2){v0[2], v0[3]}), c = gelu_pk((f32x2){v1[0], v1[1]}), d = gelu_pk((f32x2){v1[2], v1[3]});
                        v0 = (f32x4){a.x, a.y, b.x, b.y}; v1 = (f32x4){c.x, c.y, d.x, d.y}; }
                    v0 = v0 * sc; v1 = v1 * sc; u32x4 w; w.x = cvt_pk_bf16(v0[0], v0[1]); w.y = cvt_pk_bf16(v0[2], v0[3]); w.z = cvt_pk_bf16(v1[0], v1[1]); w.w = cvt_pk_bf16(v1[2], v1[3]);
                    *(u32x4*)(rowp + bj * HALF) = w; } }
    }
};
template <class Epi, class Sched, bool ALIGN_EPI = false, bool SP2 = false>
__device__ __forceinline__ void gemm_phase(PG8_LAS unsigned char* lds, const Gemm g, const Sched& S, const Epi& E) {
    int tid_l = threadIdx.x; asm volatile("" : "+v"(tid_l)); const int tid = tid_l, wid = __builtin_amdgcn_readfirstlane(tid >> 6), lane = tid & 63, wr = wid >> 2, wc = wid & 3, fr = lane & 15, fq = lane >> 4;
    static_assert(!Epi::HALF_N || SP2, "HALF_N units exist for the two-super-phase loop only");
    const int K = g.K, nt = K / BK;
    unsigned voffA[2], voffB[2];
#pragma unroll
    for (int i = 0; i < 2; ++i) { int R, C; stage_rc(tid * 16 + i * 8192, R, C); const int Rb = Epi::PERM ? ((R & ~31) + perm32(R & 31)) : R;
        voffA[i] = (unsigned)(R * K + C) * 2u; voffB[i] = (unsigned)(Rb * K + C) * 2u; }
    const size_t kstep = (size_t)(BK * 2);
    const size_t hstep = (size_t)HALF * K * 2;
    const size_t tstep = 2 * hstep;
    const unsigned ldsw = (unsigned)wid * 1024u;
    const int aoff = lds_byte(wr * 64 + fr, fq * 8), boff = lds_byte(wc * 32 + fr, fq * 8);
#define PG8_SA(b, h) (((b) * 2 + (h)) * HTB)
#define PG8_SB(b, h) ((4 + (b) * 2 + (h)) * HTB)
#define PG8_STAGE(bufoff, gbase, voff) do { _Pragma("unroll") for (int _i = 0; _i < 2; ++_i) \
        __builtin_amdgcn_global_load_lds((const unsigned*)((const char*)(gbase) + (voff)[_i]), (PG8_LAS unsigned*)(lds + (bufoff) + ldsw + _i * 8192), 16, 0, 0); } while (0)
#define PG8_LDA(dst, b, h) do { _Pragma("unroll") for (int m = 0; m < 4; ++m) _Pragma("unroll") for (int k = 0; k < 2; ++k) dst[m][k] = *(const PG8_LAS bf16x8*)(lds + PG8_SA(b, h) + aoff + m * 2048 + k * 1024); } while (0)
#define PG8_LDB(dst, b, h) do { _Pragma("unroll") for (int n = 0; n < 2; ++n) _Pragma("unroll") for (int k = 0; k < 2; ++k) dst[n][k] = *(const PG8_LAS bf16x8*)(lds + PG8_SB(b, h) + boff + n * 2048 + k * 1024); } while (0)
#define PG8_MMA(ai, bj, At, Bt) do { __builtin_amdgcn_s_setprio(1); _Pragma("unroll") for (int m = 0; m < 4; ++m) _Pragma("unroll") for (int n = 0; n < 2; ++n) _Pragma("unroll") for (int k = 0; k < 2; ++k) \
        acc[ai][bj][m][n] = __builtin_amdgcn_mfma_f32_16x16x32_bf16(Bt[n][k], At[m][k], acc[ai][bj][m][n], 0, 0, 0); __builtin_amdgcn_s_setprio(0); } while (0)
#define PG8_WAIT_V(n) asm volatile("s_waitcnt vmcnt(" #n ")" ::: "memory")
#define PG8_WAIT_L(n) asm volatile("s_waitcnt lgkmcnt(" #n ")" ::: "memory")
#define PG8_BAR __builtin_amdgcn_s_barrier()
#define PG8_SCHED __builtin_amdgcn_sched_barrier(0)
    Unit cur, nxt; int ui = 0;
    if (!S.next(0, cur)) return;
    f32x4 acc[2][2][4][2];
#pragma unroll
    for (int a = 0; a < 2; ++a)
#pragma unroll
        for (int b = 0; b < 2; ++b)
#pragma unroll
            for (int m = 0; m < 4; ++m)
#pragma unroll
                for (int n = 0; n < 2; ++n) acc[a][b][m][n] = (f32x4){0.f, 0.f, 0.f, 0.f};
    bf16x8 At[4][2], B0[2][2], B1[2][2];
    const char* cA = (const char*)g.A + (size_t)cur.pm * tstep; const char* cB = (const char*)g.Bt + (size_t)cur.pn * tstep + (Epi::HALF_N ? (size_t)cur.hn * hstep : (size_t)0);
    S.a_ready(cur);
    if constexpr (SP2) {
        PG8_STAGE(PG8_SB(0, 0), cB, voffB); PG8_STAGE(PG8_SB(0, 1), cB + hstep, voffB); PG8_STAGE(PG8_SA(0, 0), cA, voffA); PG8_STAGE(PG8_SA(0, 1), cA + hstep, voffA);
        if (wr == 1) PG8_BAR;
        PG8_WAIT_V(2); PG8_BAR;
        PG8_STAGE(PG8_SB(1, 0), cB + kstep, voffB); PG8_STAGE(PG8_SA(1, 0), cA + kstep, voffA); PG8_STAGE(PG8_SB(1, 1), cB + hstep + kstep, voffB);
        PG8_WAIT_V(6); PG8_BAR;
    } else {
        PG8_STAGE(PG8_SB(0, 0), cB, voffB); PG8_STAGE(PG8_SA(0, 0), cA, voffA); PG8_STAGE(PG8_SB(0, 1), cB + hstep, voffB); PG8_STAGE(PG8_SA(0, 1), cA + hstep, voffA);
        if (wr == 1) PG8_BAR;
        PG8_WAIT_V(4); PG8_BAR;
        PG8_STAGE(PG8_SB(1, 0), cB + kstep, voffB); PG8_STAGE(PG8_SA(1, 0), cA + kstep, voffA); PG8_STAGE(PG8_SB(1, 1), cB + hstep + kstep, voffB);
        PG8_WAIT_V(6); PG8_BAR;
    }
    for (;;) {
        const bool has_next = S.next(ui + 1, nxt);
        const char* nA = has_next ? (const char*)g.A + (size_t)nxt.pm * tstep : cA; const char* nB = has_next ? (const char*)g.Bt + (size_t)nxt.pn * tstep + (Epi::HALF_N ? (size_t)nxt.hn * hstep : (size_t)0) : cB;
        for (int t = 0; t < nt; t += 2) {
            const bool last = (t == nt - 2);
            const char* a1 = cA + (size_t)(t + 1) * kstep;
            const char* a2 = last ? nA : cA + (size_t)(t + 2) * kstep; const char* b2 = last ? nB : cB + (size_t)(t + 2) * kstep;
            const char* a3 = a2 + kstep; const char* b3 = b2 + kstep;
            if (last && has_next) S.a_ready(nxt);
            if constexpr (SP2) {
            PG8_LDB(B0, 0, 0); if constexpr (!Epi::HALF_N) PG8_LDB(B1, 0, 1); PG8_SCHED; PG8_LDA(At, 0, 0); PG8_STAGE(PG8_SA(1, 1), a1 + hstep, voffA);
            PG8_WAIT_V(8); PG8_WAIT_L(0); PG8_BAR; PG8_MMA(0, 0, At, B0); if constexpr (!Epi::HALF_N) PG8_MMA(0, 1, At, B1); PG8_BAR; PG8_SCHED;
            PG8_LDA(At, 0, 1); PG8_STAGE(PG8_SB(0, 0), b2, voffB); PG8_STAGE(PG8_SB(0, 1), b2 + hstep, voffB); PG8_STAGE(PG8_SA(0, 0), a2, voffA);
            PG8_WAIT_V(8); PG8_WAIT_L(0); PG8_BAR; PG8_MMA(1, 0, At, B0); if constexpr (!Epi::HALF_N) PG8_MMA(1, 1, At, B1); PG8_BAR; PG8_SCHED;
            PG8_LDB(B0, 1, 0); if constexpr (!Epi::HALF_N) PG8_LDB(B1, 1, 1); PG8_SCHED; PG8_LDA(At, 1, 0); PG8_STAGE(PG8_SA(0, 1), a2 + hstep, voffA);
            PG8_WAIT_V(8); PG8_WAIT_L(0); PG8_BAR; PG8_MMA(0, 0, At, B0); if constexpr (!Epi::HALF_N) PG8_MMA(0, 1, At, B1); PG8_BAR; PG8_SCHED;
            PG8_LDA(At, 1, 1); PG8_STAGE(PG8_SB(1, 0), b3, voffB); PG8_STAGE(PG8_SB(1, 1), b3 + hstep, voffB); PG8_STAGE(PG8_SA(1, 0), a3, voffA);
            PG8_WAIT_V(8); PG8_WAIT_L(0); PG8_BAR; PG8_MMA(1, 0, At, B0); if constexpr (!Epi::HALF_N) PG8_MMA(1, 1, At, B1); PG8_BAR; PG8_SCHED;
            } else {
            PG8_LDB(B0, 0, 0); PG8_SCHED; PG8_LDA(At, 0, 0); PG8_STAGE(PG8_SA(1, 1), a1 + hstep, voffA);
            PG8_WAIT_L(8); PG8_BAR; PG8_WAIT_L(0); PG8_MMA(0, 0, At, B0); PG8_BAR; PG8_SCHED;
            PG8_LDB(B1, 0, 1); PG8_STAGE(PG8_SB(0, 0), b2, voffB);
            PG8_BAR; PG8_WAIT_L(0); PG8_MMA(0, 1, At, B1); PG8_BAR;
            PG8_LDA(At, 0, 1); PG8_STAGE(PG8_SA(0, 0), a2, voffA);
            PG8_BAR; PG8_WAIT_L(0); PG8_MMA(1, 0, At, B0); PG8_BAR; PG8_SCHED;
            PG8_STAGE(PG8_SB(0, 1), b2 + hstep, voffB);
            PG8_WAIT_V(6); PG8_BAR; PG8_MMA(1, 1, At, B1); PG8_BAR;
            PG8_LDB(B0, 1, 0); PG8_SCHED; PG8_LDA(At, 1, 0); PG8_STAGE(PG8_SA(0, 1), a2 + hstep, voffA);
            PG8_WAIT_L(8); PG8_BAR; PG8_WAIT_L(0); PG8_MMA(0, 0, At, B0); PG8_BAR; PG8_SCHED;
            PG8_LDB(B1, 1, 1); PG8_STAGE(PG8_SB(1, 0), b3, voffB);
            PG8_BAR; PG8_WAIT_L(0); PG8_MMA(0, 1, At, B1); PG8_BAR;
            PG8_LDA(At, 1, 1); PG8_STAGE(PG8_SA(1, 0), a3, voffA);
            PG8_BAR; PG8_WAIT_L(0); PG8_MMA(1, 0, At, B0); PG8_BAR; PG8_SCHED;
            PG8_STAGE(PG8_SB(1, 1), b3 + hstep, voffB);
            PG8_WAIT_V(6); PG8_BAR; PG8_MMA(1, 1, At, B1); PG8_BAR;
            }
        }
        if constexpr (ALIGN_EPI) { if (wr == 0) PG8_BAR; }
        if constexpr (!Epi::AFTER_DRAIN) { E(acc, cur, wr, wc, fr, fq); S.done(cur); }
        if (!has_next) break;
#pragma unroll
        for (int a = 0; a < 2; ++a)
#pragma unroll
            for (int b = 0; b < 2; ++b)
#pragma unroll
                for (int m = 0; m < 4; ++m)
#pragma unroll
                    for (int n = 0; n < 2; ++n) acc[a][b][m][n] = (f32x4){0.f, 0.f, 0.f, 0.f};
        cur = nxt; cA = nA; cB = nB; ++ui;
        if constexpr (ALIGN_EPI) { if (wr == 1) PG8_BAR; }
    }
    PG8_WAIT_V(0);
    if constexpr (!ALIGN_EPI) { if (wr == 0) PG8_BAR; }
    PG8_BAR;
    if constexpr (Epi::AFTER_DRAIN) { E.fused(acc, cur, wr, wc, fr, fq, lds, wid, lane); S.done(cur); }
#undef PG8_SA
#undef PG8_SB
#undef PG8_STAGE
#undef PG8_LDA
#undef PG8_LDB
#undef PG8_MMA
#undef PG8_WAIT_V
#undef PG8_WAIT_L
#undef PG8_BAR
#undef PG8_SCHED
}
}
constexpr int DM = 2048, NB = 4, SEQ = 4096, CTXL = 256, DEPTH = 4;
constexpr int TB = SEQ + CTXL;
constexpr int R = NB * TB;
constexpr int INC = 5120, DFF = 5632, UPC = 2 * DFF, NMODC = 6 * DM;
constexpr int C_AQ = 0, C_AK = 1024, C_AV = 1280, C_HQ = 1536, C_HFF = 2048, C_HFB = 2560, C_HI = 3072, C_HGT = 3584, C_SU = 4096, C_SV = 4608;
constexpr float EPS = 1e-6f;
constexpr int NWAVES = 8, NTHR = 512;
constexpr int NPHASE = 3 + 9 * DEPTH;

constexpr size_t MiB = 1u << 20;
constexpr size_t WS_CTL = 0, CTL_ZERO_BYTES = 4 * MiB;
constexpr size_t WS_MOD = 3 * MiB;
constexpr size_t WS_MISC = 1146 * MiB;
constexpr size_t WS_W = 4 * MiB, W_LAYER = 94 * MiB, W_IN = 0, W_OUT = 20 * MiB, W_UP = 28 * MiB, W_DN = 72 * MiB;
constexpr size_t WS_X = 380 * MiB;
constexpr size_t WS_H = 516 * MiB;
constexpr size_t WS_PROJ = 584 * MiB;
constexpr size_t WS_QN = 754 * MiB;
constexpr size_t WS_KN = 788 * MiB;
constexpr size_t WS_MIX = 797 * MiB;
constexpr size_t WS_HS = 865 * MiB;
constexpr size_t WS_HD = 897 * MiB;
constexpr size_t WS_HO = 898 * MiB;
constexpr size_t WS_UP = 584 * MiB;
constexpr size_t WS_ACT = 958 * MiB;
constexpr size_t WS_SWIN = 1 * MiB;
constexpr size_t WS_SWUP = WS_SWIN + 512 * 1024;
constexpr size_t WS_GS = 1145 * MiB;
constexpr size_t WS_END = 1147 * MiB;
constexpr size_t WS_RS = 65536;
static_assert(WS_RS + (size_t)2 * DEPTH * R * 4 <= WS_SWIN && WS_SWIN + (size_t)DEPTH * 5 * INC * 4 <= WS_SWUP && WS_SWUP + (size_t)DEPTH * 5 * UPC * 4 <= WS_MOD && WS_MOD + (size_t)DEPTH * 5 * NMODC * 4 <= CTL_ZERO_BYTES && WS_GS + (size_t)DEPTH * 2 * 5 * DM * 4 <= WS_MISC && WS_MISC + 65536 <= WS_END && WS_MOD + (size_t)DEPTH * 5 * NMODC * 4 <= WS_W, "ws map 4");
static_assert(WS_HO + (size_t)2 * R * 512 * 4 <= 966 * MiB && WS_UP + (size_t)R * UPC * 2 <= WS_ACT && WS_ACT + (size_t)R * DFF * 2 <= WS_GS, "ws map");
static_assert(WS_PROJ + (size_t)R * INC * 2 <= WS_QN && WS_QN + (size_t)R * 1024 * 2 <= WS_KN && WS_KN + (size_t)R * 256 * 2 <= WS_MIX && WS_MIX + (size_t)R * DM * 2 <= WS_HS, "ws map 2");
static_assert(WS_X + (size_t)R * DM * 4 <= WS_H && WS_H + (size_t)R * DM * 2 <= WS_PROJ && WS_W + DEPTH * W_LAYER <= WS_X, "ws map 3");
constexpr int CW_BAR = 4096;
constexpr int CW_Q0 = 64;

constexpr int RING_BYTES = 131072, LDSCTL_OFF = RING_BYTES, MISC_OFF = LDSCTL_OFF + 320, LDS_BYTES = 147456;

#define GAS __attribute__((address_space(1)))
#define LAS __attribute__((address_space(3)))
typedef unsigned short bf16;
typedef float v4f __attribute__((ext_vector_type(4)));
typedef unsigned v4u __attribute__((ext_vector_type(4)));
typedef unsigned v2u __attribute__((ext_vector_type(2)));
typedef float v2f __attribute__((ext_vector_type(2)));
typedef GAS unsigned gu32;
#define AS4 __attribute__((address_space(4)))
typedef const AS4 unsigned char* kptr_t;
#define LDS_WAIT() asm volatile("s_waitcnt lgkmcnt(0)" ::: "memory")
#define LDS_BAR() do { asm volatile("s_waitcnt lgkmcnt(0)" ::: "memory"); __builtin_amdgcn_s_barrier(); asm volatile("" ::: "memory"); } while (0)
__device__ __forceinline__ float bf2f(unsigned u) { return __uint_as_float(u << 16); }
__device__ __forceinline__ unsigned f2bf(float f) { unsigned u = __float_as_uint(f); return (u + 0x7fffu + ((u >> 16) & 1u)) >> 16; }
__device__ __forceinline__ unsigned pk2(float lo, float hi) { return f2bf(lo) | (f2bf(hi) << 16); }
typedef float cvt_f32x2 __attribute__((ext_vector_type(2))); typedef __bf16 cvt_bf16x2 __attribute__((ext_vector_type(2)));
__device__ __forceinline__ unsigned cvtpk_rne(float lo, float hi) { const cvt_f32x2 v = {lo, hi}; return __builtin_bit_cast(unsigned, __builtin_convertvector(v, cvt_bf16x2)); }
__device__ __forceinline__ float dpp_f(float v, const int ctrl_unused) { return v; }
#define DPP_ADD(v, ctrl) ((v) + __builtin_bit_cast(float, __builtin_amdgcn_update_dpp(0, __builtin_bit_cast(int, (v)), (ctrl), 0xf, 0xf, false)))
__device__ __forceinline__ float wave_sum(float v) {
    v = DPP_ADD(v, 0xB1);
    v = DPP_ADD(v, 0x4E);
    v = DPP_ADD(v, 0x141);
    v = DPP_ADD(v, 0x140);
    { auto rr = __builtin_amdgcn_permlane16_swap(__float_as_uint(v), __float_as_uint(v), false, false); v = __uint_as_float(rr[0]) + __uint_as_float(rr[1]); }
    { auto rr = __builtin_amdgcn_permlane32_swap(__float_as_uint(v), __float_as_uint(v), false, false); v = __uint_as_float(rr[0]) + __uint_as_float(rr[1]); }
    return v;
}
__device__ __forceinline__ float sigm(float z) { return __builtin_amdgcn_rcpf(1.f + __expf(-z)); }
__device__ __forceinline__ float silu_f(float z) { return z * sigm(z); }
__device__ __forceinline__ float gelu_tanh(float x) {
    const float u = 0.7978845608028654f * (x + 0.044715f * x * x * x);
    const float th = 1.f - 2.f * __builtin_amdgcn_rcpf(1.f + __expf(2.f * u));
    return 0.5f * x * (1.f + th);
}
__device__ __forceinline__ v4f mfma4(float a, float b, v4f c) { return __builtin_amdgcn_mfma_f32_16x16x4f32(a, b, c, 0, 0, 0); }

#define XB_TMO      128
#define XB_XCNT(j)  (256  + 64 * (j))
#define XB_XSUB(j)  (1280 + 64 * (j))
#define XB_XGEN(j)  (2304 + 64 * (j))
#define XB_TOP      3328
#define XB_TOPGEN   3392
#define XCD_BAR_WORDS 3456
#define XB_SPIN_CAP (1u << 18)
__device__ __forceinline__ unsigned xb_ld(unsigned* p)              { return __hip_atomic_load(p, __ATOMIC_RELAXED, __HIP_MEMORY_SCOPE_AGENT); }
__device__ __forceinline__ unsigned xb_add(unsigned* p, unsigned v) { return __hip_atomic_fetch_add(p, v, __ATOMIC_RELAXED, __HIP_MEMORY_SCOPE_AGENT); }
__device__ __forceinline__ unsigned xb_xcc_id() { return (unsigned)__builtin_amdgcn_s_getreg((3 << 11) | 20) & 0xFu; }
#define XB_SPIN(cond, bar) do { unsigned _sp = 0; while (cond) { __builtin_amdgcn_s_sleep(1); \
    if ((++_sp & 255u) == 0u) { if (xb_ld(&(bar)[XB_TMO])) break; if (_sp > XB_SPIN_CAP) { atomicAdd(&(bar)[XB_TMO], 1u); break; } } } } while (0)
struct XcdBarrier { unsigned* bar; unsigned x; volatile LAS unsigned* st; };
__device__ __forceinline__ XcdBarrier xcd_barrier_post(unsigned* bar, volatile LAS unsigned* st) {
    XcdBarrier b; b.bar = bar; b.x = xb_xcc_id(); b.st = st;
    if (threadIdx.x == 0) (void)xb_add(&bar[XB_XCNT(b.x)], 1u);
    return b;
}
__device__ __forceinline__ void xcd_barrier_complete(unsigned* bar, unsigned x, unsigned& nloc, unsigned& nx) {
    const unsigned G = gridDim.x * gridDim.y * gridDim.z;
    unsigned sum, cnt, mine, sp = 0u;
    for (;;) {
        sum = 0u; cnt = 0u; mine = 0u;
#pragma unroll
        for (unsigned j = 0; j < 16; ++j) { const unsigned c = xb_ld(&bar[XB_XCNT(j)]); sum += c; cnt += (c > 0u) ? 1u : 0u; mine = (j == x) ? c : mine; }
        if (sum == G) break;
        __builtin_amdgcn_s_sleep(1);
        if ((++sp & 255u) == 0u) { if (xb_ld(&bar[XB_TMO])) break; if (sp > XB_SPIN_CAP) { atomicAdd(&bar[XB_TMO], 1u); break; } }
    }
    nloc = mine > 0u ? mine : 1u; nx = cnt > 0u ? cnt : 1u;
}
__device__ __forceinline__ void xcd_barrier(const XcdBarrier& b) {
    asm volatile("s_waitcnt vmcnt(0)" ::: "memory");
    __syncthreads();
    if (threadIdx.x == 0) {
        unsigned* bar = b.bar;
        __builtin_amdgcn_s_waitcnt(0);
        unsigned nloc = b.st[0], nx = b.st[1];
        if (nloc == 0u) { xcd_barrier_complete(bar, b.x, nloc, nx); b.st[0] = nloc; b.st[1] = nx; }
        const unsigned old = xb_add(&bar[XB_XSUB(b.x)], 1u);
        const unsigned gen = old / nloc;
        if (old + 1u == (gen + 1u) * nloc) {
            __builtin_amdgcn_fence(__ATOMIC_RELEASE, "agent");
            asm volatile("s_waitcnt vmcnt(0)" ::: "memory");
            const unsigned og = xb_add(&bar[XB_TOP], 1u);
            const unsigned tg = og / nx;
            if (og + 1u == (tg + 1u) * nx) xb_add(&bar[XB_TOPGEN], 1u);
            else XB_SPIN(xb_ld(&bar[XB_TOPGEN]) == tg, bar);
            __builtin_amdgcn_fence(__ATOMIC_ACQUIRE, "agent");
            xb_add(&bar[XB_XGEN(b.x)], 1u);
            asm volatile("s_waitcnt vmcnt(0)" ::: "memory");
        } else {
            XB_SPIN(xb_ld(&bar[XB_XGEN(b.x)]) == gen, bar);
            __builtin_amdgcn_fence(__ATOMIC_ACQUIRE, "agent");
            asm volatile("s_waitcnt vmcnt(0)" ::: "memory");
        }
    }
    __syncthreads();
}

struct TileOrder : pg8::StaticOrder {
    bool skip;
    __device__ void init2(int N, int G_, int c_, bool skip_) { skip = skip_; init(skip_ ? NB * SEQ : R, N, G_, c_); }
    __device__ bool next(int i, pg8::Unit& u) const { if (!pg8::StaticOrder::next(i, u)) return false; if (skip) u.pm += u.pm >> 4; return true; }
};
__device__ __forceinline__ unsigned cvt_pk2(float lo, float hi) { return cvtpk_rne(lo, hi); }
template <bool MAKE_H, bool HALF = false>
struct EpiResGate {
    static constexpr bool PERM = true, AFTER_DRAIN = false, HALF_N = HALF;
    float* X; const float* mod_l; int jg; bf16* H; const float* gs; float* rs;
    const float* xin; const float* cin;
    __device__ __forceinline__ void operator()(const pg8::f32x4 (&acc)[2][2][4][2], const pg8::Unit& u, int wr, int wc, int fr, int fq) const {
        const int b = u.pm / 17, jt = u.pm - b * 17, mrow = (jt == 16 ? 4 : b);
        const float* gp = mod_l + (size_t)mrow * NMODC + (size_t)jg * DM;
        const float* gsp = gs + (size_t)mrow * DM;
        const int col0 = u.pn * 256 + (HALF ? u.hn * 128 : 0) + wc * 32 + 8 * fq;
        constexpr int NBJ = HALF ? 1 : 2;
        pg8::f32x4 gv[2][2];
#pragma unroll
        for (int bj = 0; bj < NBJ; ++bj)
#pragma unroll
            for (int n = 0; n < 2; ++n) gv[bj][n] = *(const pg8::f32x4*)(gp + col0 + bj * 128 + 4 * n);
#pragma unroll
        for (int ai = 0; ai < 2; ++ai)
#pragma unroll
            for (int m = 0; m < 4; ++m) { const int row = u.pm * 256 + ai * 128 + wr * 64 + m * 16 + fr; const size_t off = (size_t)row * DM + col0; float ss = 0.f;
                const float* src = xin ? (jt == 16 ? cin + ((size_t)b * CTXL + (row - u.pm * 256)) * DM : xin + ((size_t)b * SEQ + jt * 256 + (row - u.pm * 256)) * DM) + col0 : X + off;
#pragma unroll
                for (int bj = 0; bj < NBJ; ++bj) { pg8::f32x4 xn[2];
#pragma unroll
                    for (int n = 0; n < 2; ++n) { xn[n] = *(const pg8::f32x4*)(src + bj * 128 + 4 * n) + gv[bj][n] * acc[ai][bj][m][n]; *(pg8::f32x4*)(X + off + bj * 128 + 4 * n) = xn[n]; }
                    if (MAKE_H) {
#pragma unroll
                        for (int n = 0; n < 2; ++n) ss += (xn[n][0] * xn[n][0] + xn[n][1] * xn[n][1]) + (xn[n][2] * xn[n][2] + xn[n][3] * xn[n][3]);
                        const pg8::f32x4 h0 = xn[0] * *(const pg8::f32x4*)(gsp + col0 + bj * 128), h1 = xn[1] * *(const pg8::f32x4*)(gsp + col0 + bj * 128 + 4);
                        v4u w; w.x = cvt_pk2(h0[0], h0[1]); w.y = cvt_pk2(h0[2], h0[3]); w.z = cvt_pk2(h1[0], h1[1]); w.w = cvt_pk2(h1[2], h1[3]);
                        *(v4u*)(H + off + bj * 128) = w; } }
                if (MAKE_H) { ss += __shfl_xor(ss, 16); ss += __shfl_xor(ss, 32); if (fq == 0) unsafeAtomicAdd(rs + row, ss); }
                if (m & 1) asm volatile("" ::: "memory"); }
    }
};
struct EpiBf16N {
    static constexpr bool PERM = true, AFTER_DRAIN = false, HALF_N = false;
    bf16* O; int ldc; const float* rs; const float* sw;
    __device__ __forceinline__ void operator()(const pg8::f32x4 (&acc)[2][2][4][2], const pg8::Unit& u, int wr, int wc, int fr, int fq) const {
        const int b = u.pm / 17, jt = u.pm - b * 17, mrow = (jt == 16 ? 4 : b);
        const int row0 = u.pm * 256 + wr * 64 + fr, col0 = u.pn * 256 + wc * 32 + 8 * fq;
        const float* swp = sw + (size_t)mrow * ldc + col0;
        pg8::f32x4 bv[2][2];
#pragma unroll
        for (int bj = 0; bj < 2; ++bj)
#pragma unroll
            for (int n = 0; n < 2; ++n) bv[bj][n] = *(const pg8::f32x4*)(swp + bj * 128 + 4 * n);
#pragma unroll
        for (int ai = 0; ai < 2; ++ai)
#pragma unroll
            for (int m = 0; m < 4; ++m) { const int row = row0 + ai * 128 + m * 16; const float rstd = 1.0f / sqrtf(rs[row] * (1.f / DM) + EPS);
                bf16* rowp = O + (size_t)row * ldc + col0;
#pragma unroll
                for (int bj = 0; bj < 2; ++bj) { const pg8::f32x4 v0 = acc[ai][bj][m][0] * rstd + bv[bj][0], v1 = acc[ai][bj][m][1] * rstd + bv[bj][1];
                    pg8::u32x4 w; w.x = cvt_pk2(v0[0], v0[1]); w.y = cvt_pk2(v0[2], v0[3]); w.z = cvt_pk2(v1[0], v1[1]); w.w = cvt_pk2(v1[2], v1[3]);
                    *(pg8::u32x4*)(rowp + bj * 128) = w; } }
    }
};

struct CtxHalfOrder {
    int nN, G, c;
    __device__ bool next(int i, pg8::Unit& u) const { const int L = i * G + c; if (c >= G || L >= NB * nN * 2) return false; u.hn = L & 1; u.pn = (L >> 1) % nN; u.pm = ((L >> 1) / nN) * 17 + 16; return true; }
    __device__ __forceinline__ void a_ready(const pg8::Unit&) const {}
    __device__ __forceinline__ void done(const pg8::Unit&) const {}
};

namespace att {
using bf16x8 = __attribute__((ext_vector_type(8))) short;
using s16x4  = __attribute__((ext_vector_type(4))) short;
using f32x16 = __attribute__((ext_vector_type(16))) float;
using u32x4  = __attribute__((ext_vector_type(4))) unsigned;
constexpr int   D = 128, NW = 8, QBLK = 32, KVBLK = 64;
constexpr float SCALE = 0.088388347648318440f;
constexpr float THR = 8.f;
constexpr int LDQ = 1024, LDK = 256, LDV = INC, LDO = DM;
constexpr size_t SHM_V = KVBLK * D * 2, SHM_K = KVBLK * D * 2, SHM_ATTN = 2 * SHM_V + 2 * SHM_K + NW * 64 * 4;
#define KSWZ(row, colB) ((row) * 256 + ((colB) ^ (((row) & 7) << 4)))
#define SBAR() __builtin_amdgcn_sched_barrier(0)
__device__ __forceinline__ int crow(int r, int hi) { return (r & 3) + 8 * (r >> 2) + 4 * hi; }
__device__ __forceinline__ unsigned cvtpk(float lo, float hi) { unsigned r; asm volatile("v_cvt_pk_bf16_f32 %0, %1, %2" : "=v"(r) : "v"(lo), "v"(hi)); return r; }
__device__ __forceinline__ void partialSM(f32x16& p0, f32x16& p1, float& m_reg, float& mn, float& alpha) {
  constexpr float C = SCALE * 1.4426950408889634f;
  float pmax = p0[0]; for (int r = 1; r < 16; ++r) pmax = fmaxf(pmax, p0[r]); for (int r = 0; r < 16; ++r) pmax = fmaxf(pmax, p1[r]);
  { auto rr = __builtin_amdgcn_permlane32_swap(__float_as_uint(pmax), __float_as_uint(pmax), false, false);
    pmax = fmaxf(__uint_as_float(rr[0]), __uint_as_float(rr[1])); }
  if (__builtin_expect(__all(pmax - m_reg <= THR / SCALE), 1)) { mn = m_reg; alpha = 1.f; }
  else { mn = fmaxf(m_reg, pmax); alpha = __builtin_amdgcn_exp2f((m_reg - mn) * C); m_reg = mn; }
  float mnC = -mn * C;
  for (int r = 0; r < 16; ++r) p0[r] = fmaf(p0[r], C, mnC); for (int r = 0; r < 16; ++r) p1[r] = fmaf(p1[r], C, mnC);
  for (int r = 0; r < 16; ++r) p0[r] = __builtin_amdgcn_exp2f(p0[r]);
}
__device__ __forceinline__ void finishSM(f32x16& p0, f32x16& p1, float alpha, float& l_reg, bf16x8& pa0, bf16x8& pa1, bf16x8& pa2, bf16x8& pa3) {
  for (int r = 0; r < 16; ++r) p1[r] = __builtin_amdgcn_exp2f(p1[r]);
  float ps = 0; for (int r = 0; r < 16; ++r) ps += p0[r]; for (int r = 0; r < 16; ++r) ps += p1[r];
  { auto rr = __builtin_amdgcn_permlane32_swap(__float_as_uint(ps), __float_as_uint(ps), false, false);
    ps = __uint_as_float(rr[0]) + __uint_as_float(rr[1]); }
  l_reg = l_reg * alpha + ps;
#define PK4(P, BASE, OUT) do { unsigned a0 = cvtpk(P[BASE + 0], P[BASE + 1]), a1 = cvtpk(P[BASE + 2], P[BASE + 3]);   \
    unsigned b0 = cvtpk(P[BASE + 4], P[BASE + 5]), b1 = cvtpk(P[BASE + 6], P[BASE + 7]);                              \
    auto r0 = __builtin_amdgcn_permlane32_swap(a0, b0, false, false); auto r1 = __builtin_amdgcn_permlane32_swap(a1, b1, false, false); \
    u32x4 w = {r0[0], r1[0], r0[1], r1[1]}; OUT = *reinterpret_cast<bf16x8*>(&w); } while (0)
  PK4(p0, 0, pa0); PK4(p0, 8, pa1); PK4(p1, 0, pa2); PK4(p1, 8, pa3);
#undef PK4
}
__device__ __forceinline__ void qkt(f32x16& p0, f32x16& p1, const bf16* Ks, const bf16x8* qr, int r32, int hi) {
  p0 = f32x16{}; p1 = f32x16{};
  for (int d0 = 0; d0 < 8; ++d0) { int cb = (d0 * 16 + hi * 8) * 2;
    bf16x8 b0 = *reinterpret_cast<const bf16x8*>((const char*)Ks + KSWZ(r32, cb));
    bf16x8 b1 = *reinterpret_cast<const bf16x8*>((const char*)Ks + KSWZ(32 + r32, cb));
    p0 = __builtin_amdgcn_mfma_f32_32x32x16_bf16(b0, qr[d0], p0, 0, 0, 0);
    p1 = __builtin_amdgcn_mfma_f32_32x32x16_bf16(b1, qr[d0], p1, 0, 0, 0); }
}
__device__ __forceinline__ int v_st(int k, int c) { const int kk = (k & ~0xC) | ((k & 4) << 1) | ((k & 8) >> 1); return ((kk >> 3) * 4 + (c >> 5)) * 512 + ((kk & 7) * 32 + (c & 31)) * 2; }
__device__ __forceinline__ int v_rd_base(int lane) { return ((lane & 3) << 3) | (((lane >> 2) & 3) << 6) | (((lane >> 4) & 1) << 5) | (((lane >> 5) & 1) << 8); }
constexpr int v_rd_off(int d0, int ks, int half) { return d0 * 512 + ks * 4096 + half * 2048; }
template <int OFF> __device__ __forceinline__ s16x4 tr_read(int vb) {
  s16x4 r; asm volatile("ds_read_b64_tr_b16 %0, %1 offset:%2" : "=&v"(r) : "v"(vb), "i"(OFF) : "memory"); return r;
}
template <int D0> __device__ __forceinline__ void pv_one(f32x16& od, int vb, bf16x8 pa0, bf16x8 pa1, bf16x8 pa2, bf16x8 pa3) {
  const s16x4 l0 = tr_read<v_rd_off(D0, 0, 0)>(vb), h0 = tr_read<v_rd_off(D0, 0, 1)>(vb), l1 = tr_read<v_rd_off(D0, 1, 0)>(vb), h1 = tr_read<v_rd_off(D0, 1, 1)>(vb);
  const s16x4 l2 = tr_read<v_rd_off(D0, 2, 0)>(vb), h2 = tr_read<v_rd_off(D0, 2, 1)>(vb), l3 = tr_read<v_rd_off(D0, 3, 0)>(vb), h3 = tr_read<v_rd_off(D0, 3, 1)>(vb);
  asm volatile("s_waitcnt lgkmcnt(0)" ::: "memory"); SBAR();
#define PK(L, H) (bf16x8){L[0], L[1], L[2], L[3], H[0], H[1], H[2], H[3]}
  od = __builtin_amdgcn_mfma_f32_32x32x16_bf16(pa0, PK(l0, h0), od, 0, 0, 0);
  od = __builtin_amdgcn_mfma_f32_32x32x16_bf16(pa1, PK(l1, h1), od, 0, 0, 0);
  od = __builtin_amdgcn_mfma_f32_32x32x16_bf16(pa2, PK(l2, h2), od, 0, 0, 0);
  od = __builtin_amdgcn_mfma_f32_32x32x16_bf16(pa3, PK(l3, h3), od, 0, 0, 0);
#undef PK
}
__device__ __forceinline__ void pv_d0(f32x16* o, int vb, bf16x8 pa0, bf16x8 pa1, bf16x8 pa2, bf16x8 pa3) {
  pv_one<0>(o[0], vb, pa0, pa1, pa2, pa3); pv_one<1>(o[1], vb, pa0, pa1, pa2, pa3); pv_one<2>(o[2], vb, pa0, pa1, pa2, pa3); pv_one<3>(o[3], vb, pa0, pa1, pa2, pa3);
}
__device__ __forceinline__ void attn_dense_body(const bf16* __restrict__ Qb, const bf16* __restrict__ Kh, const bf16* __restrict__ Vh,
                                                bf16* __restrict__ Ob, int seq, char* lds) {
  int tid_l = threadIdx.x; asm volatile("" : "+v"(tid_l)); const int tid = tid_l, wid = tid >> 6, lane = tid & 63, r32 = lane & 31, hi = lane >> 5;
  bf16* V_lds = (bf16*)lds; bf16* K_lds = (bf16*)(lds + 2 * SHM_V);
  float* ws = (float*)(lds + 2 * SHM_V + 2 * SHM_K) + wid * 64; float* li_l = ws; float* al_l = ws + 32;
  float m_reg = -1e30f, l_reg = 0; f32x16 o[4] = {}; bf16x8 qr[8];
  const bf16* Qw = Qb + (long)(wid * QBLK + r32) * LDQ + hi * 8;
#pragma unroll
  for (int d0 = 0; d0 < 8; ++d0) qr[d0] = *reinterpret_cast<const bf16x8*>(Qw + d0 * 16);
  const int sr = tid >> 4, sc = (tid & 15) * 8, vst0 = v_st(sr, sc), vst1 = v_st(32 + sr, sc);
  const int vb0 = (int)(uintptr_t)V_lds + v_rd_base(lane);
  struct { bf16x8 vs0, vs1, ks0, ks1; } sr_[2];
#define SLOAD(i, k0) do { sr_[i].vs0 = *reinterpret_cast<const bf16x8*>(&Vh[(long)((k0) + sr) * LDV + sc]); sr_[i].vs1 = *reinterpret_cast<const bf16x8*>(&Vh[(long)((k0) + 32 + sr) * LDV + sc]); \
    sr_[i].ks0 = *reinterpret_cast<const bf16x8*>(&Kh[(long)((k0) + sr) * LDK + sc]); sr_[i].ks1 = *reinterpret_cast<const bf16x8*>(&Kh[(long)((k0) + 32 + sr) * LDK + sc]); } while (0)
#define SWRITE(b, i) do { *(bf16x8*)((char*)V_lds + (b) * SHM_V + vst0) = sr_[i].vs0;          \
    *(bf16x8*)((char*)V_lds + (b) * SHM_V + vst1) = sr_[i].vs1; int kc = sc * 2;               \
    *(bf16x8*)((char*)K_lds + (b) * SHM_K + KSWZ(sr, kc)) = sr_[i].ks0;                       \
    *(bf16x8*)((char*)K_lds + (b) * SHM_K + KSWZ(32 + sr, kc)) = sr_[i].ks1; } while (0)
#define SWAIT() asm volatile("s_waitcnt vmcnt(4)" ::: "memory")
#define RESC(a) do { if (__any((a) < 1.f)) { if (hi == 0) al_l[r32] = (a); asm volatile("s_waitcnt lgkmcnt(0)" ::: "memory"); \
    for (int d = 0; d < 4; ++d) for (int r = 0; r < 16; ++r) o[d][r] *= al_l[crow(r, hi)]; } } while (0)
  f32x16 pA0, pA1, pB0, pB1; float mnA, mnB, alA, alB; bf16x8 pa0, pa1, pa2, pa3; const int NT = seq / KVBLK;
  constexpr int SE = 0, SO = 1;
  SLOAD(SE, 0); asm volatile("s_waitcnt vmcnt(0)" ::: "memory"); SWRITE(0, SE); __syncthreads();
  qkt(pA0, pA1, K_lds, qr, r32, hi); partialSM(pA0, pA1, m_reg, mnA, alA);
  SLOAD(SO, KVBLK); if (2 < NT) SLOAD(SE, 2 * KVBLK);
  SWAIT(); SWRITE(1, SO); __syncthreads();
  for (int j = 1; j + 1 < NT; j += 2) {
    SBAR(); qkt(pB0, pB1, (bf16*)((char*)K_lds + SHM_K), qr, r32, hi);
    finishSM(pA0, pA1, alA, l_reg, pa0, pa1, pa2, pa3); SBAR();
    SLOAD(SO, (j + 2) * KVBLK); SBAR();
    pv_d0(o, vb0, pa0, pa1, pa2, pa3); partialSM(pB0, pB1, m_reg, mnB, alB);
    __syncthreads(); SWAIT(); SWRITE(0, SE);
    RESC(alB); __syncthreads();
    SBAR(); qkt(pA0, pA1, K_lds, qr, r32, hi);
    finishSM(pB0, pB1, alB, l_reg, pa0, pa1, pa2, pa3); SBAR();
    if (j + 3 < NT) SLOAD(SE, (j + 3) * KVBLK); SBAR();
    pv_d0(o, vb0 + (int)SHM_V, pa0, pa1, pa2, pa3); partialSM(pA0, pA1, m_reg, mnA, alA);
    __syncthreads(); SWAIT(); SWRITE(1, SO);
    RESC(alA); __syncthreads();
  }
  SBAR(); qkt(pB0, pB1, (bf16*)((char*)K_lds + SHM_K), qr, r32, hi);
  finishSM(pA0, pA1, alA, l_reg, pa0, pa1, pa2, pa3); SBAR();
  pv_d0(o, vb0, pa0, pa1, pa2, pa3); partialSM(pB0, pB1, m_reg, mnB, alB);
  __syncthreads(); RESC(alB);
  finishSM(pB0, pB1, alB, l_reg, pa0, pa1, pa2, pa3); SBAR();
  pv_d0(o, vb0 + (int)SHM_V, pa0, pa1, pa2, pa3);
  if (hi == 0) li_l[r32] = l_reg; asm volatile("s_waitcnt lgkmcnt(0)" ::: "memory");
  float rli[16];
#pragma unroll
  for (int r = 0; r < 16; ++r) rli[r] = __builtin_amdgcn_rcpf(li_l[crow(r, hi)]);
  bf16* Ow = Ob + (long)(wid * QBLK) * LDO;
#pragma unroll
  for (int r = 0; r < 16; ++r) { int orow = crow(r, hi);
    for (int d0 = 0; d0 < 4; ++d0) Ow[(long)orow * LDO + d0 * 32 + r32] = (bf16)f2bf(o[d0][r] * rli[r]); }
  __syncthreads();
#undef SLOAD
#undef SWRITE
#undef SWAIT
#undef RESC
}
}

struct Args { const float* in[22]; float* out; unsigned char* ws; int ph_lo, ph_hi; };
enum { I_X = 0, I_C, I_CTX, I_CCTX, I_WADA, I_BADA, I_N1G, I_WIN, I_QG, I_KG, I_LBP, I_HGG, I_SGG, I_SGW, I_SGB, I_WOUT, I_N2G, I_WUP, I_CW, I_CB, I_WDN, I_FNG };

__device__ __forceinline__ void p0_mod(const float* cin, const float* ccin, const float* wada, const float* bada, LAS unsigned char* lds, float* MOD, int tid, int lane, int wave, int bx, int G) {
    LAS float* sc = (LAS float*)lds;
    LAS float* red0 = (LAS float*)(lds + 40960);
    for (int i = tid; i < 5 * DM; i += NTHR) { const int r = i >> 11, k = i & 2047; const float v = r < 4 ? cin[r * DM + k] : ccin[k]; sc[i] = silu_f(v); }
    LDS_BAR();
    int par = 0;
    for (int it = bx; it < 768; it += G, par ^= 1) {
        const int cb = it >> 2, kq = it & 3, l = cb / 48, n0 = (cb % 48) * 256, kbase = 512 * kq + 64 * wave;
        const float* wp = wada + ((size_t)l * DM + kbase) * NMODC + n0 + 4 * lane;
        LAS float* red = red0 + par * (8 * 5 * 256);
        v4f acc[5];
#pragma unroll
        for (int r = 0; r < 5; ++r) acc[r] = (v4f){0.f, 0.f, 0.f, 0.f};
#pragma unroll 16
        for (int k = 0; k < 64; ++k) {
            const v4f w = *(const v4f*)(wp + (size_t)k * NMODC);
#pragma unroll
            for (int r = 0; r < 5; ++r) { const float s = sc[r * DM + kbase + k]; acc[r] += w * s; }
        }
#pragma unroll
        for (int r = 0; r < 5; ++r) *(LAS v4f*)(red + (wave * 5 + r) * 256 + 4 * lane) = acc[r];
        LDS_BAR();
        for (int o = tid; o < 1280; o += NTHR) { const int r = o >> 8, ci = o & 255; float s = (kq == 0) ? bada[l * NMODC + n0 + ci] : 0.f;
#pragma unroll
            for (int w = 0; w < 8; ++w) s += red[(w * 5 + r) * 256 + ci];
            unsafeAtomicAdd(MOD + (size_t)(l * 5 + r) * NMODC + n0 + ci, s); }
    }
    LDS_BAR();
}
template <bool SWACC>
__device__ __forceinline__ void p0_transpose_item(const float* W, int K, int N, bf16* WT, LAS float* scr, int item, int lane, float* sw, const float* sh) {
    const int nblk = N / 32, kb = item / nblk, nb = item % nblk, k0 = 64 * kb, n0 = 32 * nb;
    {   v4f t[8];
#pragma unroll
        for (int i = 0; i < 8; ++i) t[i] = *(const v4f*)(W + (size_t)(k0 + 8 * i + (lane >> 3)) * N + n0 + 4 * (lane & 7));
#pragma unroll
        for (int i = 0; i < 8; ++i) { LAS float* d = scr + (8 * i + (lane >> 3)) * 33 + 4 * (lane & 7); d[0] = t[i].x; d[1] = t[i].y; d[2] = t[i].z; d[3] = t[i].w; } }
    LDS_WAIT(); asm volatile("" ::: "memory");
    const int c = lane & 7;
#pragma unroll
    for (int j = 0; j < 4; ++j) { const int n = (lane >> 3) + 8 * j; const LAS float* s = scr + (8 * c) * 33 + n;
        v4u o; o.x = pk2(s[0 * 33], s[1 * 33]); o.y = pk2(s[2 * 33], s[3 * 33]); o.z = pk2(s[4 * 33], s[5 * 33]); o.w = pk2(s[6 * 33], s[7 * 33]);
        *(GAS v4u*)(WT + (size_t)(n0 + n) * K + k0 + 8 * c) = o; }
    if (SWACC) {
        const int n = lane & 31, kh = lane >> 5; float s5[5] = {0.f, 0.f, 0.f, 0.f, 0.f};
        const float* shp = sh + k0 + 32 * kh; const LAS float* tp = scr + (32 * kh) * 33 + n;
#pragma unroll
        for (int q = 0; q < 8; ++q) { const float w0 = tp[(4 * q) * 33], w1 = tp[(4 * q + 1) * 33], w2 = tp[(4 * q + 2) * 33], w3 = tp[(4 * q + 3) * 33];
#pragma unroll
            for (int r = 0; r < 5; ++r) { const v4f s = *(const v4f*)(shp + (size_t)r * NMODC + 4 * q); s5[r] += (s.x * w0 + s.y * w1) + (s.z * w2 + s.w * w3); } }
#pragma unroll
        for (int r = 0; r < 5; ++r) { s5[r] += __shfl_xor(s5[r], 32); if (lane < 32) unsafeAtomicAdd(sw + (size_t)r * N + n0 + n, s5[r]); }
    }
    LDS_WAIT(); asm volatile("" ::: "memory");
}
constexpr int CI_IN = (DM / 64) * (INC / 32), CI_OUT = (DM / 64) * (DM / 32), CI_UP = (DM / 64) * (UPC / 32), CI_DN = (DFF / 64) * (DM / 32);
template <int SEL>
__device__ __forceinline__ void convert_item(int l, int r, kptr_t kp, unsigned char* ws, LAS float* scr, int lane);
template <int SEL> constexpr int convert_count() { return ((SEL & 1) ? CI_IN : 0) + ((SEL & 2) ? CI_OUT : 0) + ((SEL & 4) ? CI_UP : 0) + ((SEL & 8) ? CI_DN : 0); }
__device__ __forceinline__ void norm_phase(const float* X, bf16* H, const float* g, const float* mod_l, int jshift, int jscale, bool skip_ctx, int gw, int NGW, int lane) {
    for (int m = gw; m < R; m += NGW) {
        const int b = m / TB, t = m - b * TB; const bool isc = t >= SEQ; if (isc && skip_ctx) continue;
        const float* mrow = mod_l + (size_t)(isc ? 4 : b) * NMODC;
        const v4f* xr = (const v4f*)(X + (size_t)m * DM) + lane;
        v4f v[8]; float ss = 0.f;
#pragma unroll
        for (int j = 0; j < 8; ++j) { v[j] = xr[64 * j]; ss += (v[j].x * v[j].x + v[j].y * v[j].y) + (v[j].z * v[j].z + v[j].w * v[j].w); }
        const float rstd = 1.0f / sqrtf(wave_sum(ss) * (1.f / DM) + EPS);
#pragma unroll
        for (int j = 0; j < 8; ++j) { const int c = 4 * lane + 256 * j;
            const v4f gg = *(const v4f*)(g + c), sh = *(const v4f*)(mrow + jshift * DM + c), sc = *(const v4f*)(mrow + jscale * DM + c);
            const v4f y = v[j] * rstd * gg * (1.f + sc) + sh;
            v2u w; w.x = pk2(y.x, y.y); w.y = pk2(y.z, y.w);
            *(v2u*)(H + (size_t)m * DM + c) = w; }
    }
}
__device__ __forceinline__ void qknorm_phase(const bf16* PROJ, bf16* QN, bf16* KN, const float* qg, const float* kg, const float* rcos, const float* rsin, int gw, int NGW, int lane) {
    const float qg0 = qg[2 * lane], qg1 = qg[2 * lane + 1], kg0 = kg[2 * lane], kg1 = kg[2 * lane + 1];
#pragma unroll 1
    for (int m0 = 4 * gw; m0 < R; m0 += 4 * NGW) {
        unsigned w2[4][10];
#pragma unroll
        for (int rr = 0; rr < 4; ++rr)
#pragma unroll
            for (int hh = 0; hh < 10; ++hh) w2[rr][hh] = *(const unsigned*)(PROJ + (size_t)(m0 + rr) * INC + hh * 128 + 2 * lane);
#pragma unroll
        for (int rr = 0; rr < 4; ++rr) {
            const int m = m0 + rr, b = m / TB, t = m - b * TB; const bool lat = t < SEQ;
            float cs = 1.f, sn = 0.f;
            if (lat) { const int pos = (lane < 32) ? (t >> 6) : (t & 63); cs = rcos[pos * 32 + (lane & 31)]; sn = rsin[pos * 32 + (lane & 31)]; }
#pragma unroll
            for (int hh = 0; hh < 10; ++hh) {
                const float x1 = bf2f(w2[rr][hh] & 0xffffu), x2 = bf2f(w2[rr][hh] >> 16);
                const float rstd = __builtin_amdgcn_rsqf(wave_sum(x1 * x1 + x2 * x2) * (1.f / 128.f) + EPS);
                const float y1 = x1 * rstd * (hh < 8 ? qg0 : kg0), y2 = x2 * rstd * (hh < 8 ? qg1 : kg1);
                const float o1 = y1 * cs - y2 * sn, o2 = y1 * sn + y2 * cs;
                bf16* dst = hh < 8 ? QN + (size_t)m * 1024 + hh * 128 + 2 * lane : KN + (size_t)m * 256 + (hh - 8) * 128 + 2 * lane;
                *(unsigned*)dst = cvtpk_rne(o1, o2);
            }
        }
    }
}
typedef short hbf16x8 __attribute__((ext_vector_type(8)));
__device__ __forceinline__ v4f mfma_bf(v4u a, v4u b, v4f c) { return __builtin_amdgcn_mfma_f32_16x16x32_bf16(__builtin_bit_cast(hbf16x8, a), __builtin_bit_cast(hbf16x8, b), c, 0, 0, 0); }
__device__ __forceinline__ unsigned cvtpk_hw(float lo, float hi) { return cvtpk_rne(lo, hi); }
constexpr int SG_PB = 272;
__device__ __forceinline__ void sg_unit(int b, int n, int g, int l, const bf16* PROJ, bf16* MIX, const float* sgg, const float* sgw, const float* sgb, LAS unsigned char* Vt, int tid, int lane, int wave) {
    const int row0 = b * TB + n * 128, c4 = lane >> 4, l15 = lane & 15;
    v4u wf[4];
    {   const float* W = sgw + ((size_t)(l * 4 + g) * 128 + 16 * wave + l15) * 128 + 8 * c4;
#pragma unroll
        for (int ks = 0; ks < 4; ++ks) { const v4f a0 = *(const v4f*)(W + 32 * ks), a1 = *(const v4f*)(W + 32 * ks + 4);
            wf[ks].x = cvtpk_hw(a0.x, a0.y); wf[ks].y = cvtpk_hw(a0.z, a0.w); wf[ks].z = cvtpk_hw(a1.x, a1.y); wf[ks].w = cvtpk_hw(a1.z, a1.w); } }
    const size_t orow = (size_t)(row0 + 16 * wave + l15);
    v2u uraw[8];
#pragma unroll
    for (int dt = 0; dt < 8; ++dt) uraw[dt] = *(const v2u*)(PROJ + orow * INC + C_SU + g * 128 + 16 * dt + 4 * c4);
    const float bsv = sgb[(l * 4 + g) * 128 + 16 * wave + l15];
    {
        const int s = tid >> 2, q = tid & 3;
        const v4u* src = (const v4u*)(PROJ + (size_t)(row0 + s) * INC + C_SV + g * 128 + 32 * q);
        float ge[32]; float ss = 0.f;
#pragma unroll
        for (int i = 0; i < 4; ++i) { const v4u w = src[i];
#pragma unroll
            for (int e = 0; e < 4; ++e) { const float a0 = gelu_tanh(bf2f(w[e] & 0xffffu)), a1 = gelu_tanh(bf2f(w[e] >> 16)); ge[8 * i + 2 * e] = a0; ge[8 * i + 2 * e + 1] = a1; ss += a0 * a0 + a1 * a1; } }
        ss += __shfl_xor(ss, 1); ss += __shfl_xor(ss, 2);
        const float rstd = 1.0f / sqrtf(ss * (1.f / 128.f) + EPS);
        const float* gp = sgg + g * 128 + 32 * q;
#pragma unroll
        for (int i = 0; i < 32; ++i) *(LAS bf16*)(Vt + (32 * q + i) * SG_PB + 2 * s) = (bf16)(cvtpk_hw(ge[i] * rstd * gp[i], 0.f) & 0xffffu);
    }
    LDS_BAR();
#pragma unroll
    for (int dt = 0; dt < 8; ++dt) {
        v4f acc = (v4f){0.f, 0.f, 0.f, 0.f};
#pragma unroll
        for (int ks = 0; ks < 4; ++ks) acc = mfma_bf(*(const LAS v4u*)(Vt + (16 * dt + l15) * SG_PB + (32 * ks + 8 * c4) * 2), wf[ks], acc);
        const float u0 = gelu_tanh(bf2f(uraw[dt].x & 0xffffu)), u1 = gelu_tanh(bf2f(uraw[dt].x >> 16)), u2 = gelu_tanh(bf2f(uraw[dt].y & 0xffffu)), u3 = gelu_tanh(bf2f(uraw[dt].y >> 16));
        v2u o; o.x = cvtpk_hw(u0 * (acc[0] + bsv), u1 * (acc[1] + bsv)); o.y = cvtpk_hw(u2 * (acc[2] + bsv), u3 * (acc[3] + bsv));
        *(v2u*)(MIX + orow * DM + 1536 + g * 128 + 16 * dt + 4 * c4) = o;
    }
    LDS_BAR();
}

__device__ __forceinline__ int hg_row(int b, int dir, int P) {
    if (P < CTXL) return b * TB + SEQ + (dir ? CTXL - 1 - P : P);
    const int t = P - CTXL; return b * TB + (dir ? SEQ - 1 - t : t);
}
constexpr int NCH = 136, SCH = 17, NSC = NCH / SCH;
constexpr size_t WS_QF = 966 * MiB, WS_KF = 1000 * MiB, WS_VF = 1034 * MiB, WS_PF = 1068 * MiB, WS_DF = 1077 * MiB;
static_assert(WS_DF + (size_t)32 * NCH * 512 <= WS_GS, "fragment buffers inside the mixer-half scratch");
constexpr int PL_DD = 53248  , PL_T = 0, PL_QF = 4096, PL_KF = PL_QF + 8192, PL_VF = PL_KF + 8192, PL_PF = PL_VF + 8192, PL_QP = PL_PF + 2048, PL_KP1 = PL_QP + 8704, PL_KP0 = PL_KP1 + 8704;

__device__ __forceinline__ unsigned bf1(float x) { return cvtpk_hw(x, 0.f) & 0xffffu; }
__device__ __forceinline__ void hgrn_pre(int l, const bf16* PROJ, const float* LBS, unsigned char* QF, unsigned char* KF, unsigned char* VF, unsigned char* PF, float* DF, float* HS, float* HD,
                                         LAS unsigned char* L, int bx, int G, int tid, int lane, int wave) {
    const int kp = lane, jj = wave, c4 = lane >> 4, l15 = lane & 15;
    constexpr float LOG2E = 1.4426950408889634f, CLAMP2 = 115.f;
    LAS v2f* T = (LAS v2f*)(L + PL_T);
    unsigned zr[4], qr[4], vr[4];
#define PRE_LOAD(it_) do { const int ch_ = (it_) / NCH, ci_ = (it_) - ch_ * NCH, dir_ = ch_ & 1, bh_ = ch_ >> 1, h_ = bh_ & 3; \
        const bf16* pr_ = PROJ + (size_t)hg_row(bh_ >> 2, dir_, 32 * ci_ + 4 * jj) * INC + h_ * 128 + 2 * kp; const long st_ = dir_ ? -(long)INC : (long)INC; const int cf_ = dir_ ? C_HFB : C_HFF; \
        _Pragma("unroll") for (int i = 0; i < 4; ++i) { zr[i] = *(const unsigned*)(pr_ + cf_); qr[i] = *(const unsigned*)(pr_ + C_HQ); vr[i] = *(const unsigned*)(pr_ + C_HI); pr_ += st_; } } while (0)
#pragma unroll 1
    for (int s = bx; s < 32 * NSC; s += G) {
    v4f acc[8], dprod[8];
#pragma unroll
    for (int kt = 0; kt < 8; ++kt) { acc[kt] = (v4f){0.f, 0.f, 0.f, 0.f}; dprod[kt] = (v4f){1.f, 1.f, 1.f, 1.f}; }
    const int it0 = (s >> 3) * NCH + (s & 7) * SCH;
    PRE_LOAD(it0);
#pragma unroll 1
    for (int it = it0; it < it0 + SCH; ++it) {
        const int chain = it / NCH;
        const int dir = chain & 1, h = (chain >> 1) & 3;
        const v2f lb2 = *(const v2f*)(LBS + (dir * DEPTH + l) * 512 + h * 128 + 2 * kp);
        float cs[2][4], kk[2][4], qq[2][4];
#pragma unroll
        for (int i = 0; i < 4; ++i)
#pragma unroll
            for (int e = 0; e < 2; ++e) {
                float z = bf2f(e ? zr[i] >> 16 : zr[i] & 0xffffu); z = fminf(fmaxf(z, -40.f), 40.f);
                const float q = bf2f(e ? qr[i] >> 16 : qr[i] & 0xffffu);
                qq[e][i] = q * __builtin_amdgcn_rcpf(1.f + __builtin_amdgcn_exp2f(-q * LOG2E));
                const float lb = e ? lb2.y : lb2.x, oml = 1.f - lb;
                const float ez = __builtin_amdgcn_exp2f(-z * LOG2E), sg = __builtin_amdgcn_rcpf(1.f + ez);
                cs[e][i] = __builtin_amdgcn_logf(fmaxf(lb + oml * sg, 1e-30f)); kk[e][i] = oml * ez * sg;
            }
        v2u vfa, vfb;
        vfa.x = (vr[0] & 0xffffu) | (vr[1] << 16); vfa.y = (vr[2] & 0xffffu) | (vr[3] << 16);
        vfb.x = (vr[0] >> 16) | (vr[1] & 0xffff0000u); vfb.y = (vr[2] >> 16) | (vr[3] & 0xffff0000u);
        if (it + 1 < it0 + SCH) PRE_LOAD(it + 1);
#pragma unroll
        for (int e = 0; e < 2; ++e)
#pragma unroll
            for (int i = 1; i < 4; ++i) cs[e][i] += cs[e][i - 1];
        T[jj * 64 + kp] = (v2f){cs[0][3], cs[1][3]};
        LDS_BAR();
        v2f pre = (v2f){0.f, 0.f}, bend = pre, b15 = pre;
#pragma unroll
        for (int w = 0; w < 8; ++w) { const v2f t = T[w * 64 + kp]; bend += t; if (w < 4) b15 += t; if (w < jj) pre += t; }
        LAS unsigned char* qfp = L + PL_QF + (((jj >> 2) * 4 + (kp >> 4)) * 64 + ((kp >> 1) & 3) * 16 + 4 * (jj & 3)) * 16 + (4 * ((kp >> 3) & 1) + 2 * (kp & 1)) * 2;
        LAS unsigned char* qpp = L + PL_QP + (4 * jj) * 272 + 4 * kp;
        float kh[2][4];
#pragma unroll
        for (int i = 0; i < 4; ++i) {
            float qt[2], qp[2], kp1[2], kp0[2];
#pragma unroll
            for (int e = 0; e < 2; ++e) {
                const float bi = (e ? pre.y : pre.x) + cs[e][i], be = e ? bend.y : bend.x, bm = e ? b15.y : b15.x;
                qt[e] = qq[e][i] * __builtin_amdgcn_exp2f(bi);
                kh[e][i] = kk[e][i] * __builtin_amdgcn_exp2f(be - bi);
                qp[e] = (jj < 4) ? qt[e] : qq[e][i] * __builtin_amdgcn_exp2f(bi - bm);
                kp1[e] = kk[e][i] * __builtin_amdgcn_exp2f(fminf(bm - bi, CLAMP2));
                kp0[e] = (jj < 4) ? kk[e][i] * __builtin_amdgcn_exp2f(fminf(-bi, CLAMP2)) : 0.f;
            }
            *(LAS unsigned*)(qfp + i * 16) = cvtpk_hw(qt[0], qt[1]);
            *(LAS unsigned*)(qpp + i * 272) = cvtpk_hw(qp[0], qp[1]);
            *(LAS unsigned*)(qpp + (PL_KP1 - PL_QP) + i * 272) = cvtpk_hw(kp1[0], kp1[1]);
            if (jj < 4) *(LAS unsigned*)(qpp + (PL_KP0 - PL_QP) + i * 272) = cvtpk_hw(kp0[0], kp0[1]);
        }
        {
            const int ka = 2 * kp, fo = ((ka >> 4) * 64 + (jj >> 1) * 16 + (ka & 15)) * 16 + 8 * (jj & 1);
            v2u w0, w1; w0.x = cvtpk_hw(kh[0][0], kh[0][1]); w0.y = cvtpk_hw(kh[0][2], kh[0][3]); w1.x = cvtpk_hw(kh[1][0], kh[1][1]); w1.y = cvtpk_hw(kh[1][2], kh[1][3]);
            *(LAS v2u*)(L + PL_KF + fo) = w0; *(LAS v2u*)(L + PL_KF + fo + 16) = w1;
            *(LAS v2u*)(L + PL_VF + fo) = vfa; *(LAS v2u*)(L + PL_VF + fo + 16) = vfb; }
        if (jj == 0) { const v2f dd = (v2f){__builtin_amdgcn_exp2f(bend.x), __builtin_amdgcn_exp2f(bend.y)}; *(v2f*)(DF + (size_t)it * 128 + 2 * kp) = dd; *(LAS v2f*)(L + PL_DD + 8 * kp) = dd; }
        LDS_BAR();
        if (wave < 3) {
            const LAS unsigned char* qa = L + PL_QP + ((wave == 0 ? 0 : 16) + l15) * 272 + c4 * 16;
            const LAS unsigned char* kb = (wave == 0 ? L + PL_KP0 + l15 * 272 : L + PL_KP1 + ((wave == 2 ? 16 : 0) + l15) * 272) + c4 * 16;
            v4f p = (v4f){0.f, 0.f, 0.f, 0.f};
#pragma unroll
            for (int s = 0; s < 4; ++s) p = mfma_bf(*(const LAS v4u*)(qa + s * 64), *(const LAS v4u*)(kb + s * 64), p);
            const int mt = wave == 0 ? 0 : 1, sidx = (wave == 2 ? 16 : 0) + l15;
#pragma unroll
            for (int r = 0; r < 4; ++r) { const int tl = 4 * c4 + r; const float v = (wave == 1 || l15 <= tl) ? p[r] : 0.f;
                *(LAS bf16*)(L + PL_PF + (mt * 64 + (sidx >> 3) * 16 + tl) * 16 + (sidx & 7) * 2) = (bf16)bf1(v); }
        } else if (wave == 3) {
            if (lane < 32) { unsigned zz; asm volatile("v_mov_b32 %0, 0" : "=v"(zz)); *(LAS v4u*)(L + PL_PF + (32 + lane) * 16) = (v4u){zz, zz, zz, zz}; }
        }
        LDS_BAR();
        if ((s & 7) < NSC - 1) {
            const v4u vfr = *(const LAS v4u*)(L + PL_VF + (wave * 64 + lane) * 16);
#pragma unroll
            for (int kt = 0; kt < 8; ++kt) { const v4f d = *(const LAS v4f*)(L + PL_DD + (16 * kt + 4 * c4) * 4);
                acc[kt] = acc[kt] * d; acc[kt] = mfma_bf(*(const LAS v4u*)(L + PL_KF + (kt * 64 + lane) * 16), vfr, acc[kt]); dprod[kt] = dprod[kt] * d; }
        }
        *(v4u*)(QF + (size_t)it * 8192 + tid * 16) = *(const LAS v4u*)(L + PL_QF + tid * 16);
        *(v4u*)(KF + (size_t)it * 8192 + tid * 16) = *(const LAS v4u*)(L + PL_KF + tid * 16);
        *(v4u*)(VF + (size_t)it * 8192 + tid * 16) = *(const LAS v4u*)(L + PL_VF + tid * 16);
        if (tid < 128) *(v4u*)(PF + (size_t)it * 2048 + tid * 16) = *(const LAS v4u*)(L + PL_PF + tid * 16);
    }
    if ((s & 7) < NSC - 1) {
        float* slot = HS + (size_t)s * 16384;
#pragma unroll
        for (int kt = 0; kt < 8; ++kt)
#pragma unroll
            for (int r = 0; r < 4; ++r) slot[(16 * kt + 4 * c4 + r) * 128 + 16 * wave + l15] = acc[kt][r];
        if (wave == 0 && l15 == 0) {
#pragma unroll
            for (int kt = 0; kt < 8; ++kt) *(v4f*)(HD + (size_t)s * 128 + 16 * kt + 4 * c4) = dprod[kt];
        }
    }
    LDS_BAR();
    }
#undef PRE_LOAD
}
constexpr int HU_Q = 0, HU_K = 8192, HU_P = 16384, HU_D = 18432, HU_SLOT = 18944, HU_OT = 2 * HU_SLOT + 1024  ;
template <bool WITH_OUT>
__device__ __forceinline__ void hgrn_unit2(int chain, int sc, const unsigned char* QF, const unsigned char* KF, const unsigned char* VF, const unsigned char* PF, const float* DF,
                                           float* HS, float* HD, bf16* HO, LAS unsigned char* L, int tid, int lane, int wave) {
    static_assert(WITH_OUT, "the local-state recurrence lives in hgrn_pre now");
    const int dir = chain & 1, bh = chain >> 1, b = bh >> 2, h = bh & 3, c4 = lane >> 4, l15 = lane & 15;
    v4f acc[8];
    const size_t item0 = (size_t)chain * NCH + sc * SCH;
    v4u rq0, rk0, rp0, rd0, vf0, rq1, rk1, rp1, rd1, vf1, rq2, rk2, rp2, rd2, vf2, rq3, rk3, rp3, rd3, vf3, vf;
#define HU_LOAD(S_, it_) do { rq##S_ = *(const v4u*)(QF + (it_) * 8192 + tid * 16); rk##S_ = *(const v4u*)(KF + (it_) * 8192 + tid * 16); \
        if (tid < 128) rp##S_ = *(const v4u*)(PF + (it_) * 2048 + tid * 16); if (tid < 32) rd##S_ = *(const v4u*)((const unsigned char*)DF + (it_) * 512 + tid * 16); \
        vf##S_ = ((const v4u*)(VF + (it_) * 8192))[wave * 64 + lane]; } while (0)
#define HU_WRITE(S_, s_) do { LAS unsigned char* sl_ = L + (s_) * HU_SLOT; *(LAS v4u*)(sl_ + HU_Q + tid * 16) = rq##S_; *(LAS v4u*)(sl_ + HU_K + tid * 16) = rk##S_; \
        if (tid < 128) *(LAS v4u*)(sl_ + HU_P + tid * 16) = rp##S_; if (tid < 32) *(LAS v4u*)(sl_ + HU_D + tid * 16) = rd##S_; } while (0)
#define HU_FLUSH(step_) do { const int t_ = tid >> 4; const int row_ = hg_row(b, dir, 32 * (sc * SCH + (step_)) + t_); \
        *(v4u*)(HO + ((size_t)dir * R + row_) * 512 + h * 128 + 8 * (tid & 15)) = *(const LAS v4u*)(L + HU_OT + ((step_) & 1) * 8192 + tid * 16); } while (0)
#define HU_COMPUTE(step_) do { const LAS unsigned char* sl = L + ((step_) & 1) * HU_SLOT; \
        v4u sb[4]; \
        _Pragma("unroll") for (int ks = 0; ks < 4; ++ks) { sb[ks].x = cvtpk_hw(acc[2 * ks][0], acc[2 * ks][1]); sb[ks].y = cvtpk_hw(acc[2 * ks][2], acc[2 * ks][3]); \
            sb[ks].z = cvtpk_hw(acc[2 * ks + 1][0], acc[2 * ks + 1][1]); sb[ks].w = cvtpk_hw(acc[2 * ks + 1][2], acc[2 * ks + 1][3]); } \
        _Pragma("unroll") for (int mt = 0; mt < 2; ++mt) { \
            v4f o = (v4f){0.f, 0.f, 0.f, 0.f}; \
            _Pragma("unroll") for (int ks = 0; ks < 4; ++ks) o = mfma_bf(*(const LAS v4u*)(sl + HU_Q + ((mt * 4 + ks) * 64 + lane) * 16), sb[ks], o); \
            o = mfma_bf(*(const LAS v4u*)(sl + HU_P + (mt * 64 + lane) * 16), vf, o); \
            _Pragma("unroll") for (int r = 0; r < 4; ++r) *(LAS bf16*)(L + HU_OT + ((step_) & 1) * 8192 + ((16 * mt + 4 * c4 + r) * 128 + 16 * wave + l15) * 2) = (bf16)bf1(o[r]); } \
        _Pragma("unroll") for (int kt = 0; kt < 8; ++kt) { const v4f d = *(const LAS v4f*)(sl + HU_D + (16 * kt + 4 * c4) * 4); \
            acc[kt] = acc[kt] * d; acc[kt] = mfma_bf(*(const LAS v4u*)(sl + HU_K + (kt * 64 + lane) * 16), vf, acc[kt]); } } while (0)
    HU_LOAD(0, item0);
    HU_LOAD(1, item0 + 1);
    HU_LOAD(2, item0 + 2);
    if (sc > 0) {
        const float* slot = HS + (size_t)(chain * NSC + sc - 1) * 16384;
#pragma unroll
        for (int kt = 0; kt < 8; ++kt)
#pragma unroll
            for (int r = 0; r < 4; ++r) acc[kt][r] = slot[(16 * kt + 4 * c4 + r) * 128 + 16 * wave + l15];
    } else {
#pragma unroll
        for (int kt = 0; kt < 8; ++kt) acc[kt] = (v4f){0.f, 0.f, 0.f, 0.f};
    }
    HU_WRITE(0, 0); vf = vf0;
    LDS_BAR();
#define HU_STEP(s_, SL_, SW_) do { if ((s_) < SCH) { if ((s_) + 3 < SCH) HU_LOAD(SL_, item0 + (s_) + 3); if ((s_) > 0) HU_FLUSH((s_) - 1); HU_COMPUTE(s_); \
        if ((s_) + 1 < SCH) { HU_WRITE(SW_, ((s_) + 1) & 1); vf = vf##SW_; } LDS_BAR(); } } while (0)
#pragma unroll 1
    for (int step = 0; step < SCH; step += 4) { HU_STEP(step, 3, 1); HU_STEP(step + 1, 0, 2); HU_STEP(step + 2, 1, 3); HU_STEP(step + 3, 2, 0); }
    HU_FLUSH(SCH - 1);
    LDS_BAR();
#undef HU_STEP
#undef HU_LOAD
#undef HU_WRITE
#undef HU_COMPUTE
#undef HU_FLUSH
    (void)HD;
}
__device__ __forceinline__ void hgrn_scan(float* HS, const float* HD, int gtid, int NT) {
    for (int e = gtid; e < 32 * 4096; e += NT) {
        const int chain = e >> 12, q4 = e & 4095, k = q4 >> 5;
        v4f* p = (v4f*)(HS + (size_t)chain * NSC * 16384) + q4; const float* dp = HD + chain * NSC * 128 + k;
        v4f tmp[NSC - 1]; float dd[NSC - 1];
#pragma unroll
        for (int s = 0; s < NSC - 1; ++s) { tmp[s] = p[(size_t)s * 4096]; dd[s] = dp[s * 128]; }
        v4f st = (v4f){0.f, 0.f, 0.f, 0.f};
#pragma unroll
        for (int s = 0; s < NSC - 1; ++s) { st = st * dd[s] + tmp[s]; p[(size_t)s * 4096] = st; }
    }
}
__device__ __forceinline__ void hg_combine(const bf16* HO, const bf16* PROJ, bf16* MIX, const float* hgg, bool skip_ctx, int gw, int NGW, int lane) {
    const float g0 = hgg[2 * lane], g1 = hgg[2 * lane + 1];
#pragma unroll 1
    for (int m0 = 4 * gw; m0 < R; m0 += 4 * NGW) {
        const int b = m0 / TB, t = m0 - b * TB; if (t >= SEQ && skip_ctx) continue;
        unsigned a[4][4], c[4][4], w2[4][4];
#pragma unroll
        for (int rr = 0; rr < 4; ++rr)
#pragma unroll
            for (int h = 0; h < 4; ++h) { const bf16* p0 = HO + (size_t)(m0 + rr) * 512 + h * 128 + 2 * lane;
                a[rr][h] = *(const unsigned*)p0; c[rr][h] = *(const unsigned*)(p0 + (size_t)R * 512);
                w2[rr][h] = *(const unsigned*)(PROJ + (size_t)(m0 + rr) * INC + C_HGT + h * 128 + 2 * lane); }
#pragma unroll
        for (int rr = 0; rr < 4; ++rr)
#pragma unroll
            for (int h = 0; h < 4; ++h) {
                const float o0 = bf2f(a[rr][h] & 0xffffu) + bf2f(c[rr][h] & 0xffffu), o1 = bf2f(a[rr][h] >> 16) + bf2f(c[rr][h] >> 16);
                const float rstd = __builtin_amdgcn_rsqf(wave_sum(o0 * o0 + o1 * o1) * (1.f / 128.f) + EPS);
                const float y0 = o0 * rstd * g0 * silu_f(bf2f(w2[rr][h] & 0xffffu)), y1 = o1 * rstd * g1 * silu_f(bf2f(w2[rr][h] >> 16));
                *(unsigned*)(MIX + (size_t)(m0 + rr) * DM + 1024 + h * 128 + 2 * lane) = cvtpk_rne(y0, y1);
            }
    }
}
__device__ __forceinline__ void conv_act_phase(const bf16* UP, bf16* ACT, const float* cw, const float* cb, bool skip_ctx, int gtid, int NT) {
    constexpr int NOCT = DFF / 8, NSTRIP = R / 32;
    for (int it = gtid; it < NSTRIP * NOCT; it += NT) {
        const int strip = it / NOCT, oc = it - strip * NOCT, wi = strip % (TB / 32), c0 = oc * 8;
        if (skip_ctx && wi >= SEQ / 32) continue;
        const bool seg_start = (wi == 0 || wi == SEQ / 32), seg_end = (wi == SEQ / 32 - 1 || wi == TB / 32 - 1);
        float w[2][3][8], bb[2][8];
#pragma unroll
        for (int hlf = 0; hlf < 2; ++hlf) {
#pragma unroll
            for (int jj = 0; jj < 3; ++jj) { const v4f a0 = *(const v4f*)(cw + (size_t)jj * UPC + hlf * DFF + c0), a1 = *(const v4f*)(cw + (size_t)jj * UPC + hlf * DFF + c0 + 4);
                w[hlf][jj][0] = a0.x; w[hlf][jj][1] = a0.y; w[hlf][jj][2] = a0.z; w[hlf][jj][3] = a0.w; w[hlf][jj][4] = a1.x; w[hlf][jj][5] = a1.y; w[hlf][jj][6] = a1.z; w[hlf][jj][7] = a1.w; }
            const v4f b0 = *(const v4f*)(cb + hlf * DFF + c0), b1 = *(const v4f*)(cb + hlf * DFF + c0 + 4);
            bb[hlf][0] = b0.x; bb[hlf][1] = b0.y; bb[hlf][2] = b0.z; bb[hlf][3] = b0.w; bb[hlf][4] = b1.x; bb[hlf][5] = b1.y; bb[hlf][6] = b1.z; bb[hlf][7] = b1.w;
        }
        const size_t r0 = (size_t)strip * 32;
#pragma unroll 1
        for (int sb = 0; sb < 4; ++sb) {
            v4u gr[10], vr[10];
#pragma unroll
            for (int j = 0; j < 10; ++j) {
                const bool zero = (j == 0 && sb == 0 && seg_start) || (j == 9 && sb == 3 && seg_end);
                if (!zero) { const size_t rr = r0 + 8 * sb + j - 1; gr[j] = *(const v4u*)(UP + rr * UPC + c0); vr[j] = *(const v4u*)(UP + rr * UPC + DFF + c0); }
                else { gr[j] = (v4u){0u, 0u, 0u, 0u}; vr[j] = gr[j]; }
            }
#pragma unroll
            for (int i = 0; i < 8; ++i) {
                v4u o;
#pragma unroll
                for (int q = 0; q < 4; ++q) {
                    float res[2];
#pragma unroll
                    for (int e = 0; e < 2; ++e) {
                        const int ci = 2 * q + e;
                        const float gp = e ? bf2f(gr[i][q] >> 16) : bf2f(gr[i][q] & 0xffffu), gc = e ? bf2f(gr[i + 1][q] >> 16) : bf2f(gr[i + 1][q] & 0xffffu), gn = e ? bf2f(gr[i + 2][q] >> 16) : bf2f(gr[i + 2][q] & 0xffffu);
                        const float vp = e ? bf2f(vr[i][q] >> 16) : bf2f(vr[i][q] & 0xffffu), vc = e ? bf2f(vr[i + 1][q] >> 16) : bf2f(vr[i + 1][q] & 0xffffu), vn = e ? bf2f(vr[i + 2][q] >> 16) : bf2f(vr[i + 2][q] & 0xffffu);
                        const float yg = bb[0][ci] + w[0][0][ci] * gp + w[0][1][ci] * gc + w[0][2][ci] * gn;
                        const float yv = bb[1][ci] + w[1][0][ci] * vp + w[1][1][ci] * vc + w[1][2][ci] * vn;
                        res[e] = silu_f(yg) * yv;
                    }
                    o[q] = cvtpk_rne(res[0], res[1]);
                }
                *(v4u*)(ACT + (r0 + 8 * sb + i) * DFF + c0) = o;
            }
        }
    }
}

__device__ __forceinline__ kptr_t kargs_fresh() { kptr_t p = (kptr_t)__builtin_amdgcn_kernarg_segment_ptr(); asm volatile("" : "+s"(p)); return p; }
#define KIN(i)  (*(const float* const AS4*)(kp + 8 * (i)))
#define KOUT()  (*(float* const AS4*)(kp + 176))
#define KWS()   (*(unsigned char* const AS4*)(kp + 184))
#define PH_BEGIN \
    int tid = threadIdx.x; asm volatile("" : "+v"(tid)); \
    const int lane = tid & 63, wave = __builtin_amdgcn_readfirstlane(tid >> 6); \
    int bx = blockIdx.x; asm volatile("" : "+s"(bx)); int G = gridDim.x; asm volatile("" : "+s"(G)); \
    const int gw = bx * NWAVES + wave, NGW = G * NWAVES, gtid = bx * NTHR + tid, NT = G * NTHR; \
    const kptr_t kp = kargs_fresh(); unsigned char* const ws = KWS(); \
    (void)lane; (void)gw; (void)NGW; (void)gtid; (void)NT; (void)ws;

template <int SEL>
__device__ __forceinline__ void convert_item(int l, int r, kptr_t kp, unsigned char* ws, LAS float* scr, int lane) {
    unsigned char* wb = ws + WS_W + (size_t)l * W_LAYER; const float* MOD = (const float*)(ws + WS_MOD) + (size_t)l * 5 * NMODC;
    if (SEL & 1) { if (r < CI_IN) { p0_transpose_item<true>(KIN(I_WIN) + (size_t)l * DM * INC, DM, INC, (bf16*)(wb + W_IN), scr, r, lane, (float*)(ws + WS_SWIN) + (size_t)l * 5 * INC, MOD + 0 * DM); return; } r -= CI_IN; }
    if (SEL & 2) { if (r < CI_OUT) { p0_transpose_item<false>(KIN(I_WOUT) + (size_t)l * DM * DM, DM, DM, (bf16*)(wb + W_OUT), scr, r, lane, nullptr, nullptr); return; } r -= CI_OUT; }
    if (SEL & 4) { if (r < CI_UP) { p0_transpose_item<true>(KIN(I_WUP) + (size_t)l * DM * UPC, DM, UPC, (bf16*)(wb + W_UP), scr, r, lane, (float*)(ws + WS_SWUP) + (size_t)l * 5 * UPC, MOD + 3 * DM); return; } r -= CI_UP; }
    if (SEL & 8) { p0_transpose_item<false>(KIN(I_WDN) + (size_t)l * DFF * DM, DFF, DM, (bf16*)(wb + W_DN), scr, r, lane, nullptr, nullptr); }
}

__global__ void __launch_bounds__(NTHR, 2) mk_fwd(Args a_unused) {
    extern __shared__ __attribute__((aligned(16))) unsigned char lds[];
    LAS unsigned char* ldsp = (LAS unsigned char*)lds;
    int lo, hi;
    { const kptr_t kp = kargs_fresh(); lo = *(const int AS4*)(kp + 192); hi = *(const int AS4*)(kp + 196); }
    for (int u = threadIdx.x; u < (LDS_BYTES - LDSCTL_OFF) / 4; u += NTHR) ((LAS unsigned*)(ldsp + LDSCTL_OFF))[u] = 0u;
    __syncthreads();
#if MK_ONE_LAUNCH
    XcdBarrier bar;
    { const kptr_t kp = kargs_fresh(); bar = xcd_barrier_post((unsigned*)(KWS() + WS_CTL) + CW_BAR, (volatile LAS unsigned*)(ldsp + MISC_OFF) + 8); }
#define GRID_BAR() xcd_barrier(bar)
#else
#define GRID_BAR() do { } while (0)
#endif
#define IN(k) (lo <= (k) && (k) < hi)

    if (IN(0)) {
        PH_BEGIN
        float* MOD = (float*)(ws + WS_MOD);
        p0_mod(KIN(I_C), KIN(I_CCTX), KIN(I_WADA), KIN(I_BADA), ldsp, MOD, tid, lane, wave, bx, G);
        if (bx == G - 1) {
            float* LBS = (float*)(ws + WS_MISC); float* RCOS = (float*)(ws + WS_MISC + 16384); float* RSIN = (float*)(ws + WS_MISC + 24576);
            const float* lbp = KIN(I_LBP);
            for (int i = tid; i < 1024; i += NTHR) { const int dir = i >> 9, ci = i & 511; float v[DEPTH], mx = -3.0e38f;
#pragma unroll
                for (int l = 0; l < DEPTH; ++l) { v[l] = lbp[(dir * DEPTH + l) * 512 + ci]; mx = fmaxf(mx, v[l]); }
                float s = 0.f;
#pragma unroll
                for (int l = 0; l < DEPTH; ++l) { v[l] = expf(v[l] - mx); s += v[l]; }
                float cum = 0.f;
#pragma unroll
                for (int l = 0; l < DEPTH; ++l) { if (l > 0) cum += v[l] / s; LBS[(dir * DEPTH + l) * 512 + ci] = cum; } }
            for (int i = tid; i < 2048; i += NTHR) { const int pos = i >> 5, fi = i & 31; const float inv = powf(10000.f, -(float)fi / 32.f); const float ang = (float)pos * inv; RCOS[i] = cosf(ang); RSIN[i] = sinf(ang); }
        }
        __syncthreads();
        {
            LAS float* scr = (LAS float*)(ldsp + wave * 16384);
            for (int it = gw; it < convert_count<2 | 8>(); it += NGW) convert_item<2 | 8>(0, it, kp, ws, scr, lane);
        }
        GRID_BAR();
    }

    if (IN(1)) { PH_BEGIN
        const float* MOD = (const float*)(ws + WS_MOD);
        {
            const float* xin = KIN(I_X); const float* cin = KIN(I_CTX); bf16* H = (bf16*)(ws + WS_H); float* RS0 = (float*)(ws + WS_RS); const float* g = KIN(I_N1G);
            for (int m0 = 2 * gw; m0 < R; m0 += 2 * NGW) {
                v4f v[2][8];
#pragma unroll
                for (int rr = 0; rr < 2; ++rr) { const int m = m0 + rr, b = m / TB, t = m - b * TB;
                    const v4f* xr = (const v4f*)(t < SEQ ? xin + ((size_t)b * SEQ + t) * DM : cin + ((size_t)b * CTXL + (t - SEQ)) * DM) + lane;
#pragma unroll
                    for (int j = 0; j < 8; ++j) v[rr][j] = xr[64 * j]; }
#pragma unroll
                for (int rr = 0; rr < 2; ++rr) { const int m = m0 + rr, b = m / TB, t = m - b * TB; const float* mrow = MOD + (size_t)(t >= SEQ ? 4 : b) * NMODC; float ss = 0.f;
#pragma unroll
                    for (int j = 0; j < 8; ++j) { const v4f x = v[rr][j]; ss += (x.x * x.x + x.y * x.y) + (x.z * x.z + x.w * x.w); const int c = 4 * lane + 256 * j;
                        const v4f y = x * *(const v4f*)(g + c) * (1.f + *(const v4f*)(mrow + 1 * DM + c));
                        v2u w; w.x = cvtpk_rne(y.x, y.y); w.y = cvtpk_rne(y.z, y.w); *(v2u*)(H + (size_t)m * DM + c) = w; }
                    ss = wave_sum(ss); if (lane == 0) RS0[m] = ss; }
            } }
        {
            float* GS = (float*)(ws + WS_GS); const float* g1 = KIN(I_N1G); const float* g2 = KIN(I_N2G);
            for (int i = gtid; i < DEPTH * 2 * 5 * DM; i += NT) { const int c = i & (DM - 1), r = (i >> 11) % 5, wl = i / (5 * DM), which = wl & 1, l = wl >> 1;
                GS[i] = (which ? g2 : g1)[l * DM + c] * (1.f + MOD[(size_t)(l * 5 + r) * NMODC + (which ? 4 : 1) * DM + c]); } }
        {
            LAS float* scr = (LAS float*)(ldsp + wave * 16384);
            for (int it = gw; it < convert_count<1 | 4>(); it += NGW) convert_item<1 | 4>(0, it, kp, ws, scr, lane);
        }
        GRID_BAR();
    }

#pragma unroll 1
    for (int l = 0; l < DEPTH; ++l) {
        const int pb = 2 + 9 * l; const bool last = (l == DEPTH - 1);
#define MODL ((const float*)(ws + WS_MOD) + (size_t)l * 5 * NMODC)
#define WB   (ws + WS_W + (size_t)l * W_LAYER)
#define RSL(s_) ((float*)(ws + WS_RS) + (size_t)(s_) * R)
#define GSL(l_, which_) ((const float*)(ws + WS_GS) + (size_t)((l_) * 2 + (which_)) * 5 * DM)
        if (IN(pb + 0)) { PH_BEGIN
            pg8::Gemm g{(const bf16*)(ws + WS_H), (const bf16*)(WB + W_IN), R, INC, DM}; TileOrder S; S.init2(INC, G, bx, false);
            EpiBf16N E{(bf16*)(ws + WS_PROJ), INC, RSL(2 * l), (const float*)(ws + WS_SWIN) + (size_t)l * 5 * INC};
            pg8::gemm_phase<EpiBf16N, TileOrder, true, true>(ldsp, g, S, E);
            GRID_BAR();
        }
        if (IN(pb + 1)) { PH_BEGIN
            const bf16* PROJ = (const bf16*)(ws + WS_PROJ);
            qknorm_phase(PROJ, (bf16*)(ws + WS_QN), (bf16*)(ws + WS_KN), KIN(I_QG) + l * 128, KIN(I_KG) + l * 128, (const float*)(ws + WS_MISC + 16384), (const float*)(ws + WS_MISC + 24576), gw, NGW, lane);
            {   const int nch = last ? 32 : 34, nU = NB * nch * 4;
                for (int u = bx; u < nU; u += G) { const int g = u & 3, bn = u >> 2, b = bn / nch, n = bn - b * nch;
                    sg_unit(b, n, g, l, PROJ, (bf16*)(ws + WS_MIX), KIN(I_SGG) + l * 512, KIN(I_SGW), KIN(I_SGB), ldsp, tid, lane, wave); } }
            hgrn_pre(l, PROJ, (const float*)(ws + WS_MISC), ws + WS_QF, ws + WS_KF, ws + WS_VF, ws + WS_PF, (float*)(ws + WS_DF), (float*)(ws + WS_HS), (float*)(ws + WS_HD), ldsp, bx, G, tid, lane, wave);
            GRID_BAR();
        }
        if (IN(pb + 2)) { PH_BEGIN
            hgrn_scan((float*)(ws + WS_HS), (const float*)(ws + WS_HD), gtid, NT);
            const int nU = last ? 512 : 544;
            for (int u = bx; u < nU; u += G) {
                int b, hq, row_q, row_k, seq;
                if (u < 512) { const int xcd = u & 7, idx = u >> 3; b = xcd >> 1; hq = (xcd & 1) * 4 + (idx >> 4); row_k = b * TB; row_q = row_k + (idx & 15) * 256; seq = TB; }
                else { const int uc = u - 512; b = uc >> 3; hq = uc & 7; row_k = b * TB + SEQ; row_q = row_k; seq = CTXL; }
                const int kvh = hq >> 2;
                att::attn_dense_body((const bf16*)(ws + WS_QN) + (size_t)row_q * 1024 + hq * 128, (const bf16*)(ws + WS_KN) + (size_t)row_k * 256 + kvh * 128,
                                     (const bf16*)(ws + WS_PROJ) + (size_t)row_k * INC + C_AV + kvh * 128, (bf16*)(ws + WS_MIX) + (size_t)row_q * DM + hq * 128, seq, (char*)lds);
            }
            GRID_BAR();
        }
        if (IN(pb + 3)) { PH_BEGIN
            for (int u = bx; u < 32 * NSC; u += G) hgrn_unit2<true>(u & 31, u >> 5, ws + WS_QF, ws + WS_KF, ws + WS_VF, ws + WS_PF, (const float*)(ws + WS_DF), (float*)(ws + WS_HS), (float*)(ws + WS_HD), (bf16*)(ws + WS_HO), ldsp, tid, lane, wave);
            GRID_BAR();
        }
        if (IN(pb + 4)) { PH_BEGIN hg_combine((const bf16*)(ws + WS_HO), (const bf16*)(ws + WS_PROJ), (bf16*)(ws + WS_MIX), KIN(I_HGG) + l * 128, last, gw, NGW, lane); GRID_BAR(); }
        if (IN(pb + 5)) { PH_BEGIN
            pg8::Gemm g{(const bf16*)(ws + WS_MIX), (const bf16*)(WB + W_OUT), R, DM, DM};
            {   TileOrder S; S.init2(DM, G, bx, true);
                EpiResGate<true> E{(float*)(ws + WS_X), MODL, 2, (bf16*)(ws + WS_H), GSL(l, 1), RSL(2 * l + 1), l == 0 ? KIN(I_X) : nullptr, l == 0 ? KIN(I_CTX) : nullptr};
                pg8::gemm_phase<EpiResGate<true>, TileOrder, true, true>(ldsp, g, S, E); }
            if (!last) {
                const int nh = (G >= 64) ? 64 : G;
                __syncthreads();
                if (bx < nh) { CtxHalfOrder S{DM / 256, nh, bx};
                    EpiResGate<true, true> E{(float*)(ws + WS_X), MODL, 2, (bf16*)(ws + WS_H), GSL(l, 1), RSL(2 * l + 1), l == 0 ? KIN(I_X) : nullptr, l == 0 ? KIN(I_CTX) : nullptr};
                    pg8::gemm_phase<EpiResGate<true, true>, CtxHalfOrder, true, true>(ldsp, g, S, E); }
                const int nfull = (G > 64) ? 64 : 0; LAS float* scr = (LAS float*)(ldsp + wave * 16384);
                if (bx >= nfull) for (int it = (bx - nfull) * NWAVES + wave; it < convert_count<1 | 2>(); it += (G - nfull) * NWAVES) convert_item<1 | 2>(l + 1, it, kp, ws, scr, lane);
            }
            GRID_BAR();
        }
        if (IN(pb + 6)) { PH_BEGIN
            pg8::Gemm g{(const bf16*)(ws + WS_H), (const bf16*)(WB + W_UP), R, UPC, DM}; TileOrder S; S.init2(UPC, G, bx, last);
            EpiBf16N E{(bf16*)(ws + WS_UP), UPC, RSL(2 * l + 1), (const float*)(ws + WS_SWUP) + (size_t)l * 5 * UPC};
            pg8::gemm_phase<EpiBf16N, TileOrder, true, true>(ldsp, g, S, E);
            GRID_BAR();
        }
        if (IN(pb + 7)) { PH_BEGIN conv_act_phase((const bf16*)(ws + WS_UP), (bf16*)(ws + WS_ACT), KIN(I_CW) + (size_t)l * 3 * UPC, KIN(I_CB) + (size_t)l * UPC, last, gtid, NT); GRID_BAR(); }
        if (IN(pb + 8)) { PH_BEGIN
            pg8::Gemm g{(const bf16*)(ws + WS_ACT), (const bf16*)(WB + W_DN), R, DM, DFF}; TileOrder S; S.init2(DM, G, bx, true);
            if (!last) {
                {   EpiResGate<true> E{(float*)(ws + WS_X), MODL, 5, (bf16*)(ws + WS_H), GSL(l + 1, 0), RSL(2 * l + 2), nullptr, nullptr};
                    pg8::gemm_phase<EpiResGate<true>, TileOrder, true, true>(ldsp, g, S, E); }
                const int nh = (G >= 64) ? 64 : G;
                __syncthreads();
                if (bx < nh) { CtxHalfOrder S2{DM / 256, nh, bx};
                    EpiResGate<true, true> E2{(float*)(ws + WS_X), MODL, 5, (bf16*)(ws + WS_H), GSL(l + 1, 0), RSL(2 * l + 2), nullptr, nullptr};
                    pg8::gemm_phase<EpiResGate<true, true>, CtxHalfOrder, true, true>(ldsp, g, S2, E2); }
                const int nfull = (G > 64) ? 64 : 0; LAS float* scr = (LAS float*)(ldsp + wave * 16384);
                if (bx >= nfull) for (int it = (bx - nfull) * NWAVES + wave; it < convert_count<4 | 8>(); it += (G - nfull) * NWAVES) convert_item<4 | 8>(l + 1, it, kp, ws, scr, lane);
            } else { EpiResGate<false> E{(float*)(ws + WS_X), MODL, 5, nullptr, nullptr, nullptr, nullptr, nullptr};
                pg8::gemm_phase<EpiResGate<false>, TileOrder, true, true>(ldsp, g, S, E); }
            GRID_BAR();
        }
    }
    if (IN(NPHASE - 1)) { PH_BEGIN
        const float* g = KIN(I_FNG); const float* X = (const float*)(ws + WS_X); float* out = KOUT();
        for (int m0 = 2 * gw; m0 < NB * SEQ; m0 += 2 * NGW) {
            v4f v[2][8];
#pragma unroll
            for (int rr = 0; rr < 2; ++rr) { const int m = m0 + rr, b = m >> 12, t = m & 4095; const v4f* xr = (const v4f*)(X + (size_t)(b * TB + t) * DM) + lane;
#pragma unroll
                for (int j = 0; j < 8; ++j) v[rr][j] = xr[64 * j]; }
#pragma unroll
            for (int rr = 0; rr < 2; ++rr) { float ss = 0.f;
#pragma unroll
                for (int j = 0; j < 8; ++j) ss += (v[rr][j].x * v[rr][j].x + v[rr][j].y * v[rr][j].y) + (v[rr][j].z * v[rr][j].z + v[rr][j].w * v[rr][j].w);
                const float rstd = __builtin_amdgcn_rsqf(wave_sum(ss) * (1.f / DM) + EPS);
                v4f* orow = (v4f*)(out + (size_t)(m0 + rr) * DM) + lane;
#pragma unroll
                for (int j = 0; j < 8; ++j) orow[64 * j] = v[rr][j] * rstd * *(const v4f*)(g + 4 * lane + 256 * j); }
        }
    }
#undef IN
}

extern "C" void kernel_launch(void* const* d_in, const int* in_sizes, int n_in, void* d_out, int out_size, void* d_ws, size_t ws_size, hipStream_t stream) {
    static int grid = 0;
    if (grid == 0) {
        if (n_in != 22 || in_sizes[0] != NB * SEQ * DM || out_size != NB * SEQ * DM || ws_size < WS_END) {
            fprintf(stderr, "kernel_launch: unexpected shapes (n_in %d in0 %d out %d ws %zu, need ws >= %zu); nothing launched\n", n_in, n_in > 0 ? in_sizes[0] : -1, out_size, ws_size, (size_t)WS_END); grid = -1; return; }
        int dev = 0, cus = 0, per_cu = 0;
        if (hipGetDevice(&dev) != hipSuccess || hipDeviceGetAttribute(&cus, hipDeviceAttributeMultiprocessorCount, dev) != hipSuccess) { grid = -1; return; }
        if (hipFuncSetAttribute((const void*)mk_fwd, hipFuncAttributeMaxDynamicSharedMemorySize, LDS_BYTES) != hipSuccess) { fprintf(stderr, "kernel_launch: hipFuncSetAttribute failed\n"); grid = -1; return; }
        if (hipOccupancyMaxActiveBlocksPerMultiprocessor(&per_cu, (const void*)mk_fwd, NTHR, LDS_BYTES) != hipSuccess || per_cu < 1)
            fprintf(stderr, "kernel_launch: note: occupancy query reports %d workgroups per CU\n", per_cu);
        (void)hipGetLastError();
        grid = cus;
    }
    if (grid < 0) return;
    if (hipMemsetAsync((char*)d_ws + WS_CTL, 0, CTL_ZERO_BYTES, stream) != hipSuccess) return;
    Args a{};
    for (int i = 0; i < 22; ++i) a.in[i] = (const float*)d_in[i];
    a.out = (float*)d_out; a.ws = (unsigned char*)d_ws;
#if MK_ONE_LAUNCH
    a.ph_lo = 0; a.ph_hi = NPHASE;
    hipLaunchKernelGGL(mk_fwd, dim3(grid), dim3(NTHR), LDS_BYTES, stream, a);
#else
    for (int p = 0; p < NPHASE; ++p) { a.ph_lo = p; a.ph_hi = p + 1; hipLaunchKernelGGL(mk_fwd, dim3(grid), dim3(NTHR), LDS_BYTES, stream, a); }
#endif
    const hipError_t le = hipPeekAtLastError();
    if (le != hipSuccess) fprintf(stderr, "kernel_launch: launch failed: %s\n", hipGetErrorName(le));
}
```

```cpp
#include <hip/hip_runtime.h>
#include <cstdio>
#include <cstdint>
#ifndef MK_ONE_LAUNCH
#define MK_ONE_LAUNCH 1
#endif
namespace pg8 {
#define PG8_LAS __attribute__((address_space(3)))
typedef unsigned short bf16_t;
typedef short bf16x8 __attribute__((ext_vector_type(8)));
typedef float f32x4 __attribute__((ext_vector_type(4)));
typedef unsigned u32x4 __attribute__((ext_vector_type(4)));
constexpr int BM = 256, BK = 64, HALF = 128, HTB = HALF * BK * 2  , STAGE_BYTES = 8 * HTB, NXCD = 8, WGM = 4;

__host__ __device__ __forceinline__ int lds_byte(int r, int c) { const int st = (r >> 4) * 2 + (c >> 5), rr = r & 15, cc = c & 31, ob = rr * 64 + cc * 2; return st * 1024 + (ob ^ (((ob >> 9) & 1) << 5)); }
__host__ __device__ __forceinline__ void stage_rc(int b, int& R, int& C) { const int st = b / 1024, sb = b % 1024, swz = sb ^ (((sb >> 9) & 1) << 5); R = (st >> 1) * 16 + swz / 64; C = (st & 1) * 32 + (swz % 64) / 2; }
__host__ __device__ __forceinline__ int perm32(int rho) { const int n = rho >> 4, i = rho & 15; return 8 * (i >> 2) + 4 * n + (i & 3); }

struct Unit { int pm, pn, hn; };
struct Gemm { const bf16_t* A; const bf16_t* Bt; int M, N, K; };

struct StaticOrder {
    int nM, nN, nwg, G, c;
    __host__ __device__ void init(int M, int N, int G_, int c_) { nM = M / BM; nN = N / BM; nwg = nM * nN; G = G_; c = c_; }
    __host__ __device__ bool next(int i, Unit& u) const {
        const long L = (long)i * G + c; if (L >= nwg) return false;
        int wgid = (int)L; { const int q = nwg / NXCD, r = nwg % NXCD, xcd = wgid % NXCD, off = wgid / NXCD; wgid = (xcd < r ? xcd * (q + 1) : r * (q + 1) + (xcd - r) * q) + off; }
        const int nig = WGM * nN, gid = wgid / nig, fm = gid * WGM, gsz = (nM - fm) < WGM ? (nM - fm) : WGM;
        u.pm = fm + ((wgid % nig) % gsz); u.pn = (wgid % nig) / gsz; u.hn = 0; return true;
    }
    __device__ __forceinline__ void a_ready(const Unit&) const {}
    __device__ __forceinline__ void done(const Unit&) const {}
};

__device__ __forceinline__ unsigned cvt_pk_bf16(float lo, float hi) { unsigned r; asm volatile("v_cvt_pk_bf16_f32 %0, %1, %2" : "=v"(r) : "v"(lo), "v"(hi)); return r; }
typedef float f32x2 __attribute__((ext_vector_type(2)));
__device__ __forceinline__ f32x2 gelu_pk(f32x2 v) {
    const f32x2 av = __builtin_elementwise_abs(v), d = av * 0.2316418882f + 1.0f;
    f32x2 t; t.x = __builtin_amdgcn_rcpf(d.x); t.y = __builtin_amdgcn_rcpf(d.y);
    f32x2 q = t * 0.5307027145f + (-0.7265760135f); q = q * t + 0.7107068705f; q = q * t + (-0.142248368f); q = q * t + 0.127414796f; q = q * t;
    const f32x2 s = (v * v) * (-0.72134752044f);
    f32x2 e; e.x = __builtin_amdgcn_exp2f(s.x); e.y = __builtin_amdgcn_exp2f(s.y);
    const f32x2 m = v * (q * e), r = v - m;
    f32x2 o; o.x = v.x < 0.f ? m.x : r.x; o.y = v.y < 0.f ? m.y : r.y; return o;
}

template <int ACT  > struct EpiBf16 {
    static constexpr bool PERM = true, AFTER_DRAIN = false, HALF_N = false; static_assert(ACT == 0 || ACT == 1, "EpiBf16: ACT is 0 (none) or 1 (gelu_pk)");
    bf16_t* O; int ldc; const float* bias; int split_cols; size_t split_stride; float scale0;
    __device__ __forceinline__ void operator()(const f32x4 (&acc)[2][2][4][2], const Unit& u, int wr, int wc, int fr, int fq) const {
        const int row0 = u.pm * BM + wr * 64 + fr; int colt = u.pn * BM; bf16_t* base = O;
        float sc = 1.f; if (split_cols) { const int t = colt / split_cols; base += (size_t)t * split_stride; colt -= t * split_cols; if (t == 0) sc = scale0; }
        const int col0 = colt + wc * 32 + 8 * fq, bcol0 = u.pn * BM + wc * 32 + 8 * fq;
        f32x4 bv[2][2];
#pragma unroll
        for (int bj = 0; bj < 2; ++bj)
#pragma unroll
            for (int n = 0; n < 2; ++n) bv[bj][n] = bias ? *(const f32x4*)(bias + bcol0 + bj * HALF + 4 * n) : (f32x4){0.f, 0.f, 0.f, 0.f};
#pragma unroll
        for (int ai = 0; ai < 2; ++ai)
#pragma unroll
            for (int m = 0; m < 4; ++m) { bf16_t* rowp = base + (size_t)(row0 + ai * HALF + m * 16) * ldc + col0;
#pragma unroll
                for (int bj = 0; bj < 2; ++bj) { f32x4 v0 = acc[ai][bj][m][0] + bv[bj][0], v1 = acc[ai][bj][m][1] + bv[bj][1];
                    if (ACT == 1) { f32x2 a = gelu_pk((f32x2){v0[0], v0[1]}), b = gelu_pk((f32x2){v0[2], v0[3]}), c = gelu_pk((f32x2){v1[0], v1[1]}), d = gelu_pk((f32x2){v1[2], v1[3]});
                        v0 = (f32x4){a.x, a.y, b.x, b.y}; v1 = (f32x4){c.x, c.y, d.x, d.y}; }
                    v0 = v0 * sc; v1 = v1 * sc; u32x4 w; w.x = cvt_pk_bf16(v0[0], v0[1]); w.y = cvt_pk_bf16(v0[2], v0[3]); w.z = cvt_pk_bf16(v1[0], v1[1]); w.w = cvt_pk_bf16(v1[2], v1[3]);
                    *(u32x4*)(rowp + bj * HALF) = w; } }
    }
};
template <class Epi, class Sched, bool ALIGN_EPI = false, bool SP2 = false>
__device__ __forceinline__ void gemm_phase(PG8_LAS unsigned char* lds, const Gemm g, const Sched& S, const Epi& E) {
    int tid_l = threadIdx.x; asm volatile("" : "+v"(tid_l)); const int tid = tid_l, wid = __builtin_amdgcn_readfirstlane(tid >> 6), lane = tid & 63, wr = wid >> 2, wc = wid & 3, fr = lane & 15, fq = lane >> 4;
    static_assert(!Epi::HALF_N || SP2, "HALF_N units exist for the two-super-phase loop only");
    const int K = g.K, nt = K / BK;
    unsigned voffA[2], voffB[2];
#pragma unroll
    for (int i = 0; i < 2; ++i) { int R, C; stage_rc(tid * 16 + i * 8192, R, C); const int Rb = Epi::PERM ? ((R & ~31) + perm32(R & 31)) : R;
        voffA[i] = (unsigned)(R * K + C) * 2u; voffB[i] = (unsigned)(Rb * K + C) * 2u; }
    const size_t kstep = (size_t)(BK * 2);
    const size_t hstep = (size_t)HALF * K * 2;
    const size_t tstep = 2 * hstep;
    const unsigned ldsw = (unsigned)wid * 1024u;
    const int aoff = lds_byte(wr * 64 + fr, fq * 8), boff = lds_byte(wc * 32 + fr, fq * 8);
#define PG8_SA(b, h) (((b) * 2 + (h)) * HTB)
#define PG8_SB(b, h) ((4 + (b) * 2 + (h)) * HTB)
#define PG8_STAGE(bufoff, gbase, voff) do { _Pragma("unroll") for (int _i = 0; _i < 2; ++_i) \
        __builtin_amdgcn_global_load_lds((const unsigned*)((const char*)(gbase) + (voff)[_i]), (PG8_LAS unsigned*)(lds + (bufoff) + ldsw + _i * 8192), 16, 0, 0); } while (0)
#define PG8_LDA(dst, b, h) do { _Pragma("unroll") for (int m = 0; m < 4; ++m) _Pragma("unroll") for (int k = 0; k < 2; ++k) dst[m][k] = *(const PG8_LAS bf16x8*)(lds + PG8_SA(b, h) + aoff + m * 2048 + k * 1024); } while (0)
#define PG8_LDB(dst, b, h) do { _Pragma("unroll") for (int n = 0; n < 2; ++n) _Pragma("unroll") for (int k = 0; k < 2; ++k) dst[n][k] = *(const PG8_LAS bf16x8*)(lds + PG8_SB(b, h) + boff + n * 2048 + k * 1024); } while (0)
#define PG8_MMA(ai, bj, At, Bt) do { __builtin_amdgcn_s_setprio(1); _Pragma("unroll") for (int m = 0; m < 4; ++m) _Pragma("unroll") for (int n = 0; n < 2; ++n) _Pragma("unroll") for (int k = 0; k < 2; ++k) \
        acc[ai][bj][m][n] = __builtin_amdgcn_mfma_f32_16x16x32_bf16(Bt[n][k], At[m][k], acc[ai][bj][m][n], 0, 0, 0); __builtin_amdgcn_s_setprio(0); } while (0)
#define PG8_WAIT_V(n) asm volatile("s_waitcnt vmcnt(" #n ")" ::: "memory")
#define PG8_WAIT_L(n) asm volatile("s_waitcnt lgkmcnt(" #n ")" ::: "memory")
#define PG8_BAR __builtin_amdgcn_s_barrier()
#define PG8_SCHED __builtin_amdgcn_sched_barrier(0)
    Unit cur, nxt; int ui = 0;
    if (!S.next(0, cur)) return;
    f32x4 acc[2][2][4][2];
#pragma unroll
    for (int a = 0; a < 2; ++a)
#pragma unroll
        for (int b = 0; b < 2; ++b)
#pragma unroll
            for (int m = 0; m < 4; ++m)
#pragma unroll
                for (int n = 0; n < 2; ++n) acc[a][b][m][n] = (f32x4){0.f, 0.f, 0.f, 0.f};
    bf16x8 At[4][2], B0[2][2], B1[2][2];
    const char* cA = (const char*)g.A + (size_t)cur.pm * tstep; const char* cB = (const char*)g.Bt + (size_t)cur.pn * tstep + (Epi::HALF_N ? (size_t)cur.hn * hstep : (size_t)0);
    S.a_ready(cur);
    if constexpr (SP2) {
        PG8_STAGE(PG8_SB(0, 0), cB, voffB); PG8_STAGE(PG8_SB(0, 1), cB + hstep, voffB); PG8_STAGE(PG8_SA(0, 0), cA, voffA); PG8_STAGE(PG8_SA(0, 1), cA + hstep, voffA);
        if (wr == 1) PG8_BAR;
        PG8_WAIT_V(2); PG8_BAR;
        PG8_STAGE(PG8_SB(1, 0), cB + kstep, voffB); PG8_STAGE(PG8_SA(1, 0), cA + kstep, voffA); PG8_STAGE(PG8_SB(1, 1), cB + hstep + kstep, voffB);
        PG8_WAIT_V(6); PG8_BAR;
    } else {
        PG8_STAGE(PG8_SB(0, 0), cB, voffB); PG8_STAGE(PG8_SA(0, 0), cA, voffA); PG8_STAGE(PG8_SB(0, 1), cB + hstep, voffB); PG8_STAGE(PG8_SA(0, 1), cA + hstep, voffA);
        if (wr == 1) PG8_BAR;
        PG8_WAIT_V(4); PG8_BAR;
        PG8_STAGE(PG8_SB(1, 0), cB + kstep, voffB); PG8_STAGE(PG8_SA(1, 0), cA + kstep, voffA); PG8_STAGE(PG8_SB(1, 1), cB + hstep + kstep, voffB);
        PG8_WAIT_V(6); PG8_BAR;
    }
    for (;;) {
        const bool has_next = S.next(ui + 1, nxt);
        const char* nA = has_next ? (const char*)g.A + (size_t)nxt.pm * tstep : cA; const char* nB = has_next ? (const char*)g.Bt + (size_t)nxt.pn * tstep + (Epi::HALF_N ? (size_t)nxt.hn * hstep : (size_t)0) : cB;
        for (int t = 0; t < nt; t += 2) {
            const bool last = (t == nt - 2);
            const char* a1 = cA + (size_t)(t + 1) * kstep;
            const char* a2 = last ? nA : cA + (size_t)(t + 2) * kstep; const char* b2 = last ? nB : cB + (size_t)(t + 2) * kstep;
            const char* a3 = a2 + kstep; const char* b3 = b2 + kstep;
            if (last && has_next) S.a_ready(nxt);
            if constexpr (SP2) {
            PG8_LDB(B0, 0, 0); if constexpr (!Epi::HALF_N) PG8_LDB(B1, 0, 1); PG8_SCHED; PG8_LDA(At, 0, 0); PG8_STAGE(PG8_SA(1, 1), a1 + hstep, voffA);
            PG8_WAIT_V(8); PG8_WAIT_L(0); PG8_BAR; PG8_MMA(0, 0, At, B0); if constexpr (!Epi::HALF_N) PG8_MMA(0, 1, At, B1); PG8_BAR; PG8_SCHED;
            PG8_LDA(At, 0, 1); PG8_STAGE(PG8_SB(0, 0), b2, voffB); PG8_STAGE(PG8_SB(0, 1), b2 + hstep, voffB); PG8_STAGE(PG8_SA(0, 0), a2, voffA);
            PG8_WAIT_V(8); PG8_WAIT_L(0); PG8_BAR; PG8_MMA(1, 0, At, B0); if constexpr (!Epi::HALF_N) PG8_MMA(1, 1, At, B1); PG8_BAR; PG8_SCHED;
            PG8_LDB(B0, 1, 0); if constexpr (!Epi::HALF_N) PG8_LDB(B1, 1, 1); PG8_SCHED; PG8_LDA(At, 1, 0); PG8_STAGE(PG8_SA(0, 1), a2 + hstep, voffA);
            PG8_WAIT_V(8); PG8_WAIT_L(0); PG8_BAR; PG8_MMA(0, 0, At, B0); if constexpr (!Epi::HALF_N) PG8_MMA(0, 1, At, B1); PG8_BAR; PG8_SCHED;
            PG8_LDA(At, 1, 1); PG8_STAGE(PG8_SB(1, 0), b3, voffB); PG8_STAGE(PG8_SB(1, 1), b3 + hstep, voffB); PG8_STAGE(PG8_SA(1, 0), a3, voffA);
            PG8_WAIT_V(8); PG8_WAIT_L(0); PG8_BAR; PG8_MMA(1, 0, At, B0); if constexpr (!Epi::HALF_N) PG8_MMA(1, 1, At, B1); PG8_BAR; PG8_SCHED;
            } else {
            PG8_LDB(B0, 0, 0); PG8_SCHED; PG8_LDA(At, 0, 0); PG8_STAGE(PG8_SA(1, 1), a1 + hstep, voffA);
            PG8_WAIT_L(8); PG8_BAR; PG8_WAIT_L(0); PG8_MMA(0, 0, At, B0); PG8_BAR; PG8_SCHED;
            PG8_LDB(B1, 0, 1); PG8_STAGE(PG8_SB(0, 0), b2, voffB);
            PG8_BAR; PG8_WAIT_L(0); PG8_MMA(0, 1, At, B1); PG8_BAR;
            PG8_LDA(At, 0, 1); PG8_STAGE(PG8_SA(0, 0), a2, voffA);
            PG8_BAR; PG8_WAIT_L(0); PG8_MMA(1, 0, At, B0); PG8_BAR; PG8_SCHED;
            PG8_STAGE(PG8_SB(0, 1), b2 + hstep, voffB);
            PG8_WAIT_V(6); PG8_BAR; PG8_MMA(1, 1, At, B1); PG8_BAR;
            PG8_LDB(B0, 1, 0); PG8_SCHED; PG8_LDA(At, 1, 0); PG8_STAGE(PG8_SA(0, 1), a2 + hstep, voffA);
            PG8_WAIT_L(8); PG8_BAR; PG8_WAIT_L(0); PG8_MMA(0, 0, At, B0); PG8_BAR; PG8_SCHED;
            PG8_LDB(B1, 1, 1); PG8_STAGE(PG8_SB(1, 0), b3, voffB);
            PG8_BAR; PG8_WAIT_L(0); PG8_MMA(0, 1, At, B1); PG8_BAR;
            PG8_LDA(At, 1, 1); PG8_STAGE(PG8_SA(1, 0), a3, voffA);
            PG8_BAR; PG8_WAIT_L(0); PG8_MMA(1, 0, At, B0); PG8_BAR; PG8_SCHED;
            PG8_STAGE(PG8_SB(1, 1), b3 + hstep, voffB);
            PG8_WAIT_V(6); PG8_BAR; PG8_MMA(1, 1, At, B1); PG8_BAR;
            }
        }
        if constexpr (ALIGN_EPI) { if (wr == 0) PG8_BAR; }
        if constexpr (!Epi::AFTER_DRAIN) { E(acc, cur, wr, wc, fr, fq); S.done(cur); }
        if (!has_next) break;
#pragma unroll
        for (int a = 0; a < 2; ++a)
#pragma unroll
            for (int b = 0; b < 2; ++b)
#pragma unroll
                for (int m = 0; m < 4; ++m)
#pragma unroll
                    for (int n = 0; n < 2; ++n) acc[a][b][m][n] = (f32x4){0.f, 0.f, 0.f, 0.f};
        cur = nxt; cA = nA; cB = nB; ++ui;
        if constexpr (ALIGN_EPI) { if (wr == 1) PG8_BAR; }
    }
    PG8_WAIT_V(0);
    if constexpr (!ALIGN_EPI) { if (wr == 0) PG8_BAR; }
    PG8_BAR;
    if constexpr (Epi::AFTER_DRAIN) { E.fused(acc, cur, wr, wc, fr, fq, lds, wid, lane); S.done(cur); }
#undef PG8_SA
#undef PG8_SB
#undef PG8_STAGE
#undef PG8_LDA
#undef PG8_LDB
#undef PG8_MMA
#undef PG8_WAIT_V
#undef PG8_WAIT_L
#undef PG8_BAR
#undef PG8_SCHED
}
}
constexpr int DM = 2048, NB = 4, SEQ = 4096, CTXL = 256, DEPTH = 4;
constexpr int TB = SEQ + CTXL;
constexpr int R = NB * TB;
constexpr int INC = 5120, DFF = 5632, UPC = 2 * DFF, NMODC = 6 * DM;
constexpr int C_AQ = 0, C_AK = 1024, C_AV = 1280, C_HQ = 1536, C_HFF = 2048, C_HFB = 2560, C_HI = 3072, C_HGT = 3584, C_SU = 4096, C_SV = 4608;
constexpr float EPS = 1e-6f;
constexpr int NWAVES = 8, NTHR = 512;
constexpr int NPHASE = 3 + 9 * DEPTH;

constexpr size_t MiB = 1u << 20;
constexpr size_t WS_CTL = 0, CTL_ZERO_BYTES = 4 * MiB;
constexpr size_t WS_MOD = 3 * MiB;
constexpr size_t WS_MISC = 1146 * MiB;
constexpr size_t WS_W = 4 * MiB, W_LAYER = 94 * MiB, W_IN = 0, W_OUT = 20 * MiB, W_UP = 28 * MiB, W_DN = 72 * MiB;
constexpr size_t WS_X = 380 * MiB;
constexpr size_t WS_H = 516 * MiB;
constexpr size_t WS_PROJ = 584 * MiB;
constexpr size_t WS_QN = 754 * MiB;
constexpr size_t WS_KN = 788 * MiB;
constexpr size_t WS_MIX = 797 * MiB;
constexpr size_t WS_HS = 865 * MiB;
constexpr size_t WS_HD = 897 * MiB;
constexpr size_t WS_HO = 898 * MiB;
constexpr size_t WS_UP = 584 * MiB;
constexpr size_t WS_ACT = 958 * MiB;
constexpr size_t WS_SWIN = 1 * MiB;
constexpr size_t WS_SWUP = WS_SWIN + 512 * 1024;
constexpr size_t WS_GS = 1145 * MiB;
constexpr size_t WS_END = 1147 * MiB;
constexpr size_t WS_RS = 65536;
static_assert(WS_RS + (size_t)2 * DEPTH * R * 4 <= WS_SWIN && WS_SWIN + (size_t)DEPTH * 5 * INC * 4 <= WS_SWUP && WS_SWUP + (size_t)DEPTH * 5 * UPC * 4 <= WS_MOD && WS_MOD + (size_t)DEPTH * 5 * NMODC * 4 <= CTL_ZERO_BYTES && WS_GS + (size_t)DEPTH * 2 * 5 * DM * 4 <= WS_MISC && WS_MISC + 65536 <= WS_END && WS_MOD + (size_t)DEPTH * 5 * NMODC * 4 <= WS_W, "ws map 4");
static_assert(WS_HO + (size_t)2 * R * 512 * 4 <= 966 * MiB && WS_UP + (size_t)R * UPC * 2 <= WS_ACT && WS_ACT + (size_t)R * DFF * 2 <= WS_GS, "ws map");
static_assert(WS_PROJ + (size_t)R * INC * 2 <= WS_QN && WS_QN + (size_t)R * 1024 * 2 <= WS_KN && WS_KN + (size_t)R * 256 * 2 <= WS_MIX && WS_MIX + (size_t)R * DM * 2 <= WS_HS, "ws map 2");
static_assert(WS_X + (size_t)R * DM * 4 <= WS_H && WS_H + (size_t)R * DM * 2 <= WS_PROJ && WS_W + DEPTH * W_LAYER <= WS_X, "ws map 3");
constexpr int CW_BAR = 4096;
constexpr int CW_Q0 = 64;

constexpr int RING_BYTES = 131072, LDSCTL_OFF = RING_BYTES, MISC_OFF = LDSCTL_OFF + 320, LDS_BYTES = 147456;

#define GAS __attribute__((address_space(1)))
#define LAS __attribute__((address_space(3)))
typedef unsigned short bf16;
typedef float v4f __attribute__((ext_vector_type(4)));
typedef unsigned v4u __attribute__((ext_vector_type(4)));
typedef unsigned v2u __attribute__((ext_vector_type(2)));
typedef float v2f __attribute__((ext_vector_type(2)));
typedef GAS unsigned gu32;
#define AS4 __attribute__((address_space(4)))
typedef const AS4 unsigned char* kptr_t;
#define LDS_WAIT() asm volatile("s_waitcnt lgkmcnt(0)" ::: "memory")
#define LDS_BAR() do { asm volatile("s_waitcnt lgkmcnt(0)" ::: "memory"); __builtin_amdgcn_s_barrier(); asm volatile("" ::: "memory"); } while (0)
__device__ __forceinline__ float bf2f(unsigned u) { return __uint_as_float(u << 16); }
__device__ __forceinline__ unsigned f2bf(float f) { unsigned u = __float_as_uint(f); return (u + 0x7fffu + ((u >> 16) & 1u)) >> 16; }
__device__ __forceinline__ unsigned pk2(float lo, float hi) { return f2bf(lo) | (f2bf(hi) << 16); }
typedef float cvt_f32x2 __attribute__((ext_vector_type(2))); typedef __bf16 cvt_bf16x2 __attribute__((ext_vector_type(2)));
__device__ __forceinline__ unsigned cvtpk_rne(float lo, float hi) { const cvt_f32x2 v = {lo, hi}; return __builtin_bit_cast(unsigned, __builtin_convertvector(v, cvt_bf16x2)); }
__device__ __forceinline__ float dpp_f(float v, const int ctrl_unused) { return v; }
#define DPP_ADD(v, ctrl) ((v) + __builtin_bit_cast(float, __builtin_amdgcn_update_dpp(0, __builtin_bit_cast(int, (v)), (ctrl), 0xf, 0xf, false)))
__device__ __forceinline__ float wave_sum(float v) {
    v = DPP_ADD(v, 0xB1);
    v = DPP_ADD(v, 0x4E);
    v = DPP_ADD(v, 0x141);
    v = DPP_ADD(v, 0x140);
    { auto rr = __builtin_amdgcn_permlane16_swap(__float_as_uint(v), __float_as_uint(v), false, false); v = __uint_as_float(rr[0]) + __uint_as_float(rr[1]); }
    { auto rr = __builtin_amdgcn_permlane32_swap(__float_as_uint(v), __float_as_uint(v), false, false); v = __uint_as_float(rr[0]) + __uint_as_float(rr[1]); }
    return v;
}
__device__ __forceinline__ float sigm(float z) { return __builtin_amdgcn_rcpf(1.f + __expf(-z)); }
__device__ __forceinline__ float silu_f(float z) { return z * sigm(z); }
__device__ __forceinline__ float gelu_tanh(float x) {
    const float u = 0.7978845608028654f * (x + 0.044715f * x * x * x);
    const float th = 1.f - 2.f * __builtin_amdgcn_rcpf(1.f + __expf(2.f * u));
    return 0.5f * x * (1.f + th);
}
__device__ __forceinline__ v4f mfma4(float a, float b, v4f c) { return __builtin_amdgcn_mfma_f32_16x16x4f32(a, b, c, 0, 0, 0); }

#define XB_TMO      128
#define XB_XCNT(j)  (256  + 64 * (j))
#define XB_XSUB(j)  (1280 + 64 * (j))
#define XB_XGEN(j)  (2304 + 64 * (j))
#define XB_TOP      3328
#define XB_TOPGEN   3392
#define XCD_BAR_WORDS 3456
#define XB_SPIN_CAP (1u << 18)
__device__ __forceinline__ unsigned xb_ld(unsigned* p)              { return __hip_atomic_load(p, __ATOMIC_RELAXED, __HIP_MEMORY_SCOPE_AGENT); }
__device__ __forceinline__ unsigned xb_add(unsigned* p, unsigned v) { return __hip_atomic_fetch_add(p, v, __ATOMIC_RELAXED, __HIP_MEMORY_SCOPE_AGENT); }
__device__ __forceinline__ unsigned xb_xcc_id() { return (unsigned)__builtin_amdgcn_s_getreg((3 << 11) | 20) & 0xFu; }
#define XB_SPIN(cond, bar) do { unsigned _sp = 0; while (cond) { __builtin_amdgcn_s_sleep(1); \
    if ((++_sp & 255u) == 0u) { if (xb_ld(&(bar)[XB_TMO])) break; if (_sp > XB_SPIN_CAP) { atomicAdd(&(bar)[XB_TMO], 1u); break; } } } } while (0)
struct XcdBarrier { unsigned* bar; unsigned x; volatile LAS unsigned* st; };
__device__ __forceinline__ XcdBarrier xcd_barrier_post(unsigned* bar, volatile LAS unsigned* st) {
    XcdBarrier b; b.bar = bar; b.x = xb_xcc_id(); b.st = st;
    if (threadIdx.x == 0) (void)xb_add(&bar[XB_XCNT(b.x)], 1u);
    return b;
}
__device__ __forceinline__ void xcd_barrier_complete(unsigned* bar, unsigned x, unsigned& nloc, unsigned& nx) {
    const unsigned G = gridDim.x * gridDim.y * gridDim.z;
    unsigned sum, cnt, mine, sp = 0u;
    for (;;) {
        sum = 0u; cnt = 0u; mine = 0u;
#pragma unroll
        for (unsigned j = 0; j < 16; ++j) { const unsigned c = xb_ld(&bar[XB_XCNT(j)]); sum += c; cnt += (c > 0u) ? 1u : 0u; mine = (j == x) ? c : mine; }
        if (sum == G) break;
        __builtin_amdgcn_s_sleep(1);
        if ((++sp & 255u) == 0u) { if (xb_ld(&bar[XB_TMO])) break; if (sp > XB_SPIN_CAP) { atomicAdd(&bar[XB_TMO], 1u); break; } }
    }
    nloc = mine > 0u ? mine : 1u; nx = cnt > 0u ? cnt : 1u;
}
__device__ __forceinline__ void xcd_barrier(const XcdBarrier& b) {
    asm volatile("s_waitcnt vmcnt(0)" ::: "memory");
    __syncthreads();
    if (threadIdx.x == 0) {
        unsigned* bar = b.bar;
        __builtin_amdgcn_s_waitcnt(0);
        unsigned nloc = b.st[0], nx = b.st[1];
        if (nloc == 0u) { xcd_barrier_complete(bar, b.x, nloc, nx); b.st[0] = nloc; b.st[1] = nx; }
        const unsigned old = xb_add(&bar[XB_XSUB(b.x)], 1u);
        const unsigned gen = old / nloc;
        if (old + 1u == (gen + 1u) * nloc) {
            __builtin_amdgcn_fence(__ATOMIC_RELEASE, "agent");
            asm volatile("s_waitcnt vmcnt(0)" ::: "memory");
            const unsigned og = xb_add(&bar[XB_TOP], 1u);
            const unsigned tg = og / nx;
            if (og + 1u == (tg + 1u) * nx) xb_add(&bar[XB_TOPGEN], 1u);
            else XB_SPIN(xb_ld(&bar[XB_TOPGEN]) == tg, bar);
            __builtin_amdgcn_fence(__ATOMIC_ACQUIRE, "agent");
            xb_add(&bar[XB_XGEN(b.x)], 1u);
            asm volatile("s_waitcnt vmcnt(0)" ::: "memory");
        } else {
            XB_SPIN(xb_ld(&bar[XB_XGEN(b.x)]) == gen, bar);
            __builtin_amdgcn_fence(__ATOMIC_ACQUIRE, "agent");
            asm volatile("s_waitcnt vmcnt(0)" ::: "memory");
        }
    }
    __syncthreads();
}

struct TileOrder : pg8::StaticOrder {
    bool skip;
    __device__ void init2(int N, int G_, int c_, bool skip_) { skip = skip_; init(skip_ ? NB * SEQ : R, N, G_, c_); }
    __device__ bool next(int i, pg8::Unit& u) const { if (!pg8::StaticOrder::next(i, u)) return false; if (skip) u.pm += u.pm >> 4; return true; }
};
__device__ __forceinline__ unsigned cvt_pk2(float lo, float hi) { return cvtpk_rne(lo, hi); }
template <bool MAKE_H, bool HALF = false>
struct EpiResGate {
    static constexpr bool PERM = true, AFTER_DRAIN = false, HALF_N = HALF;
    float* X; const float* mod_l; int jg; bf16* H; const float* gs; float* rs;
    const float* xin; const float* cin;
    __device__ __forceinline__ void operator()(const pg8::f32x4 (&acc)[2][2][4][2], const pg8::Unit& u, int wr, int wc, int fr, int fq) const {
        const int b = u.pm / 17, jt = u.pm - b * 17, mrow = (jt == 16 ? 4 : b);
        const float* gp = mod_l + (size_t)mrow * NMODC + (size_t)jg * DM;
        const float* gsp = gs + (size_t)mrow * DM;
        const int col0 = u.pn * 256 + (HALF ? u.hn * 128 : 0) + wc * 32 + 8 * fq;
        constexpr int NBJ = HALF ? 1 : 2;
        pg8::f32x4 gv[2][2];
#pragma unroll
        for (int bj = 0; bj < NBJ; ++bj)
#pragma unroll
            for (int n = 0; n < 2; ++n) gv[bj][n] = *(const pg8::f32x4*)(gp + col0 + bj * 128 + 4 * n);
#pragma unroll
        for (int ai = 0; ai < 2; ++ai)
#pragma unroll
            for (int m = 0; m < 4; ++m) { const int row = u.pm * 256 + ai * 128 + wr * 64 + m * 16 + fr; const size_t off = (size_t)row * DM + col0; float ss = 0.f;
                const float* src = xin ? (jt == 16 ? cin + ((size_t)b * CTXL + (row - u.pm * 256)) * DM : xin + ((size_t)b * SEQ + jt * 256 + (row - u.pm * 256)) * DM) + col0 : X + off;
#pragma unroll
                for (int bj = 0; bj < NBJ; ++bj) { pg8::f32x4 xn[2];
#pragma unroll
                    for (int n = 0; n < 2; ++n) { xn[n] = *(const pg8::f32x4*)(src + bj * 128 + 4 * n) + gv[bj][n] * acc[ai][bj][m][n]; *(pg8::f32x4*)(X + off + bj * 128 + 4 * n) = xn[n]; }
                    if (MAKE_H) {
#pragma unroll
                        for (int n = 0; n < 2; ++n) ss += (xn[n][0] * xn[n][0] + xn[n][1] * xn[n][1]) + (xn[n][2] * xn[n][2] + xn[n][3] * xn[n][3]);
                        const pg8::f32x4 h0 = xn[0] * *(const pg8::f32x4*)(gsp + col0 + bj * 128), h1 = xn[1] * *(const pg8::f32x4*)(gsp + col0 + bj * 128 + 4);
                        v4u w; w.x = cvt_pk2(h0[0], h0[1]); w.y = cvt_pk2(h0[2], h0[3]); w.z = cvt_pk2(h1[0], h1[1]); w.w = cvt_pk2(h1[2], h1[3]);
                        *(v4u*)(H + off + bj * 128) = w; } }
                if (MAKE_H) { ss += __shfl_xor(ss, 16); ss += __shfl_xor(ss, 32); if (fq == 0) unsafeAtomicAdd(rs + row, ss); }
                if (m & 1) asm volatile("" ::: "memory"); }
    }
};
struct EpiBf16N {
    static constexpr bool PERM = true, AFTER_DRAIN = false, HALF_N = false;
    bf16* O; int ldc; const float* rs; const float* sw;
    __device__ __forceinline__ void operator()(const pg8::f32x4 (&acc)[2][2][4][2], const pg8::Unit& u, int wr, int wc, int fr, int fq) const {
        const int b = u.pm / 17, jt = u.pm - b * 17, mrow = (jt == 16 ? 4 : b);
        const int row0 = u.pm * 256 + wr * 64 + fr, col0 = u.pn * 256 + wc * 32 + 8 * fq;
        const float* swp = sw + (size_t)mrow * ldc + col0;
        pg8::f32x4 bv[2][2];
#pragma unroll
        for (int bj = 0; bj < 2; ++bj)
#pragma unroll
            for (int n = 0; n < 2; ++n) bv[bj][n] = *(const pg8::f32x4*)(swp + bj * 128 + 4 * n);
#pragma unroll
        for (int ai = 0; ai < 2; ++ai)
#pragma unroll
            for (int m = 0; m < 4; ++m) { const int row = row0 + ai * 128 + m * 16; const float rstd = 1.0f / sqrtf(rs[row] * (1.f / DM) + EPS);
                bf16* rowp = O + (size_t)row * ldc + col0;
#pragma unroll
                for (int bj = 0; bj < 2; ++bj) { const pg8::f32x4 v0 = acc[ai][bj][m][0] * rstd + bv[bj][0], v1 = acc[ai][bj][m][1] * rstd + bv[bj][1];
                    pg8::u32x4 w; w.x = cvt_pk2(v0[0], v0[1]); w.y = cvt_pk2(v0[2], v0[3]); w.z = cvt_pk2(v1[0], v1[1]); w.w = cvt_pk2(v1[2], v1[3]);
                    *(pg8::u32x4*)(rowp + bj * 128) = w; } }
    }
};

struct CtxHalfOrder {
    int nN, G, c;
    __device__ bool next(int i, pg8::Unit& u) const { const int L = i * G + c; if (c >= G || L >= NB * nN * 2) return false; u.hn = L & 1; u.pn = (L >> 1) % nN; u.pm = ((L >> 1) / nN) * 17 + 16; return true; }
    __device__ __forceinline__ void a_ready(const pg8::Unit&) const {}
    __device__ __forceinline__ void done(const pg8::Unit&) const {}
};

namespace att {
using bf16x8 = __attribute__((ext_vector_type(8))) short;
using s16x4  = __attribute__((ext_vector_type(4))) short;
using f32x16 = __attribute__((ext_vector_type(16))) float;
using u32x4  = __attribute__((ext_vector_type(4))) unsigned;
constexpr int   D = 128, NW = 8, QBLK = 32, KVBLK = 64;
constexpr float SCALE = 0.088388347648318440f;
constexpr float THR = 8.f;
constexpr int LDQ = 1024, LDK = 256, LDV = INC, LDO = DM;
constexpr size_t SHM_V = KVBLK * D * 2, SHM_K = KVBLK * D * 2, SHM_ATTN = 2 * SHM_V + 2 * SHM_K + NW * 64 * 4;
#define KSWZ(row, colB) ((row) * 256 + ((colB) ^ (((row) & 7) << 4)))
#define SBAR() __builtin_amdgcn_sched_barrier(0)
__device__ __forceinline__ int crow(int r, int hi) { return (r & 3) + 8 * (r >> 2) + 4 * hi; }
__device__ __forceinline__ unsigned cvtpk(float lo, float hi) { unsigned r; asm volatile("v_cvt_pk_bf16_f32 %0, %1, %2" : "=v"(r) : "v"(lo), "v"(hi)); return r; }
__device__ __forceinline__ void partialSM(f32x16& p0, f32x16& p1, float& m_reg, float& mn, float& alpha) {
  constexpr float C = SCALE * 1.4426950408889634f;
  float pmax = p0[0]; for (int r = 1; r < 16; ++r) pmax = fmaxf(pmax, p0[r]); for (int r = 0; r < 16; ++r) pmax = fmaxf(pmax, p1[r]);
  { auto rr = __builtin_amdgcn_permlane32_swap(__float_as_uint(pmax), __float_as_uint(pmax), false, false);
    pmax = fmaxf(__uint_as_float(rr[0]), __uint_as_float(rr[1])); }
  if (__builtin_expect(__all(pmax - m_reg <= THR / SCALE), 1)) { mn = m_reg; alpha = 1.f; }
  else { mn = fmaxf(m_reg, pmax); alpha = __builtin_amdgcn_exp2f((m_reg - mn) * C); m_reg = mn; }
  float mnC = -mn * C;
  for (int r = 0; r < 16; ++r) p0[r] = fmaf(p0[r], C, mnC); for (int r = 0; r < 16; ++r) p1[r] = fmaf(p1[r], C, mnC);
  for (int r = 0; r < 16; ++r) p0[r] = __builtin_amdgcn_exp2f(p0[r]);
}
__device__ __forceinline__ void finishSM(f32x16& p0, f32x16& p1, float alpha, float& l_reg, bf16x8& pa0, bf16x8& pa1, bf16x8& pa2, bf16x8& pa3) {
  for (int r = 0; r < 16; ++r) p1[r] = __builtin_amdgcn_exp2f(p1[r]);
  float ps = 0; for (int r = 0; r < 16; ++r) ps += p0[r]; for (int r = 0; r < 16; ++r) ps += p1[r];
  { auto rr = __builtin_amdgcn_permlane32_swap(__float_as_uint(ps), __float_as_uint(ps), false, false);
    ps = __uint_as_float(rr[0]) + __uint_as_float(rr[1]); }
  l_reg = l_reg * alpha + ps;
#define PK4(P, BASE, OUT) do { unsigned a0 = cvtpk(P[BASE + 0], P[BASE + 1]), a1 = cvtpk(P[BASE + 2], P[BASE + 3]);   \
    unsigned b0 = cvtpk(P[BASE + 4], P[BASE + 5]), b1 = cvtpk(P[BASE + 6], P[BASE + 7]);                              \
    auto r0 = __builtin_amdgcn_permlane32_swap(a0, b0, false, false); auto r1 = __builtin_amdgcn_permlane32_swap(a1, b1, false, false); \
    u32x4 w = {r0[0], r1[0], r0[1], r1[1]}; OUT = *reinterpret_cast<bf16x8*>(&w); } while (0)
  PK4(p0, 0, pa0); PK4(p0, 8, pa1); PK4(p1, 0, pa2); PK4(p1, 8, pa3);
#undef PK4
}
__device__ __forceinline__ void qkt(f32x16& p0, f32x16& p1, const bf16* Ks, const bf16x8* qr, int r32, int hi) {
  p0 = f32x16{}; p1 = f32x16{};
  for (int d0 = 0; d0 < 8; ++d0) { int cb = (d0 * 16 + hi * 8) * 2;
    bf16x8 b0 = *reinterpret_cast<const bf16x8*>((const char*)Ks + KSWZ(r32, cb));
    bf16x8 b1 = *reinterpret_cast<const bf16x8*>((const char*)Ks + KSWZ(32 + r32, cb));
    p0 = __builtin_amdgcn_mfma_f32_32x32x16_bf16(b0, qr[d0], p0, 0, 0, 0);
    p1 = __builtin_amdgcn_mfma_f32_32x32x16_bf16(b1, qr[d0], p1, 0, 0, 0); }
}
__device__ __forceinline__ int v_st(int k, int c) { const int kk = (k & ~0xC) | ((k & 4) << 1) | ((k & 8) >> 1); return ((kk >> 3) * 4 + (c >> 5)) * 512 + ((kk & 7) * 32 + (c & 31)) * 2; }
__device__ __forceinline__ int v_rd_base(int lane) { return ((lane & 3) << 3) | (((lane >> 2) & 3) << 6) | (((lane >> 4) & 1) << 5) | (((lane >> 5) & 1) << 8); }
constexpr int v_rd_off(int d0, int ks, int half) { return d0 * 512 + ks * 4096 + half * 2048; }
template <int OFF> __device__ __forceinline__ s16x4 tr_read(int vb) {
  s16x4 r; asm volatile("ds_read_b64_tr_b16 %0, %1 offset:%2" : "=&v"(r) : "v"(vb), "i"(OFF) : "memory"); return r;
}
template <int D0> __device__ __forceinline__ void pv_one(f32x16& od, int vb, bf16x8 pa0, bf16x8 pa1, bf16x8 pa2, bf16x8 pa3) {
  const s16x4 l0 = tr_read<v_rd_off(D0, 0, 0)>(vb), h0 = tr_read<v_rd_off(D0, 0, 1)>(vb), l1 = tr_read<v_rd_off(D0, 1, 0)>(vb), h1 = tr_read<v_rd_off(D0, 1, 1)>(vb);
  const s16x4 l2 = tr_read<v_rd_off(D0, 2, 0)>(vb), h2 = tr_read<v_rd_off(D0, 2, 1)>(vb), l3 = tr_read<v_rd_off(D0, 3, 0)>(vb), h3 = tr_read<v_rd_off(D0, 3, 1)>(vb);
  asm volatile("s_waitcnt lgkmcnt(0)" ::: "memory"); SBAR();
#define PK(L, H) (bf16x8){L[0], L[1], L[2], L[3], H[0], H[1], H[2], H[3]}
  od = __builtin_amdgcn_mfma_f32_32x32x16_bf16(pa0, PK(l0, h0), od, 0, 0, 0);
  od = __builtin_amdgcn_mfma_f32_32x32x16_bf16(pa1, PK(l1, h1), od, 0, 0, 0);
  od = __builtin_amdgcn_mfma_f32_32x32x16_bf16(pa2, PK(l2, h2), od, 0, 0, 0);
  od = __builtin_amdgcn_mfma_f32_32x32x16_bf16(pa3, PK(l3, h3), od, 0, 0, 0);
#undef PK
}
__device__ __forceinline__ void pv_d0(f32x16* o, int vb, bf16x8 pa0, bf16x8 pa1, bf16x8 pa2, bf16x8 pa3) {
  pv_one<0>(o[0], vb, pa0, pa1, pa2, pa3); pv_one<1>(o[1], vb, pa0, pa1, pa2, pa3); pv_one<2>(o[2], vb, pa0, pa1, pa2, pa3); pv_one<3>(o[3], vb, pa0, pa1, pa2, pa3);
}
__device__ __forceinline__ void attn_dense_body(const bf16* __restrict__ Qb, const bf16* __restrict__ Kh, const bf16* __restrict__ Vh,
                                                bf16* __restrict__ Ob, int seq, char* lds) {
  int tid_l = threadIdx.x; asm volatile("" : "+v"(tid_l)); const int tid = tid_l, wid = tid >> 6, lane = tid & 63, r32 = lane & 31, hi = lane >> 5;
  bf16* V_lds = (bf16*)lds; bf16* K_lds = (bf16*)(lds + 2 * SHM_V);
  float* ws = (float*)(lds + 2 * SHM_V + 2 * SHM_K) + wid * 64; float* li_l = ws; float* al_l = ws + 32;
  float m_reg = -1e30f, l_reg = 0; f32x16 o[4] = {}; bf16x8 qr[8];
  const bf16* Qw = Qb + (long)(wid * QBLK + r32) * LDQ + hi * 8;
#pragma unroll
  for (int d0 = 0; d0 < 8; ++d0) qr[d0] = *reinterpret_cast<const bf16x8*>(Qw + d0 * 16);
  const int sr = tid >> 4, sc = (tid & 15) * 8, vst0 = v_st(sr, sc), vst1 = v_st(32 + sr, sc);
  const int vb0 = (int)(uintptr_t)V_lds + v_rd_base(lane);
  struct { bf16x8 vs0, vs1, ks0, ks1; } sr_[2];
#define SLOAD(i, k0) do { sr_[i].vs0 = *reinterpret_cast<const bf16x8*>(&Vh[(long)((k0) + sr) * LDV + sc]); sr_[i].vs1 = *reinterpret_cast<const bf16x8*>(&Vh[(long)((k0) + 32 + sr) * LDV + sc]); \
    sr_[i].ks0 = *reinterpret_cast<const bf16x8*>(&Kh[(long)((k0) + sr) * LDK + sc]); sr_[i].ks1 = *reinterpret_cast<const bf16x8*>(&Kh[(long)((k0) + 32 + sr) * LDK + sc]); } while (0)
#define SWRITE(b, i) do { *(bf16x8*)((char*)V_lds + (b) * SHM_V + vst0) = sr_[i].vs0;          \
    *(bf16x8*)((char*)V_lds + (b) * SHM_V + vst1) = sr_[i].vs1; int kc = sc * 2;               \
    *(bf16x8*)((char*)K_lds + (b) * SHM_K + KSWZ(sr, kc)) = sr_[i].ks0;                       \
    *(bf16x8*)((char*)K_lds + (b) * SHM_K + KSWZ(32 + sr, kc)) = sr_[i].ks1; } while (0)
#define SWAIT() asm volatile("s_waitcnt vmcnt(4)" ::: "memory")
#define RESC(a) do { if (__any((a) < 1.f)) { if (hi == 0) al_l[r32] = (a); asm volatile("s_waitcnt lgkmcnt(0)" ::: "memory"); \
    for (int d = 0; d < 4; ++d) for (int r = 0; r < 16; ++r) o[d][r] *= al_l[crow(r, hi)]; } } while (0)
  f32x16 pA0, pA1, pB0, pB1; float mnA, mnB, alA, alB; bf16x8 pa0, pa1, pa2, pa3; const int NT = seq / KVBLK;
  constexpr int SE = 0, SO = 1;
  SLOAD(SE, 0); asm volatile("s_waitcnt vmcnt(0)" ::: "memory"); SWRITE(0, SE); __syncthreads();
  qkt(pA0, pA1, K_lds, qr, r32, hi); partialSM(pA0, pA1, m_reg, mnA, alA);
  SLOAD(SO, KVBLK); if (2 < NT) SLOAD(SE, 2 * KVBLK);
  SWAIT(); SWRITE(1, SO); __syncthreads();
  for (int j = 1; j + 1 < NT; j += 2) {
    SBAR(); qkt(pB0, pB1, (bf16*)((char*)K_lds + SHM_K), qr, r32, hi);
    finishSM(pA0, pA1, alA, l_reg, pa0, pa1, pa2, pa3); SBAR();
    SLOAD(SO, (j + 2) * KVBLK); SBAR();
    pv_d0(o, vb0, pa0, pa1, pa2, pa3); partialSM(pB0, pB1, m_reg, mnB, alB);
    __syncthreads(); SWAIT(); SWRITE(0, SE);
    RESC(alB); __syncthreads();
    SBAR(); qkt(pA0, pA1, K_lds, qr, r32, hi);
    finishSM(pB0, pB1, alB, l_reg, pa0, pa1, pa2, pa3); SBAR();
    if (j + 3 < NT) SLOAD(SE, (j + 3) * KVBLK); SBAR();
    pv_d0(o, vb0 + (int)SHM_V, pa0, pa1, pa2, pa3); partialSM(pA0, pA1, m_reg, mnA, alA);
    __syncthreads(); SWAIT(); SWRITE(1, SO);
    RESC(alA); __syncthreads();
  }
  SBAR(); qkt(pB0, pB1, (bf16*)((char*)K_lds + SHM_K), qr, r32, hi);
  finishSM(pA0, pA1, alA, l_reg, pa0, pa1, pa2, pa3); SBAR();
  pv_d0(o, vb0, pa0, pa1, pa2, pa3); partialSM(pB0, pB1, m_reg, mnB, alB);
  __syncthreads(); RESC(alB);
  finishSM(pB0, pB1, alB, l_reg, pa0, pa1, pa2, pa3); SBAR();
  pv_d0(o, vb0 + (int)SHM_V, pa0, pa1, pa2, pa3);
  if (hi == 0) li_l[r32] = l_reg; asm volatile("s_waitcnt lgkmcnt(0)" ::: "memory");
  float rli[16];
#pragma unroll
  for (int r = 0; r < 16; ++r) rli[r] = __builtin_amdgcn_rcpf(li_l[crow(r, hi)]);
  bf16* Ow = Ob + (long)(wid * QBLK) * LDO;
#pragma unroll
  for (int r = 0; r < 16; ++r) { int orow = crow(r, hi);
    for (int d0 = 0; d0 < 4; ++d0) Ow[(long)orow * LDO + d0 * 32 + r32] = (bf16)f2bf(o[d0][r] * rli[r]); }
  __syncthreads();
#undef SLOAD
#undef SWRITE
#undef SWAIT
#undef RESC
}
}

struct Args { const float* in[22]; float* out; unsigned char* ws; int ph_lo, ph_hi; };
enum { I_X = 0, I_C, I_CTX, I_CCTX, I_WADA, I_BADA, I_N1G, I_WIN, I_QG, I_KG, I_LBP, I_HGG, I_SGG, I_SGW, I_SGB, I_WOUT, I_N2G, I_WUP, I_CW, I_CB, I_WDN, I_FNG };

__device__ __forceinline__ void p0_mod(const float* cin, const float* ccin, const float* wada, const float* bada, LAS unsigned char* lds, float* MOD, int tid, int lane, int wave, int bx, int G) {
    LAS float* sc = (LAS float*)lds;
    LAS float* red0 = (LAS float*)(lds + 40960);
    for (int i = tid; i < 5 * DM; i += NTHR) { const int r = i >> 11, k = i & 2047; const float v = r < 4 ? cin[r * DM + k] : ccin[k]; sc[i] = silu_f(v); }
    LDS_BAR();
    int par = 0;
    for (int it = bx; it < 768; it += G, par ^= 1) {
        const int cb = it >> 2, kq = it & 3, l = cb / 48, n0 = (cb % 48) * 256, kbase = 512 * kq + 64 * wave;
        const float* wp = wada + ((size_t)l * DM + kbase) * NMODC + n0 + 4 * lane;
        LAS float* red = red0 + par * (8 * 5 * 256);
        v4f acc[5];
#pragma unroll
        for (int r = 0; r < 5; ++r) acc[r] = (v4f){0.f, 0.f, 0.f, 0.f};
#pragma unroll 16
        for (int k = 0; k < 64; ++k) {
            const v4f w = *(const v4f*)(wp + (size_t)k * NMODC);
#pragma unroll
            for (int r = 0; r < 5; ++r) { const float s = sc[r * DM + kbase + k]; acc[r] += w * s; }
        }
#pragma unroll
        for (int r = 0; r < 5; ++r) *(LAS v4f*)(red + (wave * 5 + r) * 256 + 4 * lane) = acc[r];
        LDS_BAR();
        for (int o = tid; o < 1280; o += NTHR) { const int r = o >> 8, ci = o & 255; float s = (kq == 0) ? bada[l * NMODC + n0 + ci] : 0.f;
#pragma unroll
            for (int w = 0; w < 8; ++w) s += red[(w * 5 + r) * 256 + ci];
            unsafeAtomicAdd(MOD + (size_t)(l * 5 + r) * NMODC + n0 + ci, s); }
    }
    LDS_BAR();
}
template <bool SWACC>
__device__ __forceinline__ void p0_transpose_item(const float* W, int K, int N, bf16* WT, LAS float* scr, int item, int lane, float* sw, const float* sh) {
    const int nblk = N / 32, kb = item / nblk, nb = item % nblk, k0 = 64 * kb, n0 = 32 * nb;
    {   v4f t[8];
#pragma unroll
        for (int i = 0; i < 8; ++i) t[i] = *(const v4f*)(W + (size_t)(k0 + 8 * i + (lane >> 3)) * N + n0 + 4 * (lane & 7));
#pragma unroll
        for (int i = 0; i < 8; ++i) { LAS float* d = scr + (8 * i + (lane >> 3)) * 33 + 4 * (lane & 7); d[0] = t[i].x; d[1] = t[i].y; d[2] = t[i].z; d[3] = t[i].w; } }
    LDS_WAIT(); asm volatile("" ::: "memory");
    const int c = lane & 7;
#pragma unroll
    for (int j = 0; j < 4; ++j) { const int n = (lane >> 3) + 8 * j; const LAS float* s = scr + (8 * c) * 33 + n;
        v4u o; o.x = pk2(s[0 * 33], s[1 * 33]); o.y = pk2(s[2 * 33], s[3 * 33]); o.z = pk2(s[4 * 33], s[5 * 33]); o.w = pk2(s[6 * 33], s[7 * 33]);
        *(GAS v4u*)(WT + (size_t)(n0 + n) * K + k0 + 8 * c) = o; }
    if (SWACC) {
        const int n = lane & 31, kh = lane >> 5; float s5[5] = {0.f, 0.f, 0.f, 0.f, 0.f};
        const float* shp = sh + k0 + 32 * kh; const LAS float* tp = scr + (32 * kh) * 33 + n;
#pragma unroll
        for (int q = 0; q < 8; ++q) { const float w0 = tp[(4 * q) * 33], w1 = tp[(4 * q + 1) * 33], w2 = tp[(4 * q + 2) * 33], w3 = tp[(4 * q + 3) * 33];
#pragma unroll
            for (int r = 0; r < 5; ++r) { const v4f s = *(const v4f*)(shp + (size_t)r * NMODC + 4 * q); s5[r] += (s.x * w0 + s.y * w1) + (s.z * w2 + s.w * w3); } }
#pragma unroll
        for (int r = 0; r < 5; ++r) { s5[r] += __shfl_xor(s5[r], 32); if (lane < 32) unsafeAtomicAdd(sw + (size_t)r * N + n0 + n, s5[r]); }
    }
    LDS_WAIT(); asm volatile("" ::: "memory");
}
constexpr int CI_IN = (DM / 64) * (INC / 32), CI_OUT = (DM / 64) * (DM / 32), CI_UP = (DM / 64) * (UPC / 32), CI_DN = (DFF / 64) * (DM / 32);
template <int SEL>
__device__ __forceinline__ void convert_item(int l, int r, kptr_t kp, unsigned char* ws, LAS float* scr, int lane);
template <int SEL> constexpr int convert_count() { return ((SEL & 1) ? CI_IN : 0) + ((SEL & 2) ? CI_OUT : 0) + ((SEL & 4) ? CI_UP : 0) + ((SEL & 8) ? CI_DN : 0); }
__device__ __forceinline__ void norm_phase(const float* X, bf16* H, const float* g, const float* mod_l, int jshift, int jscale, bool skip_ctx, int gw, int NGW, int lane) {
    for (int m = gw; m < R; m += NGW) {
        const int b = m / TB, t = m - b * TB; const bool isc = t >= SEQ; if (isc && skip_ctx) continue;
        const float* mrow = mod_l + (size_t)(isc ? 4 : b) * NMODC;
        const v4f* xr = (const v4f*)(X + (size_t)m * DM) + lane;
        v4f v[8]; float ss = 0.f;
#pragma unroll
        for (int j = 0; j < 8; ++j) { v[j] = xr[64 * j]; ss += (v[j].x * v[j].x + v[j].y * v[j].y) + (v[j].z * v[j].z + v[j].w * v[j].w); }
        const float rstd = 1.0f / sqrtf(wave_sum(ss) * (1.f / DM) + EPS);
#pragma unroll
        for (int j = 0; j < 8; ++j) { const int c = 4 * lane + 256 * j;
            const v4f gg = *(const v4f*)(g + c), sh = *(const v4f*)(mrow + jshift * DM + c), sc = *(const v4f*)(mrow + jscale * DM + c);
            const v4f y = v[j] * rstd * gg * (1.f + sc) + sh;
            v2u w; w.x = pk2(y.x, y.y); w.y = pk2(y.z, y.w);
            *(v2u*)(H + (size_t)m * DM + c) = w; }
    }
}
__device__ __forceinline__ void qknorm_phase(const bf16* PROJ, bf16* QN, bf16* KN, const float* qg, const float* kg, const float* rcos, const float* rsin, int gw, int NGW, int lane) {
    const float qg0 = qg[2 * lane], qg1 = qg[2 * lane + 1], kg0 = kg[2 * lane], kg1 = kg[2 * lane + 1];
#pragma unroll 1
    for (int m0 = 4 * gw; m0 < R; m0 += 4 * NGW) {
        unsigned w2[4][10];
#pragma unroll
        for (int rr = 0; rr < 4; ++rr)
#pragma unroll
            for (int hh = 0; hh < 10; ++hh) w2[rr][hh] = *(const unsigned*)(PROJ + (size_t)(m0 + rr) * INC + hh * 128 + 2 * lane);
#pragma unroll
        for (int rr = 0; rr < 4; ++rr) {
            const int m = m0 + rr, b = m / TB, t = m - b * TB; const bool lat = t < SEQ;
            float cs = 1.f, sn = 0.f;
            if (lat) { const int pos = (lane < 32) ? (t >> 6) : (t & 63); cs = rcos[pos * 32 + (lane & 31)]; sn = rsin[pos * 32 + (lane & 31)]; }
#pragma unroll
            for (int hh = 0; hh < 10; ++hh) {
                const float x1 = bf2f(w2[rr][hh] & 0xffffu), x2 = bf2f(w2[rr][hh] >> 16);
                const float rstd = __builtin_amdgcn_rsqf(wave_sum(x1 * x1 + x2 * x2) * (1.f / 128.f) + EPS);
                const float y1 = x1 * rstd * (hh < 8 ? qg0 : kg0), y2 = x2 * rstd * (hh < 8 ? qg1 : kg1);
                const float o1 = y1 * cs - y2 * sn, o2 = y1 * sn + y2 * cs;
                bf16* dst = hh < 8 ? QN + (size_t)m * 1024 + hh * 128 + 2 * lane : KN + (size_t)m * 256 + (hh - 8) * 128 + 2 * lane;
                *(unsigned*)dst = cvtpk_rne(o1, o2);
            }
        }
    }
}
typedef short hbf16x8 __attribute__((ext_vector_type(8)));
__device__ __forceinline__ v4f mfma_bf(v4u a, v4u b, v4f c) { return __builtin_amdgcn_mfma_f32_16x16x32_bf16(__builtin_bit_cast(hbf16x8, a), __builtin_bit_cast(hbf16x8, b), c, 0, 0, 0); }
__device__ __forceinline__ unsigned cvtpk_hw(float lo, float hi) { return cvtpk_rne(lo, hi); }
constexpr int SG_PB = 272;
__device__ __forceinline__ void sg_unit(int b, int n, int g, int l, const bf16* PROJ, bf16* MIX, const float* sgg, const float* sgw, const float* sgb, LAS unsigned char* Vt, int tid, int lane, int wave) {
    const int row0 = b * TB + n * 128, c4 = lane >> 4, l15 = lane & 15;
    v4u wf[4];
    {   const float* W = sgw + ((size_t)(l * 4 + g) * 128 + 16 * wave + l15) * 128 + 8 * c4;
#pragma unroll
        for (int ks = 0; ks < 4; ++ks) { const v4f a0 = *(const v4f*)(W + 32 * ks), a1 = *(const v4f*)(W + 32 * ks + 4);
            wf[ks].x = cvtpk_hw(a0.x, a0.y); wf[ks].y = cvtpk_hw(a0.z, a0.w); wf[ks].z = cvtpk_hw(a1.x, a1.y); wf[ks].w = cvtpk_hw(a1.z, a1.w); } }
    const size_t orow = (size_t)(row0 + 16 * wave + l15);
    v2u uraw[8];
#pragma unroll
    for (int dt = 0; dt < 8; ++dt) uraw[dt] = *(const v2u*)(PROJ + orow * INC + C_SU + g * 128 + 16 * dt + 4 * c4);
    const float bsv = sgb[(l * 4 + g) * 128 + 16 * wave + l15];
    {
        const int s = tid >> 2, q = tid & 3;
        const v4u* src = (const v4u*)(PROJ + (size_t)(row0 + s) * INC + C_SV + g * 128 + 32 * q);
        float ge[32]; float ss = 0.f;
#pragma unroll
        for (int i = 0; i < 4; ++i) { const v4u w = src[i];
#pragma unroll
            for (int e = 0; e < 4; ++e) { const float a0 = gelu_tanh(bf2f(w[e] & 0xffffu)), a1 = gelu_tanh(bf2f(w[e] >> 16)); ge[8 * i + 2 * e] = a0; ge[8 * i + 2 * e + 1] = a1; ss += a0 * a0 + a1 * a1; } }
        ss += __shfl_xor(ss, 1); ss += __shfl_xor(ss, 2);
        const float rstd = 1.0f / sqrtf(ss * (1.f / 128.f) + EPS);
        const float* gp = sgg + g * 128 + 32 * q;
#pragma unroll
        for (int i = 0; i < 32; ++i) *(LAS bf16*)(Vt + (32 * q + i) * SG_PB + 2 * s) = (bf16)(cvtpk_hw(ge[i] * rstd * gp[i], 0.f) & 0xffffu);
    }
    LDS_BAR();
#pragma unroll
    for (int dt = 0; dt < 8; ++dt) {
        v4f acc = (v4f){0.f, 0.f, 0.f, 0.f};
#pragma unroll
        for (int ks = 0; ks < 4; ++ks) acc = mfma_bf(*(const LAS v4u*)(Vt + (16 * dt + l15) * SG_PB + (32 * ks + 8 * c4) * 2), wf[ks], acc);
        const float u0 = gelu_tanh(bf2f(uraw[dt].x & 0xffffu)), u1 = gelu_tanh(bf2f(uraw[dt].x >> 16)), u2 = gelu_tanh(bf2f(uraw[dt].y & 0xffffu)), u3 = gelu_tanh(bf2f(uraw[dt].y >> 16));
        v2u o; o.x = cvtpk_hw(u0 * (acc[0] + bsv), u1 * (acc[1] + bsv)); o.y = cvtpk_hw(u2 * (acc[2] + bsv), u3 * (acc[3] + bsv));
        *(v2u*)(MIX + orow * DM + 1536 + g * 128 + 16 * dt + 4 * c4) = o;
    }
    LDS_BAR();
}

__device__ __forceinline__ int hg_row(int b, int dir, int P) {
    if (P < CTXL) return b * TB + SEQ + (dir ? CTXL - 1 - P : P);
    const int t = P - CTXL; return b * TB + (dir ? SEQ - 1 - t : t);
}
constexpr int NCH = 136, SCH = 17, NSC = NCH / SCH;
constexpr size_t WS_QF = 966 * MiB, WS_KF = 1000 * MiB, WS_VF = 1034 * MiB, WS_PF = 1068 * MiB, WS_DF = 1077 * MiB;
static_assert(WS_DF + (size_t)32 * NCH * 512 <= WS_GS, "fragment buffers inside the mixer-half scratch");
constexpr int PL_DD = 53248  , PL_T = 0, PL_QF = 4096, PL_KF = PL_QF + 8192, PL_VF = PL_KF + 8192, PL_PF = PL_VF + 8192, PL_QP = PL_PF + 2048, PL_KP1 = PL_QP + 8704, PL_KP0 = PL_KP1 + 8704;

__device__ __forceinline__ unsigned bf1(float x) { return cvtpk_hw(x, 0.f) & 0xffffu; }
__device__ __forceinline__ void hgrn_pre(int l, const bf16* PROJ, const float* LBS, unsigned char* QF, unsigned char* KF, unsigned char* VF, unsigned char* PF, float* DF, float* HS, float* HD,
                                         LAS unsigned char* L, int bx, int G, int tid, int lane, int wave) {
    const int kp = lane, jj = wave, c4 = lane >> 4, l15 = lane & 15;
    constexpr float LOG2E = 1.4426950408889634f, CLAMP2 = 115.f;
    LAS v2f* T = (LAS v2f*)(L + PL_T);
    unsigned zr[4], qr[4], vr[4];
#define PRE_LOAD(it_) do { const int ch_ = (it_) / NCH, ci_ = (it_) - ch_ * NCH, dir_ = ch_ & 1, bh_ = ch_ >> 1, h_ = bh_ & 3; \
        const bf16* pr_ = PROJ + (size_t)hg_row(bh_ >> 2, dir_, 32 * ci_ + 4 * jj) * INC + h_ * 128 + 2 * kp; const long st_ = dir_ ? -(long)INC : (long)INC; const int cf_ = dir_ ? C_HFB : C_HFF; \
        _Pragma("unroll") for (int i = 0; i < 4; ++i) { zr[i] = *(const unsigned*)(pr_ + cf_); qr[i] = *(const unsigned*)(pr_ + C_HQ); vr[i] = *(const unsigned*)(pr_ + C_HI); pr_ += st_; } } while (0)
#pragma unroll 1
    for (int s = bx; s < 32 * NSC; s += G) {
    v4f acc[8], dprod[8];
#pragma unroll
    for (int kt = 0; kt < 8; ++kt) { acc[kt] = (v4f){0.f, 0.f, 0.f, 0.f}; dprod[kt] = (v4f){1.f, 1.f, 1.f, 1.f}; }
    const int it0 = (s >> 3) * NCH + (s & 7) * SCH;
    PRE_LOAD(it0);
#pragma unroll 1
    for (int it = it0; it < it0 + SCH; ++it) {
        const int chain = it / NCH;
        const int dir = chain & 1, h = (chain >> 1) & 3;
        const v2f lb2 = *(const v2f*)(LBS + (dir * DEPTH + l) * 512 + h * 128 + 2 * kp);
        float cs[2][4], kk[2][4], qq[2][4];
#pragma unroll
        for (int i = 0; i < 4; ++i)
#pragma unroll
            for (int e = 0; e < 2; ++e) {
                float z = bf2f(e ? zr[i] >> 16 : zr[i] & 0xffffu); z = fminf(fmaxf(z, -40.f), 40.f);
                const float q = bf2f(e ? qr[i] >> 16 : qr[i] & 0xffffu);
                qq[e][i] = q * __builtin_amdgcn_rcpf(1.f + __builtin_amdgcn_exp2f(-q * LOG2E));
                const float lb = e ? lb2.y : lb2.x, oml = 1.f - lb;
                const float ez = __builtin_amdgcn_exp2f(-z * LOG2E), sg = __builtin_amdgcn_rcpf(1.f + ez);
                cs[e][i] = __builtin_amdgcn_logf(fmaxf(lb + oml * sg, 1e-30f)); kk[e][i] = oml * ez * sg;
            }
        v2u vfa, vfb;
        vfa.x = (vr[0] & 0xffffu) | (vr[1] << 16); vfa.y = (vr[2] & 0xffffu) | (vr[3] << 16);
        vfb.x = (vr[0] >> 16) | (vr[1] & 0xffff0000u); vfb.y = (vr[2] >> 16) | (vr[3] & 0xffff0000u);
        if (it + 1 < it0 + SCH) PRE_LOAD(it + 1);
#pragma unroll
        for (int e = 0; e < 2; ++e)
#pragma unroll
            for (int i = 1; i < 4; ++i) cs[e][i] += cs[e][i - 1];
        T[jj * 64 + kp] = (v2f){cs[0][3], cs[1][3]};
        LDS_BAR();
        v2f pre = (v2f){0.f, 0.f}, bend = pre, b15 = pre;
#pragma unroll
        for (int w = 0; w < 8; ++w) { const v2f t = T[w * 64 + kp]; bend += t; if (w < 4) b15 += t; if (w < jj) pre += t; }
        LAS unsigned char* qfp = L + PL_QF + (((jj >> 2) * 4 + (kp >> 4)) * 64 + ((kp >> 1) & 3) * 16 + 4 * (jj & 3)) * 16 + (4 * ((kp >> 3) & 1) + 2 * (kp & 1)) * 2;
        LAS unsigned char* qpp = L + PL_QP + (4 * jj) * 272 + 4 * kp;
        float kh[2][4];
#pragma unroll
        for (int i = 0; i < 4; ++i) {
            float qt[2], qp[2], kp1[2], kp0[2];
#pragma unroll
            for (int e = 0; e < 2; ++e) {
                const float bi = (e ? pre.y : pre.x) + cs[e][i], be = e ? bend.y : bend.x, bm = e ? b15.y : b15.x;
                qt[e] = qq[e][i] * __builtin_amdgcn_exp2f(bi);
                kh[e][i] = kk[e][i] * __builtin_amdgcn_exp2f(be - bi);
                qp[e] = (jj < 4) ? qt[e] : qq[e][i] * __builtin_amdgcn_exp2f(bi - bm);
                kp1[e] = kk[e][i] * __builtin_amdgcn_exp2f(fminf(bm - bi, CLAMP2));
                kp0[e] = (jj < 4) ? kk[e][i] * __builtin_amdgcn_exp2f(fminf(-bi, CLAMP2)) : 0.f;
            }
            *(LAS unsigned*)(qfp + i * 16) = cvtpk_hw(qt[0], qt[1]);
            *(LAS unsigned*)(qpp + i * 272) = cvtpk_hw(qp[0], qp[1]);
            *(LAS unsigned*)(qpp + (PL_KP1 - PL_QP) + i * 272) = cvtpk_hw(kp1[0], kp1[1]);
            if (jj < 4) *(LAS unsigned*)(qpp + (PL_KP0 - PL_QP) + i * 272) = cvtpk_hw(kp0[0], kp0[1]);
        }
        {
            const int ka = 2 * kp, fo = ((ka >> 4) * 64 + (jj >> 1) * 16 + (ka & 15)) * 16 + 8 * (jj & 1);
            v2u w0, w1; w0.x = cvtpk_hw(kh[0][0], kh[0][1]); w0.y = cvtpk_hw(kh[0][2], kh[0][3]); w1.x = cvtpk_hw(kh[1][0], kh[1][1]); w1.y = cvtpk_hw(kh[1][2], kh[1][3]);
            *(LAS v2u*)(L + PL_KF + fo) = w0; *(LAS v2u*)(L + PL_KF + fo + 16) = w1;
            *(LAS v2u*)(L + PL_VF + fo) = vfa; *(LAS v2u*)(L + PL_VF + fo + 16) = vfb; }
        if (jj == 0) { const v2f dd = (v2f){__builtin_amdgcn_exp2f(bend.x), __builtin_amdgcn_exp2f(bend.y)}; *(v2f*)(DF + (size_t)it * 128 + 2 * kp) = dd; *(LAS v2f*)(L + PL_DD + 8 * kp) = dd; }
        LDS_BAR();
        if (wave < 3) {
            const LAS unsigned char* qa = L + PL_QP + ((wave == 0 ? 0 : 16) + l15) * 272 + c4 * 16;
            const LAS unsigned char* kb = (wave == 0 ? L + PL_KP0 + l15 * 272 : L + PL_KP1 + ((wave == 2 ? 16 : 0) + l15) * 272) + c4 * 16;
            v4f p = (v4f){0.f, 0.f, 0.f, 0.f};
#pragma unroll
            for (int s = 0; s < 4; ++s) p = mfma_bf(*(const LAS v4u*)(qa + s * 64), *(const LAS v4u*)(kb + s * 64), p);
            const int mt = wave == 0 ? 0 : 1, sidx = (wave == 2 ? 16 : 0) + l15;
#pragma unroll
            for (int r = 0; r < 4; ++r) { const int tl = 4 * c4 + r; const float v = (wave == 1 || l15 <= tl) ? p[r] : 0.f;
                *(LAS bf16*)(L + PL_PF + (mt * 64 + (sidx >> 3) * 16 + tl) * 16 + (sidx & 7) * 2) = (bf16)bf1(v); }
        } else if (wave == 3) {
            if (lane < 32) { unsigned zz; asm volatile("v_mov_b32 %0, 0" : "=v"(zz)); *(LAS v4u*)(L + PL_PF + (32 + lane) * 16) = (v4u){zz, zz, zz, zz}; }
        }
        LDS_BAR();
        if ((s & 7) < NSC - 1) {
            const v4u vfr = *(const LAS v4u*)(L + PL_VF + (wave * 64 + lane) * 16);
#pragma unroll
            for (int kt = 0; kt < 8; ++kt) { const v4f d = *(const LAS v4f*)(L + PL_DD + (16 * kt + 4 * c4) * 4);
                acc[kt] = acc[kt] * d; acc[kt] = mfma_bf(*(const LAS v4u*)(L + PL_KF + (kt * 64 + lane) * 16), vfr, acc[kt]); dprod[kt] = dprod[kt] * d; }
        }
        *(v4u*)(QF + (size_t)it * 8192 + tid * 16) = *(const LAS v4u*)(L + PL_QF + tid * 16);
        *(v4u*)(KF + (size_t)it * 8192 + tid * 16) = *(const LAS v4u*)(L + PL_KF + tid * 16);
        *(v4u*)(VF + (size_t)it * 8192 + tid * 16) = *(const LAS v4u*)(L + PL_VF + tid * 16);
        if (tid < 128) *(v4u*)(PF + (size_t)it * 2048 + tid * 16) = *(const LAS v4u*)(L + PL_PF + tid * 16);
    }
    if ((s & 7) < NSC - 1) {
        float* slot = HS + (size_t)s * 16384;
#pragma unroll
        for (int kt = 0; kt < 8; ++kt)
#pragma unroll
            for (int r = 0; r < 4; ++r) slot[(16 * kt + 4 * c4 + r) * 128 + 16 * wave + l15] = acc[kt][r];
        if (wave == 0 && l15 == 0) {
#pragma unroll
            for (int kt = 0; kt < 8; ++kt) *(v4f*)(HD + (size_t)s * 128 + 16 * kt + 4 * c4) = dprod[kt];
        }
    }
    LDS_BAR();
    }
#undef PRE_LOAD
}
constexpr int HU_Q = 0, HU_K = 8192, HU_P = 16384, HU_D = 18432, HU_SLOT = 18944, HU_OT = 2 * HU_SLOT + 1024  ;
template <bool WITH_OUT>
__device__ __forceinline__ void hgrn_unit2(int chain, int sc, const unsigned char* QF, const unsigned char* KF, const unsigned char* VF, const unsigned char* PF, const float* DF,
                                           float* HS, float* HD, bf16* HO, LAS unsigned char* L, int tid, int lane, int wave) {
    static_assert(WITH_OUT, "the local-state recurrence lives in hgrn_pre now");
    const int dir = chain & 1, bh = chain >> 1, b = bh >> 2, h = bh & 3, c4 = lane >> 4, l15 = lane & 15;
    v4f acc[8];
    const size_t item0 = (size_t)chain * NCH + sc * SCH;
    v4u rq0, rk0, rp0, rd0, vf0, rq1, rk1, rp1, rd1, vf1, rq2, rk2, rp2, rd2, vf2, rq3, rk3, rp3, rd3, vf3, vf;
#define HU_LOAD(S_, it_) do { rq##S_ = *(const v4u*)(QF + (it_) * 8192 + tid * 16); rk##S_ = *(const v4u*)(KF + (it_) * 8192 + tid * 16); \
        if (tid < 128) rp##S_ = *(const v4u*)(PF + (it_) * 2048 + tid * 16); if (tid < 32) rd##S_ = *(const v4u*)((const unsigned char*)DF + (it_) * 512 + tid * 16); \
        vf##S_ = ((const v4u*)(VF + (it_) * 8192))[wave * 64 + lane]; } while (0)
#define HU_WRITE(S_, s_) do { LAS unsigned char* sl_ = L + (s_) * HU_SLOT; *(LAS v4u*)(sl_ + HU_Q + tid * 16) = rq##S_; *(LAS v4u*)(sl_ + HU_K + tid * 16) = rk##S_; \
        if (tid < 128) *(LAS v4u*)(sl_ + HU_P + tid * 16) = rp##S_; if (tid < 32) *(LAS v4u*)(sl_ + HU_D + tid * 16) = rd##S_; } while (0)
#define HU_FLUSH(step_) do { const int t_ = tid >> 4; const int row_ = hg_row(b, dir, 32 * (sc * SCH + (step_)) + t_); \
        *(v4u*)(HO + ((size_t)dir * R + row_) * 512 + h * 128 + 8 * (tid & 15)) = *(const LAS v4u*)(L + HU_OT + ((step_) & 1) * 8192 + tid * 16); } while (0)
#define HU_COMPUTE(step_) do { const LAS unsigned char* sl = L + ((step_) & 1) * HU_SLOT; \
        v4u sb[4]; \
        _Pragma("unroll") for (int ks = 0; ks < 4; ++ks) { sb[ks].x = cvtpk_hw(acc[2 * ks][0], acc[2 * ks][1]); sb[ks].y = cvtpk_hw(acc[2 * ks][2], acc[2 * ks][3]); \
            sb[ks].z = cvtpk_hw(acc[2 * ks + 1][0], acc[2 * ks + 1][1]); sb[ks].w = cvtpk_hw(acc[2 * ks + 1][2], acc[2 * ks + 1][3]); } \
        _Pragma("unroll") for (int mt = 0; mt < 2; ++mt) { \
            v4f o = (v4f){0.f, 0.f, 0.f, 0.f}; \
            _Pragma("unroll") for (int ks = 0; ks < 4; ++ks) o = mfma_bf(*(const LAS v4u*)(sl + HU_Q + ((mt * 4 + ks) * 64 + lane) * 16), sb[ks], o); \
            o = mfma_bf(*(const LAS v4u*)(sl + HU_P + (mt * 64 + lane) * 16), vf, o); \
            _Pragma("unroll") for (int r = 0; r < 4; ++r) *(LAS bf16*)(L + HU_OT + ((step_) & 1) * 8192 + ((16 * mt + 4 * c4 + r) * 128 + 16 * wave + l15) * 2) = (bf16)bf1(o[r]); } \
        _Pragma("unroll") for (int kt = 0; kt < 8; ++kt) { const v4f d = *(const LAS v4f*)(sl + HU_D + (16 * kt + 4 * c4) * 4); \
            acc[kt] = acc[kt] * d; acc[kt] = mfma_bf(*(const LAS v4u*)(sl + HU_K + (kt * 64 + lane) * 16), vf, acc[kt]); } } while (0)
    HU_LOAD(0, item0);
    HU_LOAD(1, item0 + 1);
    HU_LOAD(2, item0 + 2);
    if (sc > 0) {
        const float* slot = HS + (size_t)(chain * NSC + sc - 1) * 16384;
#pragma unroll
        for (int kt = 0; kt < 8; ++kt)
#pragma unroll
            for (int r = 0; r < 4; ++r) acc[kt][r] = slot[(16 * kt + 4 * c4 + r) * 128 + 16 * wave + l15];
    } else {
#pragma unroll
        for (int kt = 0; kt < 8; ++kt) acc[kt] = (v4f){0.f, 0.f, 0.f, 0.f};
    }
    HU_WRITE(0, 0); vf = vf0;
    LDS_BAR();
#define HU_STEP(s_, SL_, SW_) do { if ((s_) < SCH) { if ((s_) + 3 < SCH) HU_LOAD(SL_, item0 + (s_) + 3); if ((s_) > 0) HU_FLUSH((s_) - 1); HU_COMPUTE(s_); \
        if ((s_) + 1 < SCH) { HU_WRITE(SW_, ((s_) + 1) & 1); vf = vf##SW_; } LDS_BAR(); } } while (0)
#pragma unroll 1
    for (int step = 0; step < SCH; step += 4) { HU_STEP(step, 3, 1); HU_STEP(step + 1, 0, 2); HU_STEP(step + 2, 1, 3); HU_STEP(step + 3, 2, 0); }
    HU_FLUSH(SCH - 1);
    LDS_BAR();
#undef HU_STEP
#undef HU_LOAD
#undef HU_WRITE
#undef HU_COMPUTE
#undef HU_FLUSH
    (void)HD;
}
__device__ __forceinline__ void hgrn_scan(float* HS, const float* HD, int gtid, int NT) {
    for (int e = gtid; e < 32 * 4096; e += NT) {
        const int chain = e >> 12, q4 = e & 4095, k = q4 >> 5;
        v4f* p = (v4f*)(HS + (size_t)chain * NSC * 16384) + q4; const float* dp = HD + chain * NSC * 128 + k;
        v4f tmp[NSC - 1]; float dd[NSC - 1];
#pragma unroll
        for (int s = 0; s < NSC - 1; ++s) { tmp[s] = p[(size_t)s * 4096]; dd[s] = dp[s * 128]; }
        v4f st = (v4f){0.f, 0.f, 0.f, 0.f};
#pragma unroll
        for (int s = 0; s < NSC - 1; ++s) { st = st * dd[s] + tmp[s]; p[(size_t)s * 4096] = st; }
    }
}
__device__ __forceinline__ void hg_combine(const bf16* HO, const bf16* PROJ, bf16* MIX, const float* hgg, bool skip_ctx, int gw, int NGW, int lane) {
    const float g0 = hgg[2 * lane], g1 = hgg[2 * lane + 1];
#pragma unroll 1
    for (int m0 = 4 * gw; m0 < R; m0 += 4 * NGW) {
        const int b = m0 / TB, t = m0 - b * TB; if (t >= SEQ && skip_ctx) continue;
        unsigned a[4][4], c[4][4], w2[4][4];
#pragma unroll
        for (int rr = 0; rr < 4; ++rr)
#pragma unroll
            for (int h = 0; h < 4; ++h) { const bf16* p0 = HO + (size_t)(m0 + rr) * 512 + h * 128 + 2 * lane;
                a[rr][h] = *(const unsigned*)p0; c[rr][h] = *(const unsigned*)(p0 + (size_t)R * 512);
                w2[rr][h] = *(const unsigned*)(PROJ + (size_t)(m0 + rr) * INC + C_HGT + h * 128 + 2 * lane); }
#pragma unroll
        for (int rr = 0; rr < 4; ++rr)
#pragma unroll
            for (int h = 0; h < 4; ++h) {
                const float o0 = bf2f(a[rr][h] & 0xffffu) + bf2f(c[rr][h] & 0xffffu), o1 = bf2f(a[rr][h] >> 16) + bf2f(c[rr][h] >> 16);
                const float rstd = __builtin_amdgcn_rsqf(wave_sum(o0 * o0 + o1 * o1) * (1.f / 128.f) + EPS);
                const float y0 = o0 * rstd * g0 * silu_f(bf2f(w2[rr][h] & 0xffffu)), y1 = o1 * rstd * g1 * silu_f(bf2f(w2[rr][h] >> 16));
                *(unsigned*)(MIX + (size_t)(m0 + rr) * DM + 1024 + h * 128 + 2 * lane) = cvtpk_rne(y0, y1);
            }
    }
}
__device__ __forceinline__ void conv_act_phase(const bf16* UP, bf16* ACT, const float* cw, const float* cb, bool skip_ctx, int gtid, int NT) {
    constexpr int NOCT = DFF / 8, NSTRIP = R / 32;
    for (int it = gtid; it < NSTRIP * NOCT; it += NT) {
        const int strip = it / NOCT, oc = it - strip * NOCT, wi = strip % (TB / 32), c0 = oc * 8;
        if (skip_ctx && wi >= SEQ / 32) continue;
        const bool seg_start = (wi == 0 || wi == SEQ / 32), seg_end = (wi == SEQ / 32 - 1 || wi == TB / 32 - 1);
        float w[2][3][8], bb[2][8];
#pragma unroll
        for (int hlf = 0; hlf < 2; ++hlf) {
#pragma unroll
            for (int jj = 0; jj < 3; ++jj) { const v4f a0 = *(const v4f*)(cw + (size_t)jj * UPC + hlf * DFF + c0), a1 = *(const v4f*)(cw + (size_t)jj * UPC + hlf * DFF + c0 + 4);
                w[hlf][jj][0] = a0.x; w[hlf][jj][1] = a0.y; w[hlf][jj][2] = a0.z; w[hlf][jj][3] = a0.w; w[hlf][jj][4] = a1.x; w[hlf][jj][5] = a1.y; w[hlf][jj][6] = a1.z; w[hlf][jj][7] = a1.w; }
            const v4f b0 = *(const v4f*)(cb + hlf * DFF + c0), b1 = *(const v4f*)(cb + hlf * DFF + c0 + 4);
            bb[hlf][0] = b0.x; bb[hlf][1] = b0.y; bb[hlf][2] = b0.z; bb[hlf][3] = b0.w; bb[hlf][4] = b1.x; bb[hlf][5] = b1.y; bb[hlf][6] = b1.z; bb[hlf][7] = b1.w;
        }
        const size_t r0 = (size_t)strip * 32;
#pragma unroll 1
        for (int sb = 0; sb < 4; ++sb) {
            v4u gr[10], vr[10];
#pragma unroll
            for (int j = 0; j < 10; ++j) {
                const bool zero = (j == 0 && sb == 0 && seg_start) || (j == 9 && sb == 3 && seg_end);
                if (!zero) { const size_t rr = r0 + 8 * sb + j - 1; gr[j] = *(const v4u*)(UP + rr * UPC + c0); vr[j] = *(const v4u*)(UP + rr * UPC + DFF + c0); }
                else { gr[j] = (v4u){0u, 0u, 0u, 0u}; vr[j] = gr[j]; }
            }
#pragma unroll
            for (int i = 0; i < 8; ++i) {
                v4u o;
#pragma unroll
                for (int q = 0; q < 4; ++q) {
                    float res[2];
#pragma unroll
                    for (int e = 0; e < 2; ++e) {
                        const int ci = 2 * q + e;
                        const float gp = e ? bf2f(gr[i][q] >> 16) : bf2f(gr[i][q] & 0xffffu), gc = e ? bf2f(gr[i + 1][q] >> 16) : bf2f(gr[i + 1][q] & 0xffffu), gn = e ? bf2f(gr[i + 2][q] >> 16) : bf2f(gr[i + 2][q] & 0xffffu);
                        const float vp = e ? bf2f(vr[i][q] >> 16) : bf2f(vr[i][q] & 0xffffu), vc = e ? bf2f(vr[i + 1][q] >> 16) : bf2f(vr[i + 1][q] & 0xffffu), vn = e ? bf2f(vr[i + 2][q] >> 16) : bf2f(vr[i + 2][q] & 0xffffu);
                        const float yg = bb[0][ci] + w[0][0][ci] * gp + w[0][1][ci] * gc + w[0][2][ci] * gn;
                        const float yv = bb[1][ci] + w[1][0][ci] * vp + w[1][1][ci] * vc + w[1][2][ci] * vn;
                        res[e] = silu_f(yg) * yv;
                    }
                    o[q] = cvtpk_rne(res[0], res[1]);
                }
                *(v4u*)(ACT + (r0 + 8 * sb + i) * DFF + c0) = o;
            }
        }
    }
}

__device__ __forceinline__ kptr_t kargs_fresh() { kptr_t p = (kptr_t)__builtin_amdgcn_kernarg_segment_ptr(); asm volatile("" : "+s"(p)); return p; }
#define KIN(i)  (*(const float* const AS4*)(kp + 8 * (i)))
#define KOUT()  (*(float* const AS4*)(kp + 176))
#define KWS()   (*(unsigned char* const AS4*)(kp + 184))
#define PH_BEGIN \
    int tid = threadIdx.x; asm volatile("" : "+v"(tid)); \
    const int lane = tid & 63, wave = __builtin_amdgcn_readfirstlane(tid >> 6); \
    int bx = blockIdx.x; asm volatile("" : "+s"(bx)); int G = gridDim.x; asm volatile("" : "+s"(G)); \
    const int gw = bx * NWAVES + wave, NGW = G * NWAVES, gtid = bx * NTHR + tid, NT = G * NTHR; \
    const kptr_t kp = kargs_fresh(); unsigned char* const ws = KWS(); \
    (void)lane; (void)gw; (void)NGW; (void)gtid; (void)NT; (void)ws;

template <int SEL>
__device__ __forceinline__ void convert_item(int l, int r, kptr_t kp, unsigned char* ws, LAS float* scr, int lane) {
    unsigned char* wb = ws + WS_W + (size_t)l * W_LAYER; const float* MOD = (const float*)(ws + WS_MOD) + (size_t)l * 5 * NMODC;
    if (SEL & 1) { if (r < CI_IN) { p0_transpose_item<true>(KIN(I_WIN) + (size_t)l * DM * INC, DM, INC, (bf16*)(wb + W_IN), scr, r, lane, (float*)(ws + WS_SWIN) + (size_t)l * 5 * INC, MOD + 0 * DM); return; } r -= CI_IN; }
    if (SEL & 2) { if (r < CI_OUT) { p0_transpose_item<false>(KIN(I_WOUT) + (size_t)l * DM * DM, DM, DM, (bf16*)(wb + W_OUT), scr, r, lane, nullptr, nullptr); return; } r -= CI_OUT; }
    if (SEL & 4) { if (r < CI_UP) { p0_transpose_item<true>(KIN(I_WUP) + (size_t)l * DM * UPC, DM, UPC, (bf16*)(wb + W_UP), scr, r, lane, (float*)(ws + WS_SWUP) + (size_t)l * 5 * UPC, MOD + 3 * DM); return; } r -= CI_UP; }
    if (SEL & 8) { p0_transpose_item<false>(KIN(I_WDN) + (size_t)l * DFF * DM, DFF, DM, (bf16*)(wb + W_DN), scr, r, lane, nullptr, nullptr); }
}

__global__ void __launch_bounds__(NTHR, 2) mk_fwd(Args a_unused) {
    extern __shared__ __attribute__((aligned(16))) unsigned char lds[];
    LAS unsigned char* ldsp = (LAS unsigned char*)lds;
    int lo, hi;
    { const kptr_t kp = kargs_fresh(); lo = *(const int AS4*)(kp + 192); hi = *(const int AS4*)(kp + 196); }
    for (int u = threadIdx.x; u < (LDS_BYTES - LDSCTL_OFF) / 4; u += NTHR) ((LAS unsigned*)(ldsp + LDSCTL_OFF))[u] = 0u;
    __syncthreads();
#if MK_ONE_LAUNCH
    XcdBarrier bar;
    { const kptr_t kp = kargs_fresh(); bar = xcd_barrier_post((unsigned*)(KWS() + WS_CTL) + CW_BAR, (volatile LAS unsigned*)(ldsp + MISC_OFF) + 8); }
#define GRID_BAR() xcd_barrier(bar)
#else
#define GRID_BAR() do { } while (0)
#endif
#define IN(k) (lo <= (k) && (k) < hi)

    if (IN(0)) {
        PH_BEGIN
        float* MOD = (float*)(ws + WS_MOD);
        p0_mod(KIN(I_C), KIN(I_CCTX), KIN(I_WADA), KIN(I_BADA), ldsp, MOD, tid, lane, wave, bx, G);
        if (bx == G - 1) {
            float* LBS = (float*)(ws + WS_MISC); float* RCOS = (float*)(ws + WS_MISC + 16384); float* RSIN = (float*)(ws + WS_MISC + 24576);
            const float* lbp = KIN(I_LBP);
            for (int i = tid; i < 1024; i += NTHR) { const int dir = i >> 9, ci = i & 511; float v[DEPTH], mx = -3.0e38f;
#pragma unroll
                for (int l = 0; l < DEPTH; ++l) { v[l] = lbp[(dir * DEPTH + l) * 512 + ci]; mx = fmaxf(mx, v[l]); }
                float s = 0.f;
#pragma unroll
                for (int l = 0; l < DEPTH; ++l) { v[l] = expf(v[l] - mx); s += v[l]; }
                float cum = 0.f;
#pragma unroll
                for (int l = 0; l < DEPTH; ++l) { if (l > 0) cum += v[l] / s; LBS[(dir * DEPTH + l) * 512 + ci] = cum; } }
            for (int i = tid; i < 2048; i += NTHR) { const int pos = i >> 5, fi = i & 31; const float inv = powf(10000.f, -(float)fi / 32.f); const float ang = (float)pos * inv; RCOS[i] = cosf(ang); RSIN[i] = sinf(ang); }
        }
        __syncthreads();
        {
            LAS float* scr = (LAS float*)(ldsp + wave * 16384);
            for (int it = gw; it < convert_count<2 | 8>(); it += NGW) convert_item<2 | 8>(0, it, kp, ws, scr, lane);
        }
        GRID_BAR();
    }

    if (IN(1)) { PH_BEGIN
        const float* MOD = (const float*)(ws + WS_MOD);
        {
            const float* xin = KIN(I_X); const float* cin = KIN(I_CTX); bf16* H = (bf16*)(ws + WS_H); float* RS0 = (float*)(ws + WS_RS); const float* g = KIN(I_N1G);
            for (int m0 = 2 * gw; m0 < R; m0 += 2 * NGW) {
                v4f v[2][8];
#pragma unroll
                for (int rr = 0; rr < 2; ++rr) { const int m = m0 + rr, b = m / TB, t = m - b * TB;
                    const v4f* xr = (const v4f*)(t < SEQ ? xin + ((size_t)b * SEQ + t) * DM : cin + ((size_t)b * CTXL + (t - SEQ)) * DM) + lane;
#pragma unroll
                    for (int j = 0; j < 8; ++j) v[rr][j] = xr[64 * j]; }
#pragma unroll
                for (int rr = 0; rr < 2; ++rr) { const int m = m0 + rr, b = m / TB, t = m - b * TB; const float* mrow = MOD + (size_t)(t >= SEQ ? 4 : b) * NMODC; float ss = 0.f;
#pragma unroll
                    for (int j = 0; j < 8; ++j) { const v4f x = v[rr][j]; ss += (x.x * x.x + x.y * x.y) + (x.z * x.z + x.w * x.w); const int c = 4 * lane + 256 * j;
                        const v4f y = x * *(const v4f*)(g + c) * (1.f + *(const v4f*)(mrow + 1 * DM + c));
                        v2u w; w.x = cvtpk_rne(y.x, y.y); w.y = cvtpk_rne(y.z, y.w); *(v2u*)(H + (size_t)m * DM + c) = w; }
                    ss = wave_sum(ss); if (lane == 0) RS0[m] = ss; }
            } }
        {
            float* GS = (float*)(ws + WS_GS); const float* g1 = KIN(I_N1G); const float* g2 = KIN(I_N2G);
            for (int i = gtid; i < DEPTH * 2 * 5 * DM; i += NT) { const int c = i & (DM - 1), r = (i >> 11) % 5, wl = i / (5 * DM), which = wl & 1, l = wl >> 1;
                GS[i] = (which ? g2 : g1)[l * DM + c] * (1.f + MOD[(size_t)(l * 5 + r) * NMODC + (which ? 4 : 1) * DM + c]); } }
        {
            LAS float* scr = (LAS float*)(ldsp + wave * 16384);
            for (int it = gw; it < convert_count<1 | 4>(); it += NGW) convert_item<1 | 4>(0, it, kp, ws, scr, lane);
        }
        GRID_BAR();
    }

#pragma unroll 1
    for (int l = 0; l < DEPTH; ++l) {
        const int pb = 2 + 9 * l; const bool last = (l == DEPTH - 1);
#define MODL ((const float*)(ws + WS_MOD) + (size_t)l * 5 * NMODC)
#define WB   (ws + WS_W + (size_t)l * W_LAYER)
#define RSL(s_) ((float*)(ws + WS_RS) + (size_t)(s_) * R)
#define GSL(l_, which_) ((const float*)(ws + WS_GS) + (size_t)((l_) * 2 + (which_)) * 5 * DM)
        if (IN(pb + 0)) { PH_BEGIN
            pg8::Gemm g{(const bf16*)(ws + WS_H), (const bf16*)(WB + W_IN), R, INC, DM}; TileOrder S; S.init2(INC, G, bx, false);
            EpiBf16N E{(bf16*)(ws + WS_PROJ), INC, RSL(2 * l), (const float*)(ws + WS_SWIN) + (size_t)l * 5 * INC};
            pg8::gemm_phase<EpiBf16N, TileOrder, true, true>(ldsp, g, S, E);
            GRID_BAR();
        }
        if (IN(pb + 1)) { PH_BEGIN
            const bf16* PROJ = (const bf16*)(ws + WS_PROJ);
            qknorm_phase(PROJ, (bf16*)(ws + WS_QN), (bf16*)(ws + WS_KN), KIN(I_QG) + l * 128, KIN(I_KG) + l * 128, (const float*)(ws + WS_MISC + 16384), (const float*)(ws + WS_MISC + 24576), gw, NGW, lane);
            {   const int nch = last ? 32 : 34, nU = NB * nch * 4;
                for (int u = bx; u < nU; u += G) { const int g = u & 3, bn = u >> 2, b = bn / nch, n = bn - b * nch;
                    sg_unit(b, n, g, l, PROJ, (bf16*)(ws + WS_MIX), KIN(I_SGG) + l * 512, KIN(I_SGW), KIN(I_SGB), ldsp, tid, lane, wave); } }
            hgrn_pre(l, PROJ, (const float*)(ws + WS_MISC), ws + WS_QF, ws + WS_KF, ws + WS_VF, ws + WS_PF, (float*)(ws + WS_DF), (float*)(ws + WS_HS), (float*)(ws + WS_HD), ldsp, bx, G, tid, lane, wave);
            GRID_BAR();
        }
        if (IN(pb + 2)) { PH_BEGIN
            hgrn_scan((float*)(ws + WS_HS), (const float*)(ws + WS_HD), gtid, NT);
            const int nU = last ? 512 : 544;
            for (int u = bx; u < nU; u += G) {
                int b, hq, row_q, row_k, seq;
                if (u < 512) { const int xcd = u & 7, idx = u >> 3; b = xcd >> 1; hq = (xcd & 1) * 4 + (idx >> 4); row_k = b * TB; row_q = row_k + (idx & 15) * 256; seq = TB; }
                else { const int uc = u - 512; b = uc >> 3; hq = uc & 7; row_k = b * TB + SEQ; row_q = row_k; seq = CTXL; }
                const int kvh = hq >> 2;
                att::attn_dense_body((const bf16*)(ws + WS_QN) + (size_t)row_q * 1024 + hq * 128, (const bf16*)(ws + WS_KN) + (size_t)row_k * 256 + kvh * 128,
                                     (const bf16*)(ws + WS_PROJ) + (size_t)row_k * INC + C_AV + kvh * 128, (bf16*)(ws + WS_MIX) + (size_t)row_q * DM + hq * 128, seq, (char*)lds);
            }
            GRID_BAR();
        }
        if (IN(pb + 3)) { PH_BEGIN
            for (int u = bx; u < 32 * NSC; u += G) hgrn_unit2<true>(u & 31, u >> 5, ws + WS_QF, ws + WS_KF, ws + WS_VF, ws + WS_PF, (const float*)(ws + WS_DF), (float*)(ws + WS_HS), (float*)(ws + WS_HD), (bf16*)(ws + WS_HO), ldsp, tid, lane, wave);
            GRID_BAR();
        }
        if (IN(pb + 4)) { PH_BEGIN hg_combine((const bf16*)(ws + WS_HO), (const bf16*)(ws + WS_PROJ), (bf16*)(ws + WS_MIX), KIN(I_HGG) + l * 128, last, gw, NGW, lane); GRID_BAR(); }
        if (IN(pb + 5)) { PH_BEGIN
            pg8::Gemm g{(const bf16*)(ws + WS_MIX), (const bf16*)(WB + W_OUT), R, DM, DM};
            {   TileOrder S; S.init2(DM, G, bx, true);
                EpiResGate<true> E{(float*)(ws + WS_X), MODL, 2, (bf16*)(ws + WS_H), GSL(l, 1), RSL(2 * l + 1), l == 0 ? KIN(I_X) : nullptr, l == 0 ? KIN(I_CTX) : nullptr};
                pg8::gemm_phase<EpiResGate<true>, TileOrder, true, true>(ldsp, g, S, E); }
            if (!last) {
                const int nh = (G >= 64) ? 64 : G;
                __syncthreads();
                if (bx < nh) { CtxHalfOrder S{DM / 256, nh, bx};
                    EpiResGate<true, true> E{(float*)(ws + WS_X), MODL, 2, (bf16*)(ws + WS_H), GSL(l, 1), RSL(2 * l + 1), l == 0 ? KIN(I_X) : nullptr, l == 0 ? KIN(I_CTX) : nullptr};
                    pg8::gemm_phase<EpiResGate<true, true>, CtxHalfOrder, true, true>(ldsp, g, S, E); }
                const int nfull = (G > 64) ? 64 : 0; LAS float* scr = (LAS float*)(ldsp + wave * 16384);
                if (bx >= nfull) for (int it = (bx - nfull) * NWAVES + wave; it < convert_count<1 | 2>(); it += (G - nfull) * NWAVES) convert_item<1 | 2>(l + 1, it, kp, ws, scr, lane);
            }
            GRID_BAR();
        }
        if (IN(pb + 6)) { PH_BEGIN
            pg8::Gemm g{(const bf16*)(ws + WS_H), (const bf16*)(WB + W_UP), R, UPC, DM}; TileOrder S; S.init2(UPC, G, bx, last);
            EpiBf16N E{(bf16*)(ws + WS_UP), UPC, RSL(2 * l + 1), (const float*)(ws + WS_SWUP) + (size_t)l * 5 * UPC};
            pg8::gemm_phase<EpiBf16N, TileOrder, true, true>(ldsp, g, S, E);
            GRID_BAR();
        }
        if (IN(pb + 7)) { PH_BEGIN conv_act_phase((const bf16*)(ws + WS_UP), (bf16*)(ws + WS_ACT), KIN(I_CW) + (size_t)l * 3 * UPC, KIN(I_CB) + (size_t)l * UPC, last, gtid, NT); GRID_BAR(); }
        if (IN(pb + 8)) { PH_BEGIN
            pg8::Gemm g{(const bf16*)(ws + WS_ACT), (const bf16*)(WB + W_DN), R, DM, DFF}; TileOrder S; S.init2(DM, G, bx, true);
            if (!last) {
                {   EpiResGate<true> E{(float*)(ws + WS_X), MODL, 5, (bf16*)(ws + WS_H), GSL(l + 1, 0), RSL(2 * l + 2), nullptr, nullptr};
                    pg8::gemm_phase<EpiResGate<true>, TileOrder, true, true>(ldsp, g, S, E); }
                const int nh = (G >= 64) ? 64 : G;
                __syncthreads();
                if (bx < nh) { CtxHalfOrder S2{DM / 256, nh, bx};
                    EpiResGate<true, true> E2{(float*)(ws + WS_X), MODL, 5, (bf16*)(ws + WS_H), GSL(l + 1, 0), RSL(2 * l + 2), nullptr, nullptr};
                    pg8::gemm_phase<EpiResGate<true, true>, CtxHalfOrder, true, true>(ldsp, g, S2, E2); }
                const int nfull = (G > 64) ? 64 : 0; LAS float* scr = (LAS float*)(ldsp + wave * 16384);
                if (bx >= nfull) for (int it = (bx - nfull) * NWAVES + wave; it < convert_count<4 | 8>(); it += (G - nfull) * NWAVES) convert_item<4 | 8>(l + 1, it, kp, ws, scr, lane);
            } else { EpiResGate<false> E{(float*)(ws + WS_X), MODL, 5, nullptr, nullptr, nullptr, nullptr, nullptr};
                pg8::gemm_phase<EpiResGate<false>, TileOrder, true, true>(ldsp, g, S, E); }
            GRID_BAR();
        }
    }
    if (IN(NPHASE - 1)) { PH_BEGIN
        const float* g = KIN(I_FNG); const float* X = (const float*)(ws + WS_X); float* out = KOUT();
        for (int m0 = 2 * gw; m0 < NB * SEQ; m0 += 2 * NGW) {
            v4f v[2][8];
#pragma unroll
            for (int rr = 0; rr < 2; ++rr) { const int m = m0 + rr, b = m >> 12, t = m & 4095; const v4f* xr = (const v4f*)(X + (size_t)(b * TB + t) * DM) + lane;
#pragma unroll
                for (int j = 0; j < 8; ++j) v[rr][j] = xr[64 * j]; }
#pragma unroll
            for (int rr = 0; rr < 2; ++rr) { float ss = 0.f;
#pragma unroll
                for (int j = 0; j < 8; ++j) ss += (v[rr][j].x * v[rr][j].x + v[rr][j].y * v[rr][j].y) + (v[rr][j].z * v[rr][j].z + v[rr][j].w * v[rr][j].w);
                const float rstd = __builtin_amdgcn_rsqf(wave_sum(ss) * (1.f / DM) + EPS);
                v4f* orow = (v4f*)(out + (size_t)(m0 + rr) * DM) + lane;
#pragma unroll
                for (int j = 0; j < 8; ++j) orow[64 * j] = v[rr][j] * rstd * *(const v4f*)(g + 4 * lane + 256 * j); }
        }
    }
#undef IN
}

extern "C" void kernel_launch(void* const* d_in, const int* in_sizes, int n_in, void* d_out, int out_size, void* d_ws, size_t ws_size, hipStream_t stream) {
    static int grid = 0;
    if (grid == 0) {
        if (n_in != 22 || in_sizes[0] != NB * SEQ * DM || out_size != NB * SEQ * DM || ws_size < WS_END) {
            fprintf(stderr, "kernel_launch: unexpected shapes (n_in %d in0 %d out %d ws %zu, need ws >= %zu); nothing launched\n", n_in, n_in > 0 ? in_sizes[0] : -1, out_size, ws_size, (size_t)WS_END); grid = -1; return; }
        int dev = 0, cus = 0, per_cu = 0;
        if (hipGetDevice(&dev) != hipSuccess || hipDeviceGetAttribute(&cus, hipDeviceAttributeMultiprocessorCount, dev) != hipSuccess) { grid = -1; return; }
        if (hipFuncSetAttribute((const void*)mk_fwd, hipFuncAttributeMaxDynamicSharedMemorySize, LDS_BYTES) != hipSuccess) { fprintf(stderr, "kernel_launch: hipFuncSetAttribute failed\n"); grid = -1; return; }
        if (hipOccupancyMaxActiveBlocksPerMultiprocessor(&per_cu, (const void*)mk_fwd, NTHR, LDS_BYTES) != hipSuccess || per_cu < 1)
            fprintf(stderr, "kernel_launch: note: occupancy query reports %d workgroups per CU\n", per_cu);
        (void)hipGetLastError();
        grid = cus;
    }
    if (grid < 0) return;
    if (hipMemsetAsync((char*)d_ws + WS_CTL, 0, CTL_ZERO_BYTES, stream) != hipSuccess) return;
    Args a{};
    for (int i = 0; i < 22; ++i) a.in[i] = (const float*)d_in[i];
    a.out = (float*)d_out; a.ws = (unsigned char*)d_ws;
#if MK_ONE_LAUNCH
    a.ph_lo = 0; a.ph_hi = NPHASE;
    hipLaunchKernelGGL(mk_fwd, dim3(grid), dim3(NTHR), LDS_BYTES, stream, a);
#else
    for (int p = 0; p < NPHASE; ++p) { a.ph_lo = p; a.ph_hi = p + 1; hipLaunchKernelGGL(mk_fwd, dim3(grid), dim3(NTHR), LDS_BYTES, stream, a); }
#endif
    const hipError_t le = hipPeekAtLastError();
    if (le != hipSuccess) fprintf(stderr, "kernel_launch: launch failed: %s\n", hipGetErrorName(le));
}
```
